# Optimizing an MI355X kernel written in HIP

```python
import jax
import jax.numpy as jnp
from jax import lax
import numpy as np

D_MODEL = 4096
BATCH = 4
SEQ = 2048
DEPTH = 4

W_A = D_MODEL // 4
W_B = D_MODEL // 2
W_C = D_MODEL // 4
D_MIX = W_A + W_B + W_C
HEAD_DIM = 64
N_Q_HEADS = W_B // HEAD_DIM
KV_GROUP = 8
N_KV_HEADS = N_Q_HEADS // KV_GROUP
KV_W = N_KV_HEADS * HEAD_DIM
WINDOW = 128
BLOCK = 128
CONV_A = 3
CONV_C = 4
N_RG_HEADS = 8
RG_BLOCK = W_C // N_RG_HEADS
RG_C = 8.0
IN_W = 4 * W_A + (W_B + 2 * KV_W + W_B) + 2 * W_C
DEEPNORM_ALPHA = (2.0 * DEPTH) ** 0.25
DEEPNORM_BETA = (8.0 * DEPTH) ** -0.25
LN_EPS = 1e-5
RMS_EPS = 1e-6
NEG_INF = -1e30

kernel_name = "hybrid_shortconv_swa_rglru_deepnorm"


def layer_norm(x, g, b):
    xf = x.astype(jnp.float32)
    mu = xf.mean(-1, keepdims=True)
    var = jnp.mean(jnp.square(xf - mu), -1, keepdims=True)
    y = (xf - mu) * lax.rsqrt(var + LN_EPS) * g.astype(jnp.float32) + b.astype(jnp.float32)
    return y.astype(x.dtype)


def rms_norm(x, g):
    xf = x.astype(jnp.float32)
    y = xf * lax.rsqrt(jnp.mean(xf * xf, -1, keepdims=True) + RMS_EPS) * g.astype(jnp.float32)
    return y.astype(x.dtype)


def causal_depthwise_conv(u, w):
    K = w.shape[0]
    S = u.shape[1]
    up = jnp.pad(u, ((0, 0), (K - 1, 0), (0, 0)))
    y = up[:, 0:S] * w[0]
    for k in range(1, K):
        y = y + up[:, k:k + S] * w[k]
    return y


def sliding_window_attention(q, k, v, sinks):
    B, S = q.shape[0], q.shape[1]
    nb = S // BLOCK
    qb = q.reshape(B, nb, BLOCK, N_KV_HEADS, KV_GROUP, HEAD_DIM)

    def with_prev(t):
        tb = t.reshape(B, nb, BLOCK, N_KV_HEADS, HEAD_DIM)
        prev = jnp.pad(tb, ((0, 0), (1, 0), (0, 0), (0, 0), (0, 0)))[:, :-1]
        return jnp.concatenate([prev, tb], axis=2)

    kk = with_prev(k)
    vv = with_prev(v)
    s = jnp.einsum("bnqhgd,bnkhd->bnhgqk", qb, kk).astype(jnp.float32) * (HEAD_DIM ** -0.5)
    qi = jnp.arange(BLOCK)[:, None]
    kj = jnp.arange(2 * BLOCK)[None, :]
    dist = qi + BLOCK - kj
    band = (dist >= 0) & (dist < WINDOW)
    blk = jnp.arange(nb)[:, None, None]
    valid = band[None] & ((blk > 0) | (kj[None] >= BLOCK))
    s = jnp.where(valid[None, :, None, None], s, NEG_INF)
    sink = sinks.astype(jnp.float32).reshape(N_KV_HEADS, KV_GROUP)[None, None, :, :, None, None]
    m = jnp.maximum(s.max(-1, keepdims=True), sink)
    p = jnp.exp(s - m)
    p = p / (p.sum(-1, keepdims=True) + jnp.exp(sink - m))
    o = jnp.einsum("bnhgqk,bnkhd->bnqhgd", p.astype(v.dtype), vv)
    return o.reshape(B, S, N_Q_HEADS * HEAD_DIM)


def rg_lru(xc, w_r, b_r, w_i, b_i, lam):
    B, S, _ = xc.shape
    xh = xc.reshape(B, S, N_RG_HEADS, RG_BLOCK)
    r = jax.nn.sigmoid(jnp.einsum("bshi,hij->bshj", xh, w_r).reshape(B, S, W_C) + b_r)
    i = jax.nn.sigmoid(jnp.einsum("bshi,hij->bshj", xh, w_i).reshape(B, S, W_C) + b_i)
    log_a = RG_C * r.astype(jnp.float32) * jax.nn.log_sigmoid(lam.astype(jnp.float32))
    a = jnp.exp(log_a)
    u = jnp.sqrt(-jnp.expm1(2.0 * log_a)) * (i * xc).astype(jnp.float32)

    def combine(c1, c2):
        a1, b1 = c1
        a2, b2 = c2
        return a1 * a2, a2 * b1 + b2

    _, hs = lax.associative_scan(combine, (a, u), axis=1)
    return hs.astype(xc.dtype)


def hybrid_layer(x, w_in, conv_a_w, sinks, conv_c_w, conv_c_b, gate_r_w, gate_r_b,
                 gate_i_w, gate_i_b, rg_lambda, norm_a, norm_b, norm_c, w_out, ln_g, ln_b):
    B, S, _ = x.shape
    h = jnp.einsum("bsd,de->bse", x, w_in)
    sizes = [W_A, W_A, W_A, W_A, W_B, KV_W, KV_W, W_B, W_C, W_C]
    offs = np.cumsum(sizes)[:-1].tolist()
    a_b, a_c, a_x, a_g, q, k, v, b_g, c_x, c_g = jnp.split(h, offs, axis=-1)
    y_a = a_b * causal_depthwise_conv(a_c * a_x, conv_a_w)
    y_b = sliding_window_attention(q.reshape(B, S, N_Q_HEADS, HEAD_DIM),
                                   k.reshape(B, S, N_KV_HEADS, HEAD_DIM),
                                   v.reshape(B, S, N_KV_HEADS, HEAD_DIM), sinks)
    xc = causal_depthwise_conv(c_x, conv_c_w) + conv_c_b
    y_c = rg_lru(xc, gate_r_w, gate_r_b, gate_i_w, gate_i_b, rg_lambda)
    mix = jnp.concatenate([rms_norm(y_a, norm_a) * jax.nn.silu(a_g),
                           rms_norm(y_b, norm_b) * jax.nn.silu(b_g),
                           rms_norm(y_c, norm_c) * jax.nn.silu(c_g)], axis=-1)
    out = jnp.einsum("bse,ed->bsd", mix, w_out)
    return layer_norm(DEEPNORM_ALPHA * x + out, ln_g, ln_b)


def setup_inputs(seed: int = 0) -> dict:
    key = jax.random.key(seed)
    ks = jax.random.split(key, 20)
    f32 = jnp.float32
    x = jax.random.normal(ks[0], (BATCH, SEQ, D_MODEL), f32)
    w_in = jax.random.normal(ks[1], (DEPTH, D_MODEL, IN_W), f32) * D_MODEL ** -0.5
    conv_a_w = jax.random.normal(ks[2], (DEPTH, CONV_A, W_A), f32) * CONV_A ** -0.5
    sinks = jax.random.normal(ks[3], (DEPTH, N_Q_HEADS), f32) * 0.5
    conv_c_w = jax.random.normal(ks[4], (DEPTH, CONV_C, W_C), f32) * CONV_C ** -0.5
    conv_c_b = jax.random.normal(ks[5], (DEPTH, W_C), f32) * 0.01
    gate_r_w = jax.random.normal(ks[6], (DEPTH, N_RG_HEADS, RG_BLOCK, RG_BLOCK), f32) * RG_BLOCK ** -0.5
    gate_r_b = jax.random.normal(ks[7], (DEPTH, W_C), f32) * 0.01
    gate_i_w = jax.random.normal(ks[8], (DEPTH, N_RG_HEADS, RG_BLOCK, RG_BLOCK), f32) * RG_BLOCK ** -0.5
    gate_i_b = jax.random.normal(ks[9], (DEPTH, W_C), f32) * 0.01
    a_pow_c = jax.random.uniform(ks[10], (DEPTH, W_C), f32, minval=0.9, maxval=0.999)
    a0 = a_pow_c ** (1.0 / RG_C)
    rg_lambda = jnp.log(a0) - jnp.log1p(-a0)
    norm_a = 1.0 + 0.01 * jax.random.normal(ks[11], (DEPTH, W_A), f32)
    norm_b = 1.0 + 0.01 * jax.random.normal(ks[12], (DEPTH, W_B), f32)
    norm_c = 1.0 + 0.01 * jax.random.normal(ks[13], (DEPTH, W_C), f32)
    w_out = jax.random.normal(ks[14], (DEPTH, D_MIX, D_MODEL), f32) * (D_MIX ** -0.5) * DEEPNORM_BETA
    ln_g = 1.0 + 0.01 * jax.random.normal(ks[15], (DEPTH, D_MODEL), f32)
    ln_b = 0.01 * jax.random.normal(ks[16], (DEPTH, D_MODEL), f32)
    return {"x": x, "w_in": w_in, "conv_a_w": conv_a_w, "sinks": sinks,
            "conv_c_w": conv_c_w, "conv_c_b": conv_c_b,
            "gate_r_w": gate_r_w, "gate_r_b": gate_r_b,
            "gate_i_w": gate_i_w, "gate_i_b": gate_i_b, "rg_lambda": rg_lambda,
            "norm_a": norm_a, "norm_b": norm_b, "norm_c": norm_c,
            "w_out": w_out, "ln_g": ln_g, "ln_b": ln_b}


def reference(x, w_in, conv_a_w, sinks, conv_c_w, conv_c_b, gate_r_w, gate_r_b,
              gate_i_w, gate_i_b, rg_lambda, norm_a, norm_b, norm_c, w_out, ln_g, ln_b):
    for l in range(DEPTH):
        x = hybrid_layer(x, w_in[l], conv_a_w[l], sinks[l], conv_c_w[l], conv_c_b[l],
                         gate_r_w[l], gate_r_b[l], gate_i_w[l], gate_i_b[l], rg_lambda[l],
                         norm_a[l], norm_b[l], norm_c[l], w_out[l], ln_g[l], ln_b[l])
    return x
```

```cpp
#include <hip/hip_runtime.h>
#include <cstdio>
#include <cstdint>
namespace pg8 {
#define PG8_LAS __attribute__((address_space(3)))
typedef unsigned short bf16_t;
typedef short bf16x8 __attribute__((ext_vector_type(8)));
typedef float f32x4 __attribute__((ext_vector_type(4)));
typedef float f32x2 __attribute__((ext_vector_type(2)));
typedef unsigned u32x4 __attribute__((ext_vector_type(4)));
constexpr int BM = 256, BK = 64, HALF = 128, HTB = HALF * BK * 2  , STAGE_BYTES = 8 * HTB, NXCD = 8, WGM = 8;

__host__ __device__ __forceinline__ int lds_byte(int r, int c) { const int st = (r >> 4) * 2 + (c >> 5), rr = r & 15, cc = c & 31, ob = rr * 64 + cc * 2; return st * 1024 + (ob ^ (((ob >> 9) & 1) << 5)); }
__host__ __device__ __forceinline__ void stage_rc(int b, int& R, int& C) { const int st = b / 1024, sb = b % 1024, swz = sb ^ (((sb >> 9) & 1) << 5); R = (st >> 1) * 16 + swz / 64; C = (st & 1) * 32 + (swz % 64) / 2; }
__host__ __device__ __forceinline__ int perm32(int rho) { const int n = rho >> 4, i = rho & 15; return 8 * (i >> 2) + 4 * n + (i & 3); }

struct Unit { int pm, pn; };
struct Gemm { const bf16_t* A; const bf16_t* Bt; int M, N, K, pad; };

struct StaticOrder {
    int nM, nN, nwg, G, c;
    __host__ __device__ void init(int M, int N, int G_, int c_) { nM = M / BM; nN = N / BM; nwg = nM * nN; G = G_; c = c_; }
    __host__ __device__ bool next(int i, Unit& u) const {
        const long L = (long)i * G + c; if (L >= nwg) return false;
        int wgid = (int)L; { const int q = nwg / NXCD, r = nwg % NXCD, xcd = wgid % NXCD, off = wgid / NXCD; wgid = (xcd < r ? xcd * (q + 1) : r * (q + 1) + (xcd - r) * q) + off; }
        const int nig = WGM * nN, gid = wgid / nig, fm = gid * WGM, gsz = (nM - fm) < WGM ? (nM - fm) : WGM;
        u.pm = fm + ((wgid % nig) % gsz); u.pn = (wgid % nig) / gsz; return true;
    }
    __device__ __forceinline__ void a_ready(const Unit&) const {}
    __device__ __forceinline__ void done(const Unit&) const {}
};

__device__ __forceinline__ unsigned cvt_pk_bf16(float lo, float hi) { unsigned r; asm volatile("v_cvt_pk_bf16_f32 %0, %1, %2" : "=v"(r) : "v"(lo), "v"(hi)); return r; }

struct EpiBf16 {
    static constexpr bool PERM = true, AFTER_DRAIN = false;
    bf16_t* O; int ldc, pad;
    __device__ __forceinline__ void operator()(const f32x4 (&acc)[2][2][4][2], const Unit& u, int wr, int wc, int fr, int fq) const {
        const int row0 = u.pm * BM + wr * 64 + fr; const int col0 = u.pn * BM + wc * 32 + 8 * fq;
#pragma unroll
        for (int ai = 0; ai < 2; ++ai)
#pragma unroll
            for (int m = 0; m < 4; ++m) { bf16_t* rowp = O + (size_t)(row0 + ai * HALF + m * 16) * ldc + col0;
#pragma unroll
                for (int bj = 0; bj < 2; ++bj) { const f32x4 v0 = acc[ai][bj][m][0], v1 = acc[ai][bj][m][1];
                    u32x4 w; w.x = cvt_pk_bf16(v0[0], v0[1]); w.y = cvt_pk_bf16(v0[2], v0[3]); w.z = cvt_pk_bf16(v1[0], v1[1]); w.w = cvt_pk_bf16(v1[2], v1[3]);
                    *(u32x4*)(rowp + bj * HALF) = w; } }
    }
};
struct EpiResF32 {
    static constexpr bool PERM = false, AFTER_DRAIN = false;
    const float* X; float* Y; int ldc; float alpha;
    __device__ __forceinline__ void operator()(const f32x4 (&acc)[2][2][4][2], const Unit& u, int wr, int wc, int fr, int fq) const {
        const int row0 = u.pm * BM + wr * 64 + fr, col0 = u.pn * BM + wc * 32 + 4 * fq;
#pragma unroll
        for (int ai = 0; ai < 2; ++ai)
#pragma unroll
            for (int m = 0; m < 4; ++m) { const size_t off = (size_t)(row0 + ai * HALF + m * 16) * ldc + col0;
#pragma unroll
                for (int bj = 0; bj < 2; ++bj)
#pragma unroll
                    for (int n = 0; n < 2; ++n) { const f32x4 xv = *(const f32x4*)(X + off + bj * HALF + n * 16); *(f32x4*)(Y + off + bj * HALF + n * 16) = xv * alpha + acc[ai][bj][m][n]; }
                asm volatile("" ::: "memory"); }
    }
};

template <class Epi, class Sched, bool ALIGN_EPI = false, bool SP2 = false>
__device__ __forceinline__ void gemm_phase(PG8_LAS unsigned char* lds, const Gemm g, const Sched& S, const Epi& E) {
    const int tid = threadIdx.x, wid = __builtin_amdgcn_readfirstlane(tid >> 6), lane = tid & 63, wr = wid >> 2, wc = wid & 3, fr = lane & 15, fq = lane >> 4;
    const int K = g.K, nt = K / BK;
    unsigned voffA[2], voffB[2];
#pragma unroll
    for (int i = 0; i < 2; ++i) { int R, C; stage_rc(tid * 16 + i * 8192, R, C); const int Rb = Epi::PERM ? ((R & ~31) + perm32(R & 31)) : R;
        voffA[i] = (unsigned)(R * K + C) * 2u; voffB[i] = (unsigned)(Rb * K + C) * 2u; }
    const size_t kstep = (size_t)(BK * 2);
    const size_t hstep = (size_t)HALF * K * 2;
    const size_t tstep = 2 * hstep;
    const unsigned ldsw = (unsigned)wid * 1024u;
    const int aoff = lds_byte(wr * 64 + fr, fq * 8), boff = lds_byte(wc * 32 + fr, fq * 8);
#define PG8_SA(b, h) (((b) * 2 + (h)) * HTB)
#define PG8_SB(b, h) ((4 + (b) * 2 + (h)) * HTB)
#define PG8_STAGE(bufoff, gbase, voff) do { _Pragma("unroll") for (int _i = 0; _i < 2; ++_i) \
        __builtin_amdgcn_global_load_lds((const unsigned*)((const char*)(gbase) + (voff)[_i]), (PG8_LAS unsigned*)(lds + (bufoff) + ldsw + _i * 8192), 16, 0, 0); } while (0)
#define PG8_LDA(dst, b, h) do { _Pragma("unroll") for (int m = 0; m < 4; ++m) _Pragma("unroll") for (int k = 0; k < 2; ++k) dst[m][k] = *(const PG8_LAS bf16x8*)(lds + PG8_SA(b, h) + aoff + m * 2048 + k * 1024); } while (0)
#define PG8_LDB(dst, b, h) do { _Pragma("unroll") for (int n = 0; n < 2; ++n) _Pragma("unroll") for (int k = 0; k < 2; ++k) dst[n][k] = *(const PG8_LAS bf16x8*)(lds + PG8_SB(b, h) + boff + n * 2048 + k * 1024); } while (0)
#define PG8_MMA(ai, bj, At, Bt) do { __builtin_amdgcn_s_setprio(1); _Pragma("unroll") for (int m = 0; m < 4; ++m) _Pragma("unroll") for (int n = 0; n < 2; ++n) _Pragma("unroll") for (int k = 0; k < 2; ++k) \
        acc[ai][bj][m][n] = __builtin_amdgcn_mfma_f32_16x16x32_bf16(Bt[n][k], At[m][k], acc[ai][bj][m][n], 0, 0, 0); __builtin_amdgcn_s_setprio(0); } while (0)
#define PG8_WAIT_V(n) asm volatile("s_waitcnt vmcnt(" #n ")" ::: "memory")
#define PG8_WAIT_L(n) asm volatile("s_waitcnt lgkmcnt(" #n ")" ::: "memory")
#define PG8_BAR __builtin_amdgcn_s_barrier()
#define PG8_SCHED __builtin_amdgcn_sched_barrier(0)
    Unit cur, nxt; int ui = 0;
    if (!S.next(0, cur)) return;
    f32x4 acc[2][2][4][2];
#pragma unroll
    for (int a = 0; a < 2; ++a)
#pragma unroll
        for (int b = 0; b < 2; ++b)
#pragma unroll
            for (int m = 0; m < 4; ++m)
#pragma unroll
                for (int n = 0; n < 2; ++n) acc[a][b][m][n] = (f32x4){0.f, 0.f, 0.f, 0.f};
    bf16x8 At[4][2], B0[2][2], B1[2][2];
    const char* cA = (const char*)g.A + (size_t)cur.pm * tstep; const char* cB = (const char*)g.Bt + (size_t)cur.pn * tstep;
    S.a_ready(cur);
    if constexpr (SP2) {
        PG8_STAGE(PG8_SB(0, 0), cB, voffB); PG8_STAGE(PG8_SB(0, 1), cB + hstep, voffB); PG8_STAGE(PG8_SA(0, 0), cA, voffA); PG8_STAGE(PG8_SA(0, 1), cA + hstep, voffA);
        if (wr == 1) PG8_BAR;
        PG8_WAIT_V(2); PG8_BAR;
        PG8_STAGE(PG8_SB(1, 0), cB + kstep, voffB); PG8_STAGE(PG8_SA(1, 0), cA + kstep, voffA); PG8_STAGE(PG8_SB(1, 1), cB + hstep + kstep, voffB);
        PG8_WAIT_V(6); PG8_BAR;
    } else {
        PG8_STAGE(PG8_SB(0, 0), cB, voffB); PG8_STAGE(PG8_SA(0, 0), cA, voffA); PG8_STAGE(PG8_SB(0, 1), cB + hstep, voffB); PG8_STAGE(PG8_SA(0, 1), cA + hstep, voffA);
        if (wr == 1) PG8_BAR;
        PG8_WAIT_V(4); PG8_BAR;
        PG8_STAGE(PG8_SB(1, 0), cB + kstep, voffB); PG8_STAGE(PG8_SA(1, 0), cA + kstep, voffA); PG8_STAGE(PG8_SB(1, 1), cB + hstep + kstep, voffB);
        PG8_WAIT_V(6); PG8_BAR;
    }
    for (;;) {
        const bool has_next = S.next(ui + 1, nxt);
        const char* nA = has_next ? (const char*)g.A + (size_t)nxt.pm * tstep : cA; const char* nB = has_next ? (const char*)g.Bt + (size_t)nxt.pn * tstep : cB;
        for (int t = 0; t < nt; t += 2) {
            const bool last = (t == nt - 2);
            const char* a1 = cA + (size_t)(t + 1) * kstep;
            const char* a2 = last ? nA : cA + (size_t)(t + 2) * kstep; const char* b2 = last ? nB : cB + (size_t)(t + 2) * kstep;
            const char* a3 = a2 + kstep; const char* b3 = b2 + kstep;
            if (last && has_next) S.a_ready(nxt);
            if constexpr (SP2) {
            PG8_LDB(B0, 0, 0); PG8_LDB(B1, 0, 1); PG8_SCHED; PG8_LDA(At, 0, 0); PG8_STAGE(PG8_SA(1, 1), a1 + hstep, voffA);
            PG8_WAIT_V(8); PG8_WAIT_L(0); PG8_BAR; PG8_MMA(0, 0, At, B0); PG8_MMA(0, 1, At, B1); PG8_BAR; PG8_SCHED;
            PG8_LDA(At, 0, 1); PG8_STAGE(PG8_SB(0, 0), b2, voffB); PG8_STAGE(PG8_SB(0, 1), b2 + hstep, voffB); PG8_STAGE(PG8_SA(0, 0), a2, voffA);
            PG8_WAIT_V(8); PG8_WAIT_L(0); PG8_BAR; PG8_MMA(1, 0, At, B0); PG8_MMA(1, 1, At, B1); PG8_BAR; PG8_SCHED;
            PG8_LDB(B0, 1, 0); PG8_LDB(B1, 1, 1); PG8_SCHED; PG8_LDA(At, 1, 0); PG8_STAGE(PG8_SA(0, 1), a2 + hstep, voffA);
            PG8_WAIT_V(8); PG8_WAIT_L(0); PG8_BAR; PG8_MMA(0, 0, At, B0); PG8_MMA(0, 1, At, B1); PG8_BAR; PG8_SCHED;
            PG8_LDA(At, 1, 1); PG8_STAGE(PG8_SB(1, 0), b3, voffB); PG8_STAGE(PG8_SB(1, 1), b3 + hstep, voffB); PG8_STAGE(PG8_SA(1, 0), a3, voffA);
            PG8_WAIT_V(8); PG8_WAIT_L(0); PG8_BAR; PG8_MMA(1, 0, At, B0); PG8_MMA(1, 1, At, B1); PG8_BAR; PG8_SCHED;
            } else {
            PG8_LDB(B0, 0, 0); PG8_SCHED; PG8_LDA(At, 0, 0); PG8_STAGE(PG8_SA(1, 1), a1 + hstep, voffA);
            PG8_WAIT_L(8); PG8_BAR; PG8_WAIT_L(0); PG8_MMA(0, 0, At, B0); PG8_BAR; PG8_SCHED;
            PG8_LDB(B1, 0, 1); PG8_STAGE(PG8_SB(0, 0), b2, voffB);
            PG8_BAR; PG8_WAIT_L(0); PG8_MMA(0, 1, At, B1); PG8_BAR;
            PG8_LDA(At, 0, 1); PG8_STAGE(PG8_SA(0, 0), a2, voffA);
            PG8_BAR; PG8_WAIT_L(0); PG8_MMA(1, 0, At, B0); PG8_BAR; PG8_SCHED;
            PG8_STAGE(PG8_SB(0, 1), b2 + hstep, voffB);
            PG8_WAIT_V(6); PG8_BAR; PG8_MMA(1, 1, At, B1); PG8_BAR;
            PG8_LDB(B0, 1, 0); PG8_SCHED; PG8_LDA(At, 1, 0); PG8_STAGE(PG8_SA(0, 1), a2 + hstep, voffA);
            PG8_WAIT_L(8); PG8_BAR; PG8_WAIT_L(0); PG8_MMA(0, 0, At, B0); PG8_BAR; PG8_SCHED;
            PG8_LDB(B1, 1, 1); PG8_STAGE(PG8_SB(1, 0), b3, voffB);
            PG8_BAR; PG8_WAIT_L(0); PG8_MMA(0, 1, At, B1); PG8_BAR;
            PG8_LDA(At, 1, 1); PG8_STAGE(PG8_SA(1, 0), a3, voffA);
            PG8_BAR; PG8_WAIT_L(0); PG8_MMA(1, 0, At, B0); PG8_BAR; PG8_SCHED;
            PG8_STAGE(PG8_SB(1, 1), b3 + hstep, voffB);
            PG8_WAIT_V(6); PG8_BAR; PG8_MMA(1, 1, At, B1); PG8_BAR;
            }
        }
        if constexpr (ALIGN_EPI) { if (wr == 0) PG8_BAR; }
        if constexpr (!Epi::AFTER_DRAIN) { E(acc, cur, wr, wc, fr, fq); S.done(cur); }
        if (!has_next) break;
#pragma unroll
        for (int a = 0; a < 2; ++a)
#pragma unroll
            for (int b = 0; b < 2; ++b)
#pragma unroll
                for (int m = 0; m < 4; ++m)
#pragma unroll
                    for (int n = 0; n < 2; ++n) acc[a][b][m][n] = (f32x4){0.f, 0.f, 0.f, 0.f};
        cur = nxt; cA = nA; cB = nB; ++ui;
        if constexpr (ALIGN_EPI) { if (wr == 1) PG8_BAR; }
    }
    PG8_WAIT_V(0);
    if constexpr (!ALIGN_EPI) { if (wr == 0) PG8_BAR; }
    PG8_BAR;
    if constexpr (Epi::AFTER_DRAIN) { E.fused(acc, cur, wr, wc, fr, fq, lds, wid, lane); S.done(cur); }
#undef PG8_SA
#undef PG8_SB
#undef PG8_STAGE
#undef PG8_LDA
#undef PG8_LDB
#undef PG8_MMA
#undef PG8_WAIT_V
#undef PG8_WAIT_L
#undef PG8_BAR
#undef PG8_SCHED
}
}

typedef unsigned short bf16;
typedef unsigned v4u __attribute__((ext_vector_type(4)));
typedef unsigned v2u __attribute__((ext_vector_type(2)));
typedef float f32x4 __attribute__((ext_vector_type(4)));
constexpr int DM = 4096, NB = 4, SEQ = 2048, M = NB * SEQ, DEPTH = 4;
constexpr int WA = 1024, WB = 2048, WC = 1024, DMIX = 4096, HD = 64, NQH = 32, KVG = 8, NKV = 4;
constexpr int INW = 10752;
constexpr int OFF_AB = 0, OFF_AC = 1024, OFF_AX = 2048, OFF_AG = 3072, OFF_Q = 4096, OFF_K = 6144, OFF_V = 6400, OFF_BG = 6656, OFF_CX = 8704, OFF_CG = 9728;
constexpr float ALPHA = 1.6817928305074290861f;
constexpr float LN_EPS = 1e-5f, RMS_EPS = 1e-6f;
constexpr size_t MiB = 1u << 20;
constexpr size_t WS_CTL = 0, WS_WIN = 16 * MiB, WS_WOUT = 352 * MiB, WS_XB = 480 * MiB, WS_H = 544 * MiB, WS_MIX = 712 * MiB, WS_YB = 776 * MiB,
                 WS_A = 840 * MiB, WS_U = 872 * MiB, WS_YC = 904 * MiB, WS_Y = 936 * MiB, WS_XC = 1064 * MiB, WS_END = 1192 * MiB;
constexpr size_t WIN_L = (size_t)INW * DM, WOUT_L = (size_t)DM * DMIX;

__device__ __forceinline__ unsigned f2bf(float f) { unsigned u = __builtin_bit_cast(unsigned, f); return (u + 0x7fffu + ((u >> 16) & 1u)) >> 16; }
__device__ __forceinline__ unsigned pk2(float lo, float hi) { return f2bf(lo) | (f2bf(hi) << 16); }
__device__ __forceinline__ float bf2f(unsigned short b) { return __builtin_bit_cast(float, (unsigned)b << 16); }
__device__ __forceinline__ float bflo(unsigned w) { return __builtin_bit_cast(float, w << 16); }
__device__ __forceinline__ float bfhi(unsigned w) { return __builtin_bit_cast(float, w & 0xffff0000u); }
__device__ __forceinline__ float wave_sum(float v) {
#pragma unroll
    for (int o = 1; o < 64; o <<= 1) v += __shfl_xor(v, o);
    return v;
}
__device__ __forceinline__ float wave_max(float v) {
#pragma unroll
    for (int o = 1; o < 64; o <<= 1) v = fmaxf(v, __shfl_xor(v, o));
    return v;
}
__device__ __forceinline__ float silu(float x) { return x / (1.f + __expf(-x)); }
__device__ __forceinline__ float sigmoidf(float x) { return 1.f / (1.f + __expf(-x)); }
#define LDS_WAIT() asm volatile("s_waitcnt lgkmcnt(0)" ::: "memory")

__global__ void __launch_bounds__(256) k_convert_w(const float* __restrict__ W, bf16* __restrict__ WT, int K, int N) {
    __shared__ float scr_all[4][64 * 33];
    const int lane = threadIdx.x & 63, wave = threadIdx.x >> 6;
    float* scr = scr_all[wave];
    const int nblk = N / 32, nitems = (K / 64) * nblk;
    for (int item = blockIdx.x * 4 + wave; item < nitems; item += gridDim.x * 4) {
        const int kb = item / nblk, nb = item % nblk, k0 = 64 * kb, n0 = 32 * nb;
#pragma unroll 8
        for (int i = 0; i < 32; ++i) { const int kk = 2 * i + (lane >> 5); scr[kk * 33 + (lane & 31)] = W[(size_t)(k0 + kk) * N + n0 + (lane & 31)]; }
        LDS_WAIT();
        const int c = lane & 7;
#pragma unroll
        for (int j = 0; j < 4; ++j) { const int n = (lane >> 3) + 8 * j; const float* s = scr + (8 * c) * 33 + n;
            v4u o; o.x = pk2(s[0 * 33], s[1 * 33]); o.y = pk2(s[2 * 33], s[3 * 33]); o.z = pk2(s[4 * 33], s[5 * 33]); o.w = pk2(s[6 * 33], s[7 * 33]);
            *(v4u*)(WT + (size_t)(n0 + n) * K + k0 + 8 * c) = o; }
        LDS_WAIT();
    }
}
__global__ void __launch_bounds__(256) k_x_to_bf16(const float* __restrict__ x, bf16* __restrict__ xb, size_t n8) {
    for (size_t i = (size_t)blockIdx.x * 256 + threadIdx.x; i < n8; i += (size_t)gridDim.x * 256) {
        const f32x4 a = ((const f32x4*)x)[2 * i], b = ((const f32x4*)x)[2 * i + 1];
        v4u o; o.x = pk2(a[0], a[1]); o.y = pk2(a[2], a[3]); o.z = pk2(b[0], b[1]); o.w = pk2(b[2], b[3]);
        ((v4u*)xb)[i] = o; }
}

template <class Epi> __global__ __launch_bounds__(512, 2) void k_gemm(pg8::Gemm g, Epi E) {
    extern __shared__ __attribute__((aligned(16))) unsigned char shm[];
    pg8::StaticOrder S; S.init(g.M, g.N, (int)gridDim.x, (int)blockIdx.x);
    pg8::gemm_phase<Epi, pg8::StaticOrder, true, true>((PG8_LAS unsigned char*)shm, g, S, E);
}

__global__ void __launch_bounds__(256) k_branch_a(const bf16* __restrict__ h, const float* __restrict__ cw, const float* __restrict__ nrm, bf16* __restrict__ mix) {
    const int lane = threadIdx.x & 63, wave = threadIdx.x >> 6, t = blockIdx.x * 4 + wave, s = t % SEQ;
    const bf16* hr = h + (size_t)t * INW;
    float y[16], g[16]; float ss = 0.f;
#pragma unroll
    for (int j = 0; j < 2; ++j) {
        const int ch0 = j * 512 + lane * 8;
        const v4u ab = *(const v4u*)(hr + OFF_AB + ch0), ag = *(const v4u*)(hr + OFF_AG + ch0);
        v4u c0 = *(const v4u*)(hr + OFF_AC + ch0), x0 = *(const v4u*)(hr + OFF_AX + ch0), c1 = {0, 0, 0, 0}, x1 = {0, 0, 0, 0}, c2 = {0, 0, 0, 0}, x2 = {0, 0, 0, 0};
        if (s >= 1) { c1 = *(const v4u*)(hr - INW + OFF_AC + ch0); x1 = *(const v4u*)(hr - INW + OFF_AX + ch0); }
        if (s >= 2) { c2 = *(const v4u*)(hr - 2 * INW + OFF_AC + ch0); x2 = *(const v4u*)(hr - 2 * INW + OFF_AX + ch0); }
#pragma unroll
        for (int e = 0; e < 8; ++e) {
            const int w = e >> 1; const bool hi = e & 1;
            const float p0 = hi ? bfhi(c0[w]) * bfhi(x0[w]) : bflo(c0[w]) * bflo(x0[w]);
            const float p1 = hi ? bfhi(c1[w]) * bfhi(x1[w]) : bflo(c1[w]) * bflo(x1[w]);
            const float p2 = hi ? bfhi(c2[w]) * bfhi(x2[w]) : bflo(c2[w]) * bflo(x2[w]);
            const int ch = ch0 + e;
            const float cv = cw[ch] * p2 + cw[1024 + ch] * p1 + cw[2048 + ch] * p0;
            const float abv = hi ? bfhi(ab[w]) : bflo(ab[w]);
            const float yv = abv * cv; y[j * 8 + e] = yv; ss += yv * yv;
            g[j * 8 + e] = silu(hi ? bfhi(ag[w]) : bflo(ag[w])) * nrm[ch];
        }
    }
    const float rstd = rsqrtf(wave_sum(ss) * (1.f / WA) + RMS_EPS);
#pragma unroll
    for (int j = 0; j < 2; ++j) { const int ch0 = j * 512 + lane * 8; v4u o;
        o.x = pk2(y[j * 8 + 0] * rstd * g[j * 8 + 0], y[j * 8 + 1] * rstd * g[j * 8 + 1]); o.y = pk2(y[j * 8 + 2] * rstd * g[j * 8 + 2], y[j * 8 + 3] * rstd * g[j * 8 + 3]);
        o.z = pk2(y[j * 8 + 4] * rstd * g[j * 8 + 4], y[j * 8 + 5] * rstd * g[j * 8 + 5]); o.w = pk2(y[j * 8 + 6] * rstd * g[j * 8 + 6], y[j * 8 + 7] * rstd * g[j * 8 + 7]);
        *(v4u*)(mix + (size_t)t * DMIX + ch0) = o; }
}

__global__ void __launch_bounds__(512) k_attn(const bf16* __restrict__ h, const float* __restrict__ sinks, float* __restrict__ yb) {
    __shared__ unsigned Kl[160][33];
    __shared__ unsigned Vl[160][32];
    __shared__ float Pl[8][128];
    const int bid = blockIdx.x, qb = bid % 64, kvh = (bid / 64) % 4, b = bid / 256;
    const int s0 = qb * 32, kbase = s0 - 127;
    for (int idx = threadIdx.x; idx < 160 * 32; idx += 512) { const int r = idx >> 5, dp = idx & 31, pos = kbase + r; unsigned kv = 0u, vv = 0u;
        if (pos >= 0 && pos < SEQ) { const bf16* row = h + (size_t)(b * SEQ + pos) * INW; kv = *(const unsigned*)(row + OFF_K + kvh * 64 + 2 * dp); vv = *(const unsigned*)(row + OFF_V + kvh * 64 + 2 * dp); }
        Kl[r][dp] = kv; Vl[r][dp] = vv; }
    __syncthreads();
    const int wave = threadIdx.x >> 6, lane = threadIdx.x & 63, hq = kvh * 8 + wave;
    const float sink = sinks[hq];
    for (int i = 0; i < 32; ++i) {
        const size_t t = (size_t)b * SEQ + s0 + i;
        const float qv = bf2f(h[t * INW + OFF_Q + hq * 64 + lane]);
        float sc[2];
#pragma unroll
        for (int rr = 0; rr < 2; ++rr) { const int r = i + lane + 64 * rr; float a = 0.f;
#pragma unroll
            for (int dp = 0; dp < 32; ++dp) { const unsigned kw = Kl[r][dp];
                const float q0 = __builtin_bit_cast(float, __builtin_amdgcn_readlane(__builtin_bit_cast(int, qv), 2 * dp)), q1 = __builtin_bit_cast(float, __builtin_amdgcn_readlane(__builtin_bit_cast(int, qv), 2 * dp + 1));
                a += q0 * bflo(kw) + q1 * bfhi(kw); }
            sc[rr] = (kbase + r >= 0) ? a * 0.125f : -1e30f; }
        const float m = fmaxf(wave_max(fmaxf(sc[0], sc[1])), sink);
        const float p0 = (sc[0] > -1e29f) ? __expf(sc[0] - m) : 0.f, p1 = (sc[1] > -1e29f) ? __expf(sc[1] - m) : 0.f;
        const float den = wave_sum(p0 + p1) + __expf(sink - m);
        LDS_WAIT();
        Pl[wave][lane] = p0; Pl[wave][lane + 64] = p1;
        LDS_WAIT();
        float o = 0.f;
        const unsigned short* vcol = (const unsigned short*)&Vl[0][0] + lane;
#pragma unroll 8
        for (int j = 0; j < 128; ++j) o += Pl[wave][j] * bf2f(vcol[(i + j) * 64]);
        yb[t * WB + hq * 64 + lane] = o / den;
        LDS_WAIT();
    }
}
__global__ void __launch_bounds__(256) k_branch_b_fin(const bf16* __restrict__ h, const float* __restrict__ yb, const float* __restrict__ nrm, bf16* __restrict__ mix) {
    const int lane = threadIdx.x & 63, wave = threadIdx.x >> 6, t = blockIdx.x * 4 + wave;
    const f32x4* yr = (const f32x4*)(yb + (size_t)t * WB) + lane;
    f32x4 v[8]; float ss = 0.f;
#pragma unroll
    for (int j = 0; j < 8; ++j) { v[j] = yr[64 * j]; ss += (v[j][0] * v[j][0] + v[j][1] * v[j][1]) + (v[j][2] * v[j][2] + v[j][3] * v[j][3]); }
    const float rstd = rsqrtf(wave_sum(ss) * (1.f / WB) + RMS_EPS);
#pragma unroll
    for (int j = 0; j < 8; ++j) { const int c = 4 * (lane + 64 * j); const v2u gw = *(const v2u*)(h + (size_t)t * INW + OFF_BG + c); const f32x4 nv = *(const f32x4*)(nrm + c);
        v2u o; o.x = pk2(v[j][0] * rstd * nv[0] * silu(bflo(gw.x)), v[j][1] * rstd * nv[1] * silu(bfhi(gw.x))); o.y = pk2(v[j][2] * rstd * nv[2] * silu(bflo(gw.y)), v[j][3] * rstd * nv[3] * silu(bfhi(gw.y)));
        *(v2u*)(mix + (size_t)t * DMIX + WA + c) = o; }
}
__global__ void __launch_bounds__(256) k_rg_gates(const bf16* __restrict__ h, const float* __restrict__ ccw, const float* __restrict__ ccb, const float* __restrict__ wr, const float* __restrict__ br,
                                                  const float* __restrict__ wi, const float* __restrict__ bi, const float* __restrict__ lam, float* __restrict__ abuf, float* __restrict__ ubuf) {
    __shared__ float xc[16][128];
    const int tid = threadIdx.x, hd = blockIdx.x % 8, t0 = (blockIdx.x / 8) * 16;
    for (int e = tid; e < 2048; e += 256) { const int tt = e >> 7, c = e & 127, ch = hd * 128 + c, t = t0 + tt, s = t % SEQ;
        float acc = ccb[ch];
#pragma unroll
        for (int k = 0; k < 4; ++k) { if (s - 3 + k >= 0) acc += ccw[k * 1024 + ch] * bf2f(h[(size_t)(t - 3 + k) * INW + OFF_CX + ch]); }
        xc[tt][c] = acc; }
    __syncthreads();
    const int n = tid & 127, th = tid >> 7;
    float ar[8], ai[8];
#pragma unroll
    for (int j = 0; j < 8; ++j) { ar[j] = 0.f; ai[j] = 0.f; }
    const float* wrp = wr + (size_t)hd * 128 * 128 + n; const float* wip = wi + (size_t)hd * 128 * 128 + n;
#pragma unroll 4
    for (int k = 0; k < 128; ++k) { const float w1 = wrp[k * 128], w2 = wip[k * 128];
#pragma unroll
        for (int j = 0; j < 8; ++j) { const float x = xc[th * 8 + j][k]; ar[j] += x * w1; ai[j] += x * w2; } }
    const int ch = hd * 128 + n; const float ls = -log1pf(expf(-lam[ch])), brv = br[ch], biv = bi[ch];
#pragma unroll
    for (int j = 0; j < 8; ++j) { const int t = t0 + th * 8 + j; const float r = sigmoidf(ar[j] + brv), ig = sigmoidf(ai[j] + biv), la = 8.f * r * ls, a = expf(la);
        const float u = sqrtf(-expm1f(2.f * la)) * (ig * xc[th * 8 + j][n]);
        abuf[(size_t)t * WC + ch] = a; ubuf[(size_t)t * WC + ch] = u; }
}
__global__ void __launch_bounds__(512) k_rg_scan(const float* __restrict__ abuf, const float* __restrict__ ubuf, float* __restrict__ yc) {
    __shared__ float Ag[8][64], Hg[8][64];
    const int wave = threadIdx.x >> 6, lane = threadIdx.x & 63, b = blockIdx.x / 16, ch = (blockIdx.x % 16) * 64 + lane;
    const size_t base = ((size_t)b * SEQ + wave * 256) * WC + ch;
    float A = 1.f, H = 0.f;
#pragma unroll 8
    for (int t = 0; t < 256; ++t) { const float a = abuf[base + (size_t)t * WC], u = ubuf[base + (size_t)t * WC]; H = a * H + u; A *= a; }
    Ag[wave][lane] = A; Hg[wave][lane] = H;
    __syncthreads();
    float hc = 0.f;
    for (int w = 0; w < wave; ++w) hc = Ag[w][lane] * hc + Hg[w][lane];
#pragma unroll 8
    for (int t = 0; t < 256; ++t) { const float a = abuf[base + (size_t)t * WC], u = ubuf[base + (size_t)t * WC]; hc = a * hc + u; yc[base + (size_t)t * WC] = hc; }
}
__global__ void __launch_bounds__(256) k_branch_c_fin(const bf16* __restrict__ h, const float* __restrict__ yc, const float* __restrict__ nrm, bf16* __restrict__ mix) {
    const int lane = threadIdx.x & 63, wave = threadIdx.x >> 6, t = blockIdx.x * 4 + wave;
    const f32x4* yr = (const f32x4*)(yc + (size_t)t * WC) + lane;
    f32x4 v[4]; float ss = 0.f;
#pragma unroll
    for (int j = 0; j < 4; ++j) { v[j] = yr[64 * j]; ss += (v[j][0] * v[j][0] + v[j][1] * v[j][1]) + (v[j][2] * v[j][2] + v[j][3] * v[j][3]); }
    const float rstd = rsqrtf(wave_sum(ss) * (1.f / WC) + RMS_EPS);
#pragma unroll
    for (int j = 0; j < 4; ++j) { const int c = 4 * (lane + 64 * j); const v2u gw = *(const v2u*)(h + (size_t)t * INW + OFF_CG + c); const f32x4 nv = *(const f32x4*)(nrm + c);
        v2u o; o.x = pk2(v[j][0] * rstd * nv[0] * silu(bflo(gw.x)), v[j][1] * rstd * nv[1] * silu(bfhi(gw.x))); o.y = pk2(v[j][2] * rstd * nv[2] * silu(bflo(gw.y)), v[j][3] * rstd * nv[3] * silu(bfhi(gw.y)));
        *(v2u*)(mix + (size_t)t * DMIX + WA + WB + c) = o; }
}
__global__ void __launch_bounds__(256) k_ln(const float* __restrict__ y, const float* __restrict__ g, const float* __restrict__ bta, float* __restrict__ xo, bf16* __restrict__ xb) {
    const int lane = threadIdx.x & 63, wave = threadIdx.x >> 6, t = blockIdx.x * 4 + wave;
    const f32x4* yr = (const f32x4*)(y + (size_t)t * DM) + lane;
    f32x4 v[16]; float s = 0.f;
#pragma unroll
    for (int j = 0; j < 16; ++j) { v[j] = yr[64 * j]; s += (v[j][0] + v[j][1]) + (v[j][2] + v[j][3]); }
    const float mean = wave_sum(s) * (1.f / DM); float q = 0.f;
#pragma unroll
    for (int j = 0; j < 16; ++j) { v[j] = v[j] - mean; q += (v[j][0] * v[j][0] + v[j][1] * v[j][1]) + (v[j][2] * v[j][2] + v[j][3] * v[j][3]); }
    const float rstd = rsqrtf(wave_sum(q) * (1.f / DM) + LN_EPS);
#pragma unroll
    for (int j = 0; j < 16; ++j) { const int c = 4 * (lane + 64 * j); const f32x4 gv = *(const f32x4*)(g + c), bv = *(const f32x4*)(bta + c);
        const f32x4 o = v[j] * rstd * gv + bv; *(f32x4*)(xo + (size_t)t * DM + c) = o;
        if (xb) { v2u w; w.x = pk2(o[0], o[1]); w.y = pk2(o[2], o[3]); *(v2u*)(xb + (size_t)t * DM + c) = w; } }
}

extern "C" void kernel_launch(void* const* d_in, const int* in_sizes, int n_in, void* d_out, int out_size, void* d_ws, size_t ws_size, hipStream_t stream) {
    static int grid = 0;
    if (grid == 0) {
        if (n_in != 17 || in_sizes[0] != M * DM || out_size != M * DM || ws_size < WS_END) { fprintf(stderr, "kernel_launch: unexpected shapes/workspace (n_in %d, ws %zu)\n", n_in, ws_size); grid = -1; return; }
        int dev = 0, cus = 0; hipGetDevice(&dev); hipDeviceGetAttribute(&cus, hipDeviceAttributeMultiprocessorCount, dev);
        hipFuncSetAttribute((const void*)k_gemm<pg8::EpiBf16>, hipFuncAttributeMaxDynamicSharedMemorySize, pg8::STAGE_BYTES);
        hipFuncSetAttribute((const void*)k_gemm<pg8::EpiResF32>, hipFuncAttributeMaxDynamicSharedMemorySize, pg8::STAGE_BYTES);
        grid = cus > 0 ? cus : 256;
    }
    if (grid < 0) return;
    const float* x = (const float*)d_in[0]; const float* w_in = (const float*)d_in[1]; const float* conv_a_w = (const float*)d_in[2]; const float* sinks = (const float*)d_in[3];
    const float* conv_c_w = (const float*)d_in[4]; const float* conv_c_b = (const float*)d_in[5]; const float* gate_r_w = (const float*)d_in[6]; const float* gate_r_b = (const float*)d_in[7];
    const float* gate_i_w = (const float*)d_in[8]; const float* gate_i_b = (const float*)d_in[9]; const float* rg_lambda = (const float*)d_in[10];
    const float* norm_a = (const float*)d_in[11]; const float* norm_b = (const float*)d_in[12]; const float* norm_c = (const float*)d_in[13];
    const float* w_out = (const float*)d_in[14]; const float* ln_g = (const float*)d_in[15]; const float* ln_b = (const float*)d_in[16];
    unsigned char* ws = (unsigned char*)d_ws;
    bf16* win_t = (bf16*)(ws + WS_WIN); bf16* wout_t = (bf16*)(ws + WS_WOUT); bf16* xb = (bf16*)(ws + WS_XB); bf16* hb = (bf16*)(ws + WS_H); bf16* mix = (bf16*)(ws + WS_MIX);
    float* yb = (float*)(ws + WS_YB); float* abuf = (float*)(ws + WS_A); float* ubuf = (float*)(ws + WS_U); float* yc = (float*)(ws + WS_YC); float* ybuf = (float*)(ws + WS_Y); float* xcur = (float*)(ws + WS_XC);
    for (int l = 0; l < DEPTH; ++l) {
        k_convert_w<<<2048, 256, 0, stream>>>(w_in + (size_t)l * DM * INW, win_t + (size_t)l * WIN_L, DM, INW);
        k_convert_w<<<2048, 256, 0, stream>>>(w_out + (size_t)l * DMIX * DM, wout_t + (size_t)l * WOUT_L, DMIX, DM);
    }
    k_x_to_bf16<<<2048, 256, 0, stream>>>(x, xb, (size_t)M * DM / 8);
    for (int l = 0; l < DEPTH; ++l) {
        const float* xres = (l == 0) ? x : xcur;
        { pg8::Gemm g; g.A = xb; g.Bt = win_t + (size_t)l * WIN_L; g.M = M; g.N = INW; g.K = DM; g.pad = 0; pg8::EpiBf16 E; E.O = hb; E.ldc = INW; E.pad = 0;
          k_gemm<pg8::EpiBf16><<<grid, 512, pg8::STAGE_BYTES, stream>>>(g, E); }
        k_branch_a<<<M / 4, 256, 0, stream>>>(hb, conv_a_w + (size_t)l * 3 * WA, norm_a + (size_t)l * WA, mix);
        k_attn<<<NB * NKV * 64, 512, 0, stream>>>(hb, sinks + (size_t)l * NQH, yb);
        k_branch_b_fin<<<M / 4, 256, 0, stream>>>(hb, yb, norm_b + (size_t)l * WB, mix);
        k_rg_gates<<<8 * (M / 16), 256, 0, stream>>>(hb, conv_c_w + (size_t)l * 4 * WC, conv_c_b + (size_t)l * WC, gate_r_w + (size_t)l * 8 * 128 * 128, gate_r_b + (size_t)l * WC,
                                                    gate_i_w + (size_t)l * 8 * 128 * 128, gate_i_b + (size_t)l * WC, rg_lambda + (size_t)l * WC, abuf, ubuf);
        k_rg_scan<<<NB * 16, 512, 0, stream>>>(abuf, ubuf, yc);
        k_branch_c_fin<<<M / 4, 256, 0, stream>>>(hb, yc, norm_c + (size_t)l * WC, mix);
        { pg8::Gemm g; g.A = mix; g.Bt = wout_t + (size_t)l * WOUT_L; g.M = M; g.N = DM; g.K = DMIX; g.pad = 0; pg8::EpiResF32 E; E.X = xres; E.Y = ybuf; E.ldc = DM; E.alpha = ALPHA;
          k_gemm<pg8::EpiResF32><<<grid, 512, pg8::STAGE_BYTES, stream>>>(g, E); }
        k_ln<<<M / 4, 256, 0, stream>>>(ybuf, ln_g + (size_t)l * DM, ln_b + (size_t)l * DM, (l == DEPTH - 1) ? (float*)d_out : xcur, (l == DEPTH - 1) ? (bf16*)nullptr : xb);
    }
}
```

```cpp
#include <hip/hip_runtime.h>
#include <cstdio>
#include <cstdint>
namespace pg8 {
#define PG8_LAS __attribute__((address_space(3)))
typedef unsigned short bf16_t;
typedef short bf16x8 __attribute__((ext_vector_type(8)));
typedef float f32x4 __attribute__((ext_vector_type(4)));
typedef float f32x2 __attribute__((ext_vector_type(2)));
typedef unsigned u32x4 __attribute__((ext_vector_type(4)));
constexpr int BM = 256, BK = 64, HALF = 128, HTB = HALF * BK * 2  , STAGE_BYTES = 8 * HTB, NXCD = 8, WGM = 8;

__host__ __device__ __forceinline__ int lds_byte(int r, int c) { const int st = (r >> 4) * 2 + (c >> 5), rr = r & 15, cc = c & 31, ob = rr * 64 + cc * 2; return st * 1024 + (ob ^ (((ob >> 9) & 1) << 5)); }
__host__ __device__ __forceinline__ void stage_rc(int b, int& R, int& C) { const int st = b / 1024, sb = b % 1024, swz = sb ^ (((sb >> 9) & 1) << 5); R = (st >> 1) * 16 + swz / 64; C = (st & 1) * 32 + (swz % 64) / 2; }
__host__ __device__ __forceinline__ int perm32(int rho) { const int n = rho >> 4, i = rho & 15; return 8 * (i >> 2) + 4 * n + (i & 3); }

struct Unit { int pm, pn; };
struct Gemm { const bf16_t* A; const bf16_t* Bt; int M, N, K, ld; };

struct StaticOrder {
    int nM, nN, nwg, G, c;
    __host__ __device__ void init(int M, int N, int G_, int c_) { nM = M / BM; nN = N / BM; nwg = nM * nN; G = G_; c = c_; }
    __host__ __device__ bool next(int i, Unit& u) const {
        const long L = (long)i * G + c; if (L >= nwg) return false;
        int wgid = (int)L; { const int q = nwg / NXCD, r = nwg % NXCD, xcd = wgid % NXCD, off = wgid / NXCD; wgid = (xcd < r ? xcd * (q + 1) : r * (q + 1) + (xcd - r) * q) + off; }
        const int nig = WGM * nN, gid = wgid / nig, fm = gid * WGM, gsz = (nM - fm) < WGM ? (nM - fm) : WGM;
        u.pm = fm + ((wgid % nig) % gsz); u.pn = (wgid % nig) / gsz; return true;
    }
    __device__ __forceinline__ void a_ready(const Unit&) const {}
    __device__ __forceinline__ void done(const Unit&) const {}
};

struct OneUnit {
    int pm, pn, has;
    __host__ __device__ bool next(int i, Unit& u) const { if (i != 0 || !has) return false; u.pm = pm; u.pn = pn; return true; }
    __device__ __forceinline__ void a_ready(const Unit&) const {}
    __device__ __forceinline__ void done(const Unit&) const {}
};

__device__ __forceinline__ void fx_add(unsigned long long* p, float v) { atomicAdd(p, (unsigned long long)__float2ll_rn(v * 4294967296.f)); }
__device__ __forceinline__ float fx_get(const unsigned long long* p) { return (float)(long long)(*p) * 2.3283064365386963e-10f; }
__device__ __forceinline__ unsigned cvt_pk_bf16(float lo, float hi) { unsigned r; asm volatile("v_cvt_pk_bf16_f32 %0, %1, %2" : "=v"(r) : "v"(lo), "v"(hi)); return r; }

constexpr int TBL_ROW = 131072 + 2048;
constexpr int TBL_COL = TBL_ROW + 6 * 256 * 8;
struct EpiBf16LN {
    static constexpr bool PERM = true, AFTER_DRAIN = false, KSCALE = false;
    bf16_t* O; int ldc, pad;
    __device__ __forceinline__ void operator()(const f32x4 (&acc)[2][2][4][2], const Unit& u, int wr, int wc, int fr, int fq, int ui, PG8_LAS unsigned char* lds) const {
        const int row0 = u.pm * BM + wr * 64 + fr; const int col0 = u.pn * BM + wc * 32 + 8 * fq;
        const PG8_LAS f32x2* rt = (const PG8_LAS f32x2*)(lds + TBL_ROW) + ui * 256 + wr * 64 + fr;
        const PG8_LAS f32x4* ct = (const PG8_LAS f32x4*)(lds + TBL_COL + (ui * 256 + wc * 32 + 8 * fq) * 8);
        f32x4 cq[2][2][2];
#pragma unroll
        for (int bj = 0; bj < 2; ++bj)
#pragma unroll
            for (int n = 0; n < 2; ++n) { cq[bj][n][0] = ct[(bj * HALF + 4 * n) / 2]; cq[bj][n][1] = ct[(bj * HALF + 4 * n) / 2 + 1]; }
#pragma unroll
        for (int ai = 0; ai < 2; ++ai)
#pragma unroll
            for (int m = 0; m < 4; ++m) { bf16_t* rowp = O + (size_t)(row0 + ai * HALF + m * 16) * ldc + col0; const f32x2 ms = rt[ai * HALF + m * 16]; const float mu = ms.x, rs = ms.y;
#pragma unroll
                for (int bj = 0; bj < 2; ++bj) { float o[8];
#pragma unroll
                    for (int n = 0; n < 2; ++n) { const f32x4 v = acc[ai][bj][m][n];
                        o[4 * n + 0] = rs * (v[0] - mu * cq[bj][n][0][0]) + cq[bj][n][0][1]; o[4 * n + 1] = rs * (v[1] - mu * cq[bj][n][0][2]) + cq[bj][n][0][3];
                        o[4 * n + 2] = rs * (v[2] - mu * cq[bj][n][1][0]) + cq[bj][n][1][1]; o[4 * n + 3] = rs * (v[3] - mu * cq[bj][n][1][2]) + cq[bj][n][1][3]; }
                    u32x4 w; w.x = cvt_pk_bf16(o[0], o[1]); w.y = cvt_pk_bf16(o[2], o[3]); w.z = cvt_pk_bf16(o[4], o[5]); w.w = cvt_pk_bf16(o[6], o[7]);
                    *(u32x4*)(rowp + bj * HALF) = w; } }
    }
};
struct EpiResLN {
    static constexpr bool PERM = true, AFTER_DRAIN = false, KSCALE = true;
    static constexpr int KS1 = 16, KS2 = 48;
    bf16_t* Yb; unsigned long long* st; float alpha; int ldb;
    __device__ __forceinline__ void kscale(f32x4 (&acc)[2][2][4][2], int ui, int which, int wr, int fr, PG8_LAS unsigned char* lds) const {
        const PG8_LAS f32x4* tbl = (const PG8_LAS f32x4*)(lds + TBL_ROW) + ui * 256 + wr * 64 + fr;
#pragma unroll
        for (int ai = 0; ai < 2; ++ai)
#pragma unroll
            for (int m = 0; m < 4; ++m) { const f32x4 fv = tbl[ai * HALF + m * 16]; const float f = which ? fv[1] : fv[0];
#pragma unroll
                for (int bj = 0; bj < 2; ++bj)
#pragma unroll
                    for (int n = 0; n < 2; ++n) acc[ai][bj][m][n] = acc[ai][bj][m][n] * f; }
    }
    static __device__ __forceinline__ float lo16(unsigned w) { return __builtin_bit_cast(float, w << 16); }
    static __device__ __forceinline__ float hi16(unsigned w) { return __builtin_bit_cast(float, w & 0xffff0000u); }
    __device__ __forceinline__ void operator()(const f32x4 (&acc)[2][2][4][2], const Unit& u, int wr, int wc, int fr, int fq, int ui, PG8_LAS unsigned char* lds) const {
        const int row0 = u.pm * BM + wr * 64 + fr, col0 = u.pn * BM + wc * 32 + 8 * fq;
        const PG8_LAS f32x4* rt = (const PG8_LAS f32x4*)(lds + TBL_ROW) + ui * 256 + wr * 64 + fr;
        const PG8_LAS f32x4* ct = (const PG8_LAS f32x4*)(lds + TBL_COL + (ui * 256 + wc * 32 + 8 * fq) * 8);
        u32x4 A0[4][2];
#define EPI_LOAD(buf, stg) do { _Pragma("unroll") for (int bj_ = 0; bj_ < 2; ++bj_) { const int row_ = row0 + ((stg) >> 2) * HALF + ((stg) & 3) * 16; \
            A0[buf][bj_] = *(const u32x4*)(Yb + (size_t)row_ * ldb + col0 + bj_ * HALF); } } while (0)
        EPI_LOAD(0, 0); EPI_LOAD(1, 1); EPI_LOAD(2, 2);
        float sq[2][2];
#pragma unroll
        for (int stg = 0; stg < 8; ++stg) {
            const int ai = stg >> 2, m = stg & 3, mi = m & 1;
            if (stg + 3 < 8) { if (((stg + 3) & 3) == 0) EPI_LOAD(0, stg + 3); else if (((stg + 3) & 3) == 1) EPI_LOAD(1, stg + 3); else if (((stg + 3) & 3) == 2) EPI_LOAD(2, stg + 3); else EPI_LOAD(3, stg + 3); }
            asm volatile("" ::: "memory");
            { const int row = row0 + ai * HALF + m * 16; const f32x4 tv = rt[ai * HALF + m * 16]; const float mu = tv[2], rs = tv[3];
                float s = 0.f, q = 0.f;
#pragma unroll
                for (int bj = 0; bj < 2; ++bj) { const size_t oh = (size_t)row * ldb + col0 + bj * HALF;
                    const u32x4 w0 = ((stg & 3) == 0) ? A0[0][bj] : (((stg & 3) == 1) ? A0[1][bj] : (((stg & 3) == 2) ? A0[2][bj] : A0[3][bj]));
                    float xr[8];
#pragma unroll
                    for (int j = 0; j < 4; ++j) { const float ye = lo16(w0[j]), yo = hi16(w0[j]);
                        const f32x4 gb = ct[(bj * HALF) / 2 + j];
                        xr[2 * j] = (ye - mu) * rs * gb[0] + gb[1]; xr[2 * j + 1] = (yo - mu) * rs * gb[2] + gb[3]; }
                    float y[8];
#pragma unroll
                    for (int j = 0; j < 4; ++j) { y[j] = xr[j] * alpha + acc[ai][bj][m][0][j]; y[4 + j] = xr[4 + j] * alpha + acc[ai][bj][m][1][j]; }
#pragma unroll
                    for (int j = 0; j < 8; ++j) { s += y[j]; q += y[j] * y[j]; }
                    u32x4 hn;
#pragma unroll
                    for (int j = 0; j < 4; ++j) hn[j] = cvt_pk_bf16(y[2 * j], y[2 * j + 1]);
                    *(u32x4*)(Yb + oh) = hn; }
                s += __shfl_xor(s, 16); s += __shfl_xor(s, 32); q += __shfl_xor(q, 16); q += __shfl_xor(q, 32);
                sq[mi][0] = s; sq[mi][1] = q; }
            if (mi == 1) {
                const int mi2 = fq >> 1, wh = fq & 1; const int row = row0 + ai * HALF + ((m & 2) + mi2) * 16;
                const float v = mi2 ? (wh ? sq[1][1] : sq[1][0]) : (wh ? sq[0][1] : sq[0][0]);
                fx_add(st + 2 * (size_t)row + wh, v); }
        }
#undef EPI_LOAD
    }
};

template <class Epi, class Sched, bool ALIGN_EPI = false, bool SP2 = false>
__device__ __forceinline__ void gemm_phase(PG8_LAS unsigned char* lds, const Gemm g, const Sched& S, const Epi& E, const int tid) {
    const int wid = __builtin_amdgcn_readfirstlane(tid >> 6), lane = tid & 63, wr = wid >> 2, wc = wid & 3, fr = lane & 15, fq = lane >> 4;
    const int K = g.ld, nt = g.K / BK;
    unsigned voffA[2], voffB[2];
#pragma unroll
    for (int i = 0; i < 2; ++i) { int R, C; stage_rc(tid * 16 + i * 8192, R, C); const int Rb = Epi::PERM ? ((R & ~31) + perm32(R & 31)) : R;
        voffA[i] = (unsigned)(R * K + C) * 2u; voffB[i] = (unsigned)(Rb * K + C) * 2u; }
    const size_t kstep = (size_t)(BK * 2);
    const size_t hstep = (size_t)HALF * K * 2;
    const size_t tstep = 2 * hstep;
    const unsigned ldsw = (unsigned)wid * 1024u;
    const int aoff = lds_byte(wr * 64 + fr, fq * 8), boff = lds_byte(wc * 32 + fr, fq * 8);
#define PG8_SA(b, h) (((b) * 2 + (h)) * HTB)
#define PG8_SB(b, h) ((4 + (b) * 2 + (h)) * HTB)
#define PG8_STAGE(bufoff, gbase, voff) do { _Pragma("unroll") for (int _i = 0; _i < 2; ++_i) \
        __builtin_amdgcn_global_load_lds((const unsigned*)((const char*)(gbase) + (voff)[_i]), (PG8_LAS unsigned*)(lds + (bufoff) + ldsw + _i * 8192), 16, 0, 0); } while (0)
#define PG8_LDA(dst, b, h) do { _Pragma("unroll") for (int m = 0; m < 4; ++m) _Pragma("unroll") for (int k = 0; k < 2; ++k) dst[m][k] = *(const PG8_LAS bf16x8*)(lds + PG8_SA(b, h) + aoff + m * 2048 + k * 1024); } while (0)
#define PG8_LDB(dst, b, h) do { _Pragma("unroll") for (int n = 0; n < 2; ++n) _Pragma("unroll") for (int k = 0; k < 2; ++k) dst[n][k] = *(const PG8_LAS bf16x8*)(lds + PG8_SB(b, h) + boff + n * 2048 + k * 1024); } while (0)
#define PG8_MMA(ai, bj, At, Bt) do { __builtin_amdgcn_s_setprio(1); _Pragma("unroll") for (int m = 0; m < 4; ++m) _Pragma("unroll") for (int n = 0; n < 2; ++n) _Pragma("unroll") for (int k = 0; k < 2; ++k) \
        acc[ai][bj][m][n] = __builtin_amdgcn_mfma_f32_16x16x32_bf16(Bt[n][k], At[m][k], acc[ai][bj][m][n], 0, 0, 0); __builtin_amdgcn_s_setprio(0); } while (0)
#define PG8_WAIT_V(n) asm volatile("s_waitcnt vmcnt(" #n ")" ::: "memory")
#define PG8_WAIT_L(n) asm volatile("s_waitcnt lgkmcnt(" #n ")" ::: "memory")
#define PG8_BAR __builtin_amdgcn_s_barrier()
#define PG8_SCHED __builtin_amdgcn_sched_barrier(0)
    Unit cur, nxt; int ui = 0;
    if (!S.next(0, cur)) return;
    f32x4 acc[2][2][4][2];
#pragma unroll
    for (int a = 0; a < 2; ++a)
#pragma unroll
        for (int b = 0; b < 2; ++b)
#pragma unroll
            for (int m = 0; m < 4; ++m)
#pragma unroll
                for (int n = 0; n < 2; ++n) acc[a][b][m][n] = (f32x4){0.f, 0.f, 0.f, 0.f};
    bf16x8 At[4][2], B0[2][2], B1[2][2];
    const char* cA = (const char*)g.A + (size_t)cur.pm * tstep; const char* cB = (const char*)g.Bt + (size_t)cur.pn * tstep;
    S.a_ready(cur);
    if constexpr (SP2) {
        PG8_STAGE(PG8_SB(0, 0), cB, voffB); PG8_STAGE(PG8_SB(0, 1), cB + hstep, voffB); PG8_STAGE(PG8_SA(0, 0), cA, voffA); PG8_STAGE(PG8_SA(0, 1), cA + hstep, voffA);
        if (wr == 1) PG8_BAR;
        PG8_WAIT_V(2); PG8_BAR;
        PG8_STAGE(PG8_SB(1, 0), cB + kstep, voffB); PG8_STAGE(PG8_SA(1, 0), cA + kstep, voffA); PG8_STAGE(PG8_SB(1, 1), cB + hstep + kstep, voffB);
        PG8_WAIT_V(6); PG8_BAR;
    } else {
        PG8_STAGE(PG8_SB(0, 0), cB, voffB); PG8_STAGE(PG8_SA(0, 0), cA, voffA); PG8_STAGE(PG8_SB(0, 1), cB + hstep, voffB); PG8_STAGE(PG8_SA(0, 1), cA + hstep, voffA);
        if (wr == 1) PG8_BAR;
        PG8_WAIT_V(4); PG8_BAR;
        PG8_STAGE(PG8_SB(1, 0), cB + kstep, voffB); PG8_STAGE(PG8_SA(1, 0), cA + kstep, voffA); PG8_STAGE(PG8_SB(1, 1), cB + hstep + kstep, voffB);
        PG8_WAIT_V(6); PG8_BAR;
    }
    for (;;) {
        const bool has_next = S.next(ui + 1, nxt);
        const char* nA = has_next ? (const char*)g.A + (size_t)nxt.pm * tstep : cA; const char* nB = has_next ? (const char*)g.Bt + (size_t)nxt.pn * tstep : cB;
        for (int t = 0; t < nt; t += 2) {
            const bool last = (t == nt - 2);
            const char* a1 = cA + (size_t)(t + 1) * kstep;
            const char* a2 = last ? nA : cA + (size_t)(t + 2) * kstep; const char* b2 = last ? nB : cB + (size_t)(t + 2) * kstep;
            const char* a3 = a2 + kstep; const char* b3 = b2 + kstep;
            if (last && has_next) S.a_ready(nxt);
            if constexpr (Epi::KSCALE) { if (t == Epi::KS1 || t == Epi::KS2) E.kscale(acc, ui, t == Epi::KS1 ? 0 : 1, wr, fr, lds); }
            if constexpr (SP2) {
            PG8_LDB(B0, 0, 0); PG8_LDB(B1, 0, 1); PG8_SCHED; PG8_LDA(At, 0, 0); PG8_STAGE(PG8_SA(1, 1), a1 + hstep, voffA);
            PG8_WAIT_V(8); PG8_WAIT_L(0); PG8_BAR; PG8_MMA(0, 0, At, B0); PG8_MMA(0, 1, At, B1); PG8_BAR; PG8_SCHED;
            PG8_LDA(At, 0, 1); PG8_STAGE(PG8_SB(0, 0), b2, voffB); PG8_STAGE(PG8_SB(0, 1), b2 + hstep, voffB); PG8_STAGE(PG8_SA(0, 0), a2, voffA);
            PG8_WAIT_V(8); PG8_WAIT_L(0); PG8_BAR; PG8_MMA(1, 0, At, B0); PG8_MMA(1, 1, At, B1); PG8_BAR; PG8_SCHED;
            PG8_LDB(B0, 1, 0); PG8_LDB(B1, 1, 1); PG8_SCHED; PG8_LDA(At, 1, 0); PG8_STAGE(PG8_SA(0, 1), a2 + hstep, voffA);
            PG8_WAIT_V(8); PG8_WAIT_L(0); PG8_BAR; PG8_MMA(0, 0, At, B0); PG8_MMA(0, 1, At, B1); PG8_BAR; PG8_SCHED;
            PG8_LDA(At, 1, 1); PG8_STAGE(PG8_SB(1, 0), b3, voffB); PG8_STAGE(PG8_SB(1, 1), b3 + hstep, voffB); PG8_STAGE(PG8_SA(1, 0), a3, voffA);
            PG8_WAIT_V(8); PG8_WAIT_L(0); PG8_BAR; PG8_MMA(1, 0, At, B0); PG8_MMA(1, 1, At, B1); PG8_BAR; PG8_SCHED;
            } else {
            PG8_LDB(B0, 0, 0); PG8_SCHED; PG8_LDA(At, 0, 0); PG8_STAGE(PG8_SA(1, 1), a1 + hstep, voffA);
            PG8_WAIT_L(8); PG8_BAR; PG8_WAIT_L(0); PG8_MMA(0, 0, At, B0); PG8_BAR; PG8_SCHED;
            PG8_LDB(B1, 0, 1); PG8_STAGE(PG8_SB(0, 0), b2, voffB);
            PG8_BAR; PG8_WAIT_L(0); PG8_MMA(0, 1, At, B1); PG8_BAR;
            PG8_LDA(At, 0, 1); PG8_STAGE(PG8_SA(0, 0), a2, voffA);
            PG8_BAR; PG8_WAIT_L(0); PG8_MMA(1, 0, At, B0); PG8_BAR; PG8_SCHED;
            PG8_STAGE(PG8_SB(0, 1), b2 + hstep, voffB);
            PG8_WAIT_V(6); PG8_BAR; PG8_MMA(1, 1, At, B1); PG8_BAR;
            PG8_LDB(B0, 1, 0); PG8_SCHED; PG8_LDA(At, 1, 0); PG8_STAGE(PG8_SA(0, 1), a2 + hstep, voffA);
            PG8_WAIT_L(8); PG8_BAR; PG8_WAIT_L(0); PG8_MMA(0, 0, At, B0); PG8_BAR; PG8_SCHED;
            PG8_LDB(B1, 1, 1); PG8_STAGE(PG8_SB(1, 0), b3, voffB);
            PG8_BAR; PG8_WAIT_L(0); PG8_MMA(0, 1, At, B1); PG8_BAR;
            PG8_LDA(At, 1, 1); PG8_STAGE(PG8_SA(1, 0), a3, voffA);
            PG8_BAR; PG8_WAIT_L(0); PG8_MMA(1, 0, At, B0); PG8_BAR; PG8_SCHED;
            PG8_STAGE(PG8_SB(1, 1), b3 + hstep, voffB);
            PG8_WAIT_V(6); PG8_BAR; PG8_MMA(1, 1, At, B1); PG8_BAR;
            }
        }
        if constexpr (ALIGN_EPI) { if (wr == 0) PG8_BAR; }
        if constexpr (!Epi::AFTER_DRAIN) { E(acc, cur, wr, wc, fr, fq, ui, lds); S.done(cur); }
        if (!has_next) break;
#pragma unroll
        for (int a = 0; a < 2; ++a)
#pragma unroll
            for (int b = 0; b < 2; ++b)
#pragma unroll
                for (int m = 0; m < 4; ++m)
#pragma unroll
                    for (int n = 0; n < 2; ++n) acc[a][b][m][n] = (f32x4){0.f, 0.f, 0.f, 0.f};
        cur = nxt; cA = nA; cB = nB; ++ui;
        if constexpr (ALIGN_EPI) { if (wr == 1) PG8_BAR; }
    }
    PG8_WAIT_V(0);
    if constexpr (!ALIGN_EPI) { if (wr == 0) PG8_BAR; }
    PG8_BAR;
    if constexpr (Epi::AFTER_DRAIN) { E.fused(acc, cur, wr, wc, fr, fq, lds, wid, lane); S.done(cur); }
#undef PG8_SA
#undef PG8_SB
#undef PG8_STAGE
#undef PG8_LDA
#undef PG8_LDB
#undef PG8_MMA
#undef PG8_WAIT_V
#undef PG8_WAIT_L
#undef PG8_BAR
#undef PG8_SCHED
}
}

typedef unsigned short bf16;
typedef unsigned v4u __attribute__((ext_vector_type(4)));
typedef unsigned v2u __attribute__((ext_vector_type(2)));
typedef float f32x4 __attribute__((ext_vector_type(4)));
constexpr int DM = 4096, NB = 4, SEQ = 2048, M = NB * SEQ, DEPTH = 4;
constexpr int WA = 1024, WB = 2048, WC = 1024, DMIX = 4096, HD = 64, NQH = 32, KVG = 8, NKV = 4;
constexpr int INW = 10752;
constexpr int LDK = 4096 + 64;
constexpr int OFF_AB = 0, OFF_AC = 1024, OFF_AX = 2048, OFF_AG = 3072, OFF_Q = 4096, OFF_K = 6144, OFF_V = 6400, OFF_BG = 6656, OFF_CX = 8704, OFF_CG = 9728;
constexpr int MIX_C = 0, MIX_B = 1024, MIX_A = 3072;
constexpr size_t CTL_SS = 65536;
constexpr size_t CTL_BYTES = 3u << 20, CTL_GR = 2u << 20;
constexpr size_t WS_WG = 8u << 20;
constexpr size_t CTL_GV = CTL_SS + (size_t)DEPTH * 2 * M * 8, CTL_BV = CTL_GV + (size_t)DEPTH * INW * 8, CTL_ST = CTL_BV + (size_t)DEPTH * INW * 8;
static_assert(CTL_ST + (size_t)DEPTH * M * 2 * 8 <= CTL_GR, "CTL map");
typedef unsigned long long fx_t;
constexpr size_t CTL_Q = 4096;
constexpr float ALPHA = 1.6817928305074290861f;
constexpr float LN_EPS = 1e-5f, RMS_EPS = 1e-6f;
constexpr size_t MiB = 1u << 20;
constexpr size_t WS_CTL = 0, WS_WIN = 16 * MiB, WS_WOUT = 360 * MiB, WS_XB = 492 * MiB, WS_H = 558 * MiB, WS_MIX = 726 * MiB, WS_Y = 792 * MiB, WS_END = 920 * MiB;
constexpr size_t WIN_L = (size_t)INW * LDK, WOUT_L = (size_t)DM * LDK;

__device__ __forceinline__ unsigned f2bf(float f) { unsigned u = __builtin_bit_cast(unsigned, f); return (u + 0x7fffu + ((u >> 16) & 1u)) >> 16; }
__device__ __forceinline__ unsigned pk2(float lo, float hi) { return f2bf(lo) | (f2bf(hi) << 16); }
__device__ __forceinline__ float bf2f(unsigned short b) { return __builtin_bit_cast(float, (unsigned)b << 16); }
__device__ __forceinline__ float bflo(unsigned w) { return __builtin_bit_cast(float, w << 16); }
__device__ __forceinline__ float bfhi(unsigned w) { return __builtin_bit_cast(float, w & 0xffff0000u); }
__device__ __forceinline__ float wave_sum(float v) {
#pragma unroll
    for (int o = 1; o < 64; o <<= 1) v += __shfl_xor(v, o);
    return v;
}
__device__ __forceinline__ float wave_max(float v) {
#pragma unroll
    for (int o = 1; o < 64; o <<= 1) v = fmaxf(v, __shfl_xor(v, o));
    return v;
}
__device__ __forceinline__ float silu(float x) { return x * __builtin_amdgcn_rcpf(1.f + __builtin_amdgcn_exp2f(x * -1.44269504088896341f)); }
__device__ __forceinline__ float sigmoidf(float x) { return 1.f / (1.f + __expf(-x)); }
#define LDS_WAIT() asm volatile("s_waitcnt lgkmcnt(0)" ::: "memory")

static_assert(WS_WIN + DEPTH * WIN_L * 2 <= WS_WOUT && WS_WOUT + DEPTH * WOUT_L * 2 <= WS_XB && WS_XB + (size_t)M * LDK * 2 <= WS_H && WS_H + (size_t)M * INW * 2 <= WS_MIX && WS_MIX + (size_t)M * LDK * 2 <= WS_Y && WS_Y + (size_t)M * DM * 4 <= WS_END, "workspace map");
#define XB_TMO      128
#define XB_XCNT(j)  (256  + 64 * (j))
#define XB_XSUB(j)  (1280 + 64 * (j))
#define XB_XGEN(j)  (2304 + 64 * (j))
#define XB_TOP      3328
#define XB_TOPGEN   3392
#define XCD_BAR_WORDS 3456
#define XB_SPIN_CAP (1u << 18)
#define LAS __attribute__((address_space(3)))

__device__ __forceinline__ unsigned xb_ld(unsigned* p)              { return __hip_atomic_load(p, __ATOMIC_RELAXED, __HIP_MEMORY_SCOPE_AGENT); }
__device__ __forceinline__ unsigned xb_add(unsigned* p, unsigned v) { return __hip_atomic_fetch_add(p, v, __ATOMIC_RELAXED, __HIP_MEMORY_SCOPE_AGENT); }
__device__ __forceinline__ unsigned xb_xcc_id() { return (unsigned)__builtin_amdgcn_s_getreg((3 << 11) | 20) & 0xFu; }
#define XB_SPIN(cond, bar) do { unsigned _sp = 0; while (cond) { __builtin_amdgcn_s_sleep(1); \
    if ((++_sp & 255u) == 0u) { if (xb_ld(&(bar)[XB_TMO])) break; if (_sp > XB_SPIN_CAP) { atomicAdd(&(bar)[XB_TMO], 1u); break; } } } } while (0)

struct XcdBarrier {
    unsigned* bar; unsigned x;
    volatile LAS unsigned* st;
};

__device__ __forceinline__ XcdBarrier xcd_barrier_post(unsigned* bar, volatile LAS unsigned* st) {
    XcdBarrier b; b.bar = bar; b.x = xb_xcc_id(); b.st = st;
    if (threadIdx.x == 0) (void)xb_add(&bar[XB_XCNT(b.x)], 1u);
    return b;
}
__device__ __forceinline__ void xcd_barrier_complete(unsigned* bar, unsigned x, unsigned& nloc, unsigned& nx) {
    const unsigned G = gridDim.x * gridDim.y * gridDim.z;
    unsigned sum, cnt, mine, sp = 0u;
    for (;;) {
        sum = 0u; cnt = 0u; mine = 0u;
#pragma unroll
        for (unsigned j = 0; j < 16; ++j) { const unsigned c = xb_ld(&bar[XB_XCNT(j)]); sum += c; cnt += (c > 0u) ? 1u : 0u; mine = (j == x) ? c : mine; }
        if (sum == G) break;
        __builtin_amdgcn_s_sleep(1);
        if ((++sp & 255u) == 0u) { if (xb_ld(&bar[XB_TMO])) break; if (sp > XB_SPIN_CAP) { atomicAdd(&bar[XB_TMO], 1u); break; } }
    }
    nloc = mine > 0u ? mine : 1u; nx = cnt > 0u ? cnt : 1u;
}

__device__ __forceinline__ void xcd_barrier(const XcdBarrier& b) {
    asm volatile("s_waitcnt vmcnt(0)" ::: "memory");
    __syncthreads();
    if (threadIdx.x == 0) {
        unsigned* bar = b.bar;
        __builtin_amdgcn_s_waitcnt(0);
        unsigned nloc = b.st[0], nx = b.st[1];
        if (nloc == 0u) { xcd_barrier_complete(bar, b.x, nloc, nx); b.st[0] = nloc; b.st[1] = nx; }
        const unsigned old = xb_add(&bar[XB_XSUB(b.x)], 1u);
        const unsigned gen = old / nloc;
        if (old + 1u == (gen + 1u) * nloc) {
            __builtin_amdgcn_fence(__ATOMIC_RELEASE, "agent");
            asm volatile("s_waitcnt vmcnt(0)" ::: "memory");
            const unsigned og = xb_add(&bar[XB_TOP], 1u);
            const unsigned tg = og / nx;
            if (og + 1u == (tg + 1u) * nx) xb_add(&bar[XB_TOPGEN], 1u);
            else XB_SPIN(xb_ld(&bar[XB_TOPGEN]) == tg, bar);
            __builtin_amdgcn_fence(__ATOMIC_ACQUIRE, "agent");
            xb_add(&bar[XB_XGEN(b.x)], 1u);
            asm volatile("s_waitcnt vmcnt(0)" ::: "memory");
        } else {
            XB_SPIN(xb_ld(&bar[XB_XGEN(b.x)]) == gen, bar);
            __builtin_amdgcn_fence(__ATOMIC_ACQUIRE, "agent");
            asm volatile("s_waitcnt vmcnt(0)" ::: "memory");
        }
    }
    __syncthreads();
}
constexpr int NWAVES = 8, NTHR = 512;
constexpr int LDS_MISC = 131072 + 320, LDS_BYTES = 163840;
#define VM_WAIT() asm volatile("s_waitcnt vmcnt(0)" ::: "memory")

template <bool KPERM, bool GFOLD> __device__ __forceinline__ void convert_task(const float* __restrict__ W, bf16* __restrict__ WT, int ldt, int N, LAS float* scr, int nb, int kb0, int nkb, int lane,
                                                                               const float* __restrict__ gvec, const float* __restrict__ bvec, fx_t* __restrict__ Gout, fx_t* __restrict__ Bout) {
    const int n0 = 64 * nb, c = lane & 7, nr = lane >> 3;
    const __amdgpu_buffer_rsrc_t rsW = __builtin_amdgcn_make_buffer_rsrc((void*)W, (short)0, 0x7ffffff0, 0x00020000);
    float gacc[8], bacc[8];
#pragma unroll
    for (int j = 0; j < 8; ++j) { gacc[j] = 0.f; bacc[j] = 0.f; }
    for (int kb = kb0; kb < kb0 + nkb; ++kb) {
        const int k0 = 64 * kb;
        const int ks = KPERM ? (k0 < 1024 ? k0 + 3072 : (k0 < 3072 ? k0 : k0 - 3072)) : k0;
        const int kr = lane >> 4, cq = lane & 15;
        const int voff = (kr * N + 4 * cq) * 4;
        f32x4 r[16];
#pragma unroll
        for (int i = 0; i < 16; ++i) r[i] = __builtin_bit_cast(f32x4, __builtin_amdgcn_raw_buffer_load_b128(rsW, voff, ((ks + 4 * i) * N + n0) * 4, 2));
#pragma unroll
        for (int i = 0; i < 16; ++i) { const int row = 4 * i + kr; *(LAS f32x4*)(scr + row * 64 + ((4 * cq) ^ (8 * (row >> 3)))) = r[i]; }
        LDS_WAIT();
        float gk[8], bk[8];
        if (GFOLD) { const f32x4 g0 = *(const f32x4*)(gvec + k0 + 8 * c), g1 = *(const f32x4*)(gvec + k0 + 8 * c + 4), b0 = *(const f32x4*)(bvec + k0 + 8 * c), b1 = *(const f32x4*)(bvec + k0 + 8 * c + 4);
#pragma unroll
            for (int e = 0; e < 4; ++e) { gk[e] = g0[e]; gk[4 + e] = g1[e]; bk[e] = b0[e]; bk[4 + e] = b1[e]; } }
#pragma unroll
        for (int j = 0; j < 8; ++j) { const int n = nr + 8 * j; const LAS float* s = scr + (8 * c) * 64 + (n ^ (8 * c));
            float v[8];
#pragma unroll
            for (int e = 0; e < 8; ++e) { v[e] = s[e * 64]; if (GFOLD) { bacc[j] += bk[e] * v[e]; v[e] *= gk[e]; } }
            v4u o; o.x = pk2(v[0], v[1]); o.y = pk2(v[2], v[3]); o.z = pk2(v[4], v[5]); o.w = pk2(v[6], v[7]);
            *(v4u*)(WT + (size_t)(n0 + n) * ldt + k0 + 8 * c) = o;
            if (GFOLD) gacc[j] += ((bflo(o.x) + bfhi(o.x)) + (bflo(o.y) + bfhi(o.y))) + ((bflo(o.z) + bfhi(o.z)) + (bflo(o.w) + bfhi(o.w))); }
        LDS_WAIT();
    }
    if (GFOLD) {
#pragma unroll
        for (int j = 0; j < 8; ++j) { float gp = gacc[j], bp = bacc[j];
            gp += __shfl_xor(gp, 1); gp += __shfl_xor(gp, 2); gp += __shfl_xor(gp, 4); bp += __shfl_xor(bp, 1); bp += __shfl_xor(bp, 2); bp += __shfl_xor(bp, 4);
            if (c == 0) { pg8::fx_add(Gout + n0 + nr + 8 * j, gp); pg8::fx_add(Bout + n0 + nr + 8 * j, bp); } } }
}
constexpr int CV_NK = 2, CV_KQ = DM / 64 / CV_NK, CV_T_IN = (INW / 64) * CV_KQ, CV_T_OUT = (DM / 64) * CV_KQ, CV_T_L = CV_T_IN + CV_T_OUT;
__device__ __forceinline__ void convert_layer(const float* __restrict__ w_in, const float* __restrict__ w_out, const float* __restrict__ ln_g, const float* __restrict__ ln_b, unsigned char* ws, int ll, LAS float* scr, int wv, int nwv, int lane) {
    for (int r = wv; r < CV_T_L; r += nwv) {
        if (r < CV_T_IN) { const int kq = r % CV_KQ, nb = r / CV_KQ;
            if (ll == 0) convert_task<false, false>(w_in, (bf16*)(ws + WS_WIN), LDK, INW, scr, nb, kq * CV_NK, CV_NK, lane, nullptr, nullptr, nullptr, nullptr);
            else convert_task<false, true>(w_in + (size_t)ll * DM * INW, (bf16*)(ws + WS_WIN) + (size_t)ll * WIN_L, LDK, INW, scr, nb, kq * CV_NK, CV_NK, lane, ln_g + (size_t)(ll - 1) * DM, ln_b + (size_t)(ll - 1) * DM,
                                                (fx_t*)(ws + WS_CTL + CTL_GV) + (size_t)ll * INW, (fx_t*)(ws + WS_CTL + CTL_BV) + (size_t)ll * INW); }
        else { const int r2 = r - CV_T_IN, kq = r2 % CV_KQ, nb = r2 / CV_KQ;
            convert_task<true, false>(w_out + (size_t)ll * DMIX * DM, (bf16*)(ws + WS_WOUT) + (size_t)ll * WOUT_L, LDK, DM, scr, nb, kq * CV_NK, CV_NK, lane, nullptr, nullptr, nullptr, nullptr); }
    }
}

__device__ __forceinline__ void branch_a_pair(const bf16* __restrict__ h, const float* __restrict__ cw, const float* __restrict__ nrm, bf16* __restrict__ mix, int t0, int lane) {
    const int s0 = t0 % SEQ;
    const bf16* hr = h + (size_t)t0 * INW;
    float y[2][16], ss[2] = {0.f, 0.f}; v4u agk[2][2];
#pragma unroll
    for (int j = 0; j < 2; ++j) {
        const int ch0 = j * 512 + lane * 8;
        v4u cr[4], xr[4], ab[2];
#pragma unroll
        for (int i = 0; i < 4; ++i) { cr[i] = (v4u){0u, 0u, 0u, 0u}; xr[i] = (v4u){0u, 0u, 0u, 0u};
            if (i >= 2 || s0 > 0) { cr[i] = *(const v4u*)(hr + (long)(i - 2) * INW + OFF_AC + ch0); xr[i] = *(const v4u*)(hr + (long)(i - 2) * INW + OFF_AX + ch0); } }
#pragma unroll
        for (int i = 0; i < 2; ++i) { ab[i] = *(const v4u*)(hr + (size_t)i * INW + OFF_AB + ch0); agk[i][j] = *(const v4u*)(hr + (size_t)i * INW + OFF_AG + ch0); }
        float w0[8], w1[8], w2[8];
        { const f32x4 a0 = *(const f32x4*)(cw + ch0), a1 = *(const f32x4*)(cw + ch0 + 4), b0 = *(const f32x4*)(cw + 1024 + ch0), b1 = *(const f32x4*)(cw + 1024 + ch0 + 4),
                      c0 = *(const f32x4*)(cw + 2048 + ch0), c1 = *(const f32x4*)(cw + 2048 + ch0 + 4);
#pragma unroll
          for (int e = 0; e < 4; ++e) { w0[e] = a0[e]; w0[4 + e] = a1[e]; w1[e] = b0[e]; w1[4 + e] = b1[e]; w2[e] = c0[e]; w2[4 + e] = c1[e]; } }
        float p[4][8];
#pragma unroll
        for (int i = 0; i < 4; ++i)
#pragma unroll
            for (int e = 0; e < 8; ++e) { const int w = e >> 1; p[i][e] = (e & 1) ? bfhi(cr[i][w]) * bfhi(xr[i][w]) : bflo(cr[i][w]) * bflo(xr[i][w]); }
#pragma unroll
        for (int i = 0; i < 2; ++i)
#pragma unroll
            for (int e = 0; e < 8; ++e) { const int w = e >> 1;
                const float cv = w0[e] * p[i][e] + w1[e] * p[i + 1][e] + w2[e] * p[i + 2][e];
                const float yv = ((e & 1) ? bfhi(ab[i][w]) : bflo(ab[i][w])) * cv; y[i][j * 8 + e] = yv; ss[i] += yv * yv; }
    }
#pragma unroll
    for (int i = 0; i < 2; ++i) { const float rstd = rsqrtf(wave_sum(ss[i]) * (1.f / WA) + RMS_EPS);
#pragma unroll
        for (int j = 0; j < 2; ++j) { const int ch0 = j * 512 + lane * 8; const f32x4 n0 = *(const f32x4*)(nrm + ch0), n1 = *(const f32x4*)(nrm + ch0 + 4); const v4u ag = agk[i][j]; float ov[8];
#pragma unroll
            for (int e = 0; e < 8; ++e) { const int w = e >> 1; ov[e] = y[i][j * 8 + e] * rstd * ((e < 4) ? n0[e & 3] : n1[e & 3]) * silu((e & 1) ? bfhi(ag[w]) : bflo(ag[w])); }
            v4u o; o.x = pk2(ov[0], ov[1]); o.y = pk2(ov[2], ov[3]); o.z = pk2(ov[4], ov[5]); o.w = pk2(ov[6], ov[7]);
            *(v4u*)(mix + (size_t)(t0 + i) * LDK + MIX_A + ch0) = o; } }
}
typedef short s16x8 __attribute__((ext_vector_type(8)));
typedef float f32x16 __attribute__((ext_vector_type(16)));
typedef __bf16 bf16x2_t __attribute__((ext_vector_type(2)));
typedef float f32x2_t __attribute__((ext_vector_type(2)));
__device__ __forceinline__ unsigned cvtpk(float lo, float hi) { const f32x2_t v = {lo, hi}; return __builtin_bit_cast(unsigned, __builtin_convertvector(v, bf16x2_t)); }
constexpr int ATT_KROW = 144, ATT_VROW = 520, ATT_K_OFF = 0, ATT_V_OFF = 256 * ATT_KROW;
__device__ __forceinline__ void attn_unit(const bf16* __restrict__ h, const float* __restrict__ sinks, const float* __restrict__ nrm, bf16* __restrict__ mix, fx_t* __restrict__ ssb, LAS unsigned char* lds, int task, const int tid) {
    const int n = task & 15, kvh = (task >> 4) & 3, b = task >> 6;
    const int lane = tid & 63, wave = tid >> 6;
    for (int pc = tid; pc < 2048; pc += NTHR) {
        const int j = pc >> 3, q = pc & 7, pos = 128 * n - 128 + j;
        v4u kv = {0u, 0u, 0u, 0u}, vv = {0u, 0u, 0u, 0u};
        if (pos >= 0) { const bf16* row = h + (size_t)(b * SEQ + pos) * INW; kv = *(const v4u*)(row + OFF_K + kvh * 64 + 8 * q); vv = *(const v4u*)(row + OFF_V + kvh * 64 + 8 * q); }
        *(LAS v4u*)(lds + ATT_K_OFF + j * ATT_KROW + 16 * q) = kv;
        LAS unsigned short* vt = (LAS unsigned short*)(lds + ATT_V_OFF) + (8 * q) * (ATT_VROW / 2) + j;
#pragma unroll
        for (int e = 0; e < 8; ++e) vt[e * (ATT_VROW / 2)] = (unsigned short)((e & 1) ? (vv[e >> 1] >> 16) : (vv[e >> 1] & 0xffffu));
    }
    __syncthreads();
    const int hq = kvh * 8 + wave; const float sink = sinks[hq];
    const int r = lane & 31, hh = lane >> 5; const bool first_blk = (n == 0);
    constexpr float LOG2E = 1.44269504088896341f, SC = 0.125f * LOG2E;
    const size_t tq0 = (size_t)b * SEQ + 128 * n + r;
    s16x8 qf[4];
    { const bf16* hrow = h + tq0 * INW;
#pragma unroll
      for (int s = 0; s < 4; ++s) qf[s] = *(const s16x8*)(hrow + OFF_Q + hq * 64 + 8 * hh + 16 * s); }
#pragma unroll 1
    for (int qs = 0; qs < 4; ++qs) {
        const size_t t = tq0 + 32 * qs;
        s16x8 qn[4]; v2u gw[2][4];
        { const bf16* hrow = h + (t + (qs < 3 ? 32 : 0)) * INW;
#pragma unroll
          for (int s = 0; s < 4; ++s) qn[s] = *(const s16x8*)(hrow + OFF_Q + hq * 64 + 8 * hh + 16 * s);
          const bf16* grow = h + t * INW;
#pragma unroll
          for (int dt = 0; dt < 2; ++dt)
#pragma unroll
              for (int g = 0; g < 4; ++g) gw[dt][g] = *(const v2u*)(grow + OFF_BG + hq * 64 + 32 * dt + 8 * g + 4 * hh); }
        f32x16 sc[5];
#pragma unroll
        for (int ci = 0; ci < 5; ++ci) {
            const LAS unsigned char* kp = lds + ATT_K_OFF + (32 * (qs + ci) + r) * ATT_KROW + 16 * hh;
            f32x16 acc;
#pragma unroll
            for (int i = 0; i < 16; ++i) acc[i] = 0.f;
#pragma unroll
            for (int s = 0; s < 4; ++s) { const s16x8 kf = *(const LAS s16x8*)(kp + 32 * s); acc = __builtin_amdgcn_mfma_f32_32x32x16_bf16(kf, qf[s], acc, 0, 0, 0); }
            sc[ci] = acc;
        }
        float mx = -1e30f;
#pragma unroll
        for (int ci = 0; ci < 5; ++ci)
#pragma unroll
            for (int i = 0; i < 16; ++i) { const int kk = (i & 3) + 8 * (i >> 2) + 4 * hh;
                const bool valid = ((ci == 0) ? (kk > r) : ((ci == 4) ? (kk <= r) : true)) && !(first_blk && qs + ci < 4);
                const float v = valid ? sc[ci][i] : -1e30f; sc[ci][i] = v; mx = fmaxf(mx, v); }
        mx = fmaxf(mx, __shfl_xor(mx, 32));
        const float m = fmaxf(mx * 0.125f, sink), mb = m * LOG2E;
        float sum = 0.f;
#pragma unroll
        for (int ci = 0; ci < 5; ++ci)
#pragma unroll
            for (int i = 0; i < 16; ++i) { const float p = __builtin_amdgcn_exp2f(sc[ci][i] * SC - mb); sc[ci][i] = p; sum += p; }
        sum += __shfl_xor(sum, 32);
        const float inv = 1.f / (sum + __builtin_amdgcn_exp2f((sink - m) * LOG2E));
        f32x16 o[2];
#pragma unroll
        for (int i = 0; i < 16; ++i) { o[0][i] = 0.f; o[1][i] = 0.f; }
#pragma unroll
        for (int ci = 0; ci < 5; ++ci)
#pragma unroll
            for (int s2 = 0; s2 < 2; ++s2) {
                v4u pw; pw.x = cvtpk(sc[ci][8 * s2 + 0], sc[ci][8 * s2 + 1]); pw.y = cvtpk(sc[ci][8 * s2 + 2], sc[ci][8 * s2 + 3]); pw.z = cvtpk(sc[ci][8 * s2 + 4], sc[ci][8 * s2 + 5]); pw.w = cvtpk(sc[ci][8 * s2 + 6], sc[ci][8 * s2 + 7]);
                const s16x8 pf = __builtin_bit_cast(s16x8, pw);
                const int key0 = 32 * (qs + ci) + 16 * s2 + 4 * hh;
#pragma unroll
                for (int dt = 0; dt < 2; ++dt) { const LAS unsigned char* vp = lds + ATT_V_OFF + (32 * dt + r) * ATT_VROW + 2 * key0;
                    const v2u lo = *(const LAS v2u*)vp, hi = *(const LAS v2u*)(vp + 16);
                    v4u vw; vw.x = lo.x; vw.y = lo.y; vw.z = hi.x; vw.w = hi.y;
                    o[dt] = __builtin_amdgcn_mfma_f32_32x32x16_bf16(__builtin_bit_cast(s16x8, vw), pf, o[dt], 0, 0, 0); }
            }
        float ssq = 0.f;
#pragma unroll
        for (int dt = 0; dt < 2; ++dt)
#pragma unroll
            for (int i = 0; i < 16; ++i) { const float y = o[dt][i] * inv; o[dt][i] = y; ssq += y * y; }
        ssq += __shfl_xor(ssq, 32);
        if (hh == 0) pg8::fx_add(ssb + t, ssq);
#pragma unroll
        for (int dt = 0; dt < 2; ++dt)
#pragma unroll
            for (int g = 0; g < 4; ++g) { const int cc = hq * 64 + 32 * dt + 8 * g + 4 * hh;
                const v2u gwv = gw[dt][g]; const f32x4 nv = *(const f32x4*)(nrm + cc);
                v2u ov; ov.x = cvtpk(o[dt][4 * g + 0] * nv[0] * silu(bflo(gwv.x)), o[dt][4 * g + 1] * nv[1] * silu(bfhi(gwv.x)));
                ov.y = cvtpk(o[dt][4 * g + 2] * nv[2] * silu(bflo(gwv.y)), o[dt][4 * g + 3] * nv[3] * silu(bfhi(gwv.y)));
                *(v2u*)(mix + t * LDK + MIX_B + cc) = ov; }
#pragma unroll
        for (int s = 0; s < 4; ++s) qf[s] = qn[s];
    }
    __syncthreads();
}
constexpr int RG_TOK = 128, RG_ROW = 272, RG_HP_OFF = RG_TOK * RG_ROW, RG_HP_ROW = 576, RG_CARRY_OFF = RG_HP_OFF + RG_TOK * RG_HP_ROW;
__device__ __forceinline__ void rg_unit(const bf16* __restrict__ h, const float* __restrict__ ccw, const float* __restrict__ ccb, const bf16* __restrict__ wg, const float* __restrict__ br, const float* __restrict__ bi,
                                        const float* __restrict__ lam, const float* __restrict__ nrm, bf16* __restrict__ mix, fx_t* __restrict__ ssc, unsigned long long* gran, unsigned* tmo, const unsigned epoch,
                                        LAS unsigned char* lds, const int c, const int hd, const int b, const int tid) {
    const int lane = tid & 63, wave = tid >> 6;
    const size_t T0 = (size_t)b * SEQ + RG_TOK * c;
    constexpr float LOG2E = 1.44269504088896341f;
    const int l15 = lane & 15, lg = lane >> 4, chl = 16 * wave + l15, ch = hd * 128 + chl;
    s16x8 Br[4], Bi[4];
    { const bf16* wrp = wg + ((size_t)hd * 128 + chl) * 128 + 8 * lg; const bf16* wip = wrp + (size_t)8 * 128 * 128;
#pragma unroll
      for (int s = 0; s < 4; ++s) { Br[s] = *(const s16x8*)(wrp + 32 * s); Bi[s] = *(const s16x8*)(wip + 32 * s); } }
    const float brv = br[ch] * LOG2E, biv = bi[ch] * LOG2E, L2 = -8.f * log1pf(expf(-lam[ch])) * LOG2E;
    {
        const int g = tid & 15, tr = tid >> 4, ch = hd * 128 + 8 * g;
        float w[4][8], bs[8];
#pragma unroll
        for (int k = 0; k < 4; ++k) { const f32x4 a = *(const f32x4*)(ccw + k * 1024 + ch), q = *(const f32x4*)(ccw + k * 1024 + ch + 4);
#pragma unroll
            for (int e = 0; e < 4; ++e) { w[k][e] = a[e]; w[k][4 + e] = q[e]; } }
        { const f32x4 a = *(const f32x4*)(ccb + ch), q = *(const f32x4*)(ccb + ch + 4);
#pragma unroll
          for (int e = 0; e < 4; ++e) { bs[e] = a[e]; bs[4 + e] = q[e]; } }
        v4u rows[7];
#pragma unroll
        for (int i = 0; i < 7; ++i) { const int trow = 4 * tr - 3 + i; const bool ok = (c > 0) || (trow >= 0);
            v4u z = {0u, 0u, 0u, 0u}; if (ok) z = *(const v4u*)(h + (size_t)((long)T0 + trow) * INW + OFF_CX + ch); rows[i] = z; }
#pragma unroll
        for (int i = 0; i < 4; ++i) { float o[8];
#pragma unroll
            for (int e = 0; e < 8; ++e) { float acc = bs[e];
#pragma unroll
                for (int k = 0; k < 4; ++k) { const unsigned wd = rows[i + k][e >> 1]; acc += w[k][e] * ((e & 1) ? bfhi(wd) : bflo(wd)); }
                o[e] = acc; }
            v4u ov; ov.x = cvtpk(o[0], o[1]); ov.y = cvtpk(o[2], o[3]); ov.z = cvtpk(o[4], o[5]); ov.w = cvtpk(o[6], o[7]);
            *(LAS v4u*)(lds + (4 * tr + i) * RG_ROW + 16 * g) = ov; }
    }
    __syncthreads();
    float Prun = 1.f, Hrun = 0.f;
    {
#pragma unroll 2
        for (int tt = 0; tt < RG_TOK / 16; ++tt) {
            const LAS unsigned char* ap = lds + (16 * tt + l15) * RG_ROW + 16 * lg;
            pg8::f32x4 ar = {0.f, 0.f, 0.f, 0.f}, ai = {0.f, 0.f, 0.f, 0.f};
#pragma unroll
            for (int s = 0; s < 4; ++s) { const s16x8 af = *(const LAS s16x8*)(ap + 64 * s);
                ar = __builtin_amdgcn_mfma_f32_16x16x32_bf16(af, Br[s], ar, 0, 0, 0); ai = __builtin_amdgcn_mfma_f32_16x16x32_bf16(af, Bi[s], ai, 0, 0, 0); }
            float pl[4], hl[4]; float P = 1.f, H = 0.f;
#pragma unroll
            for (int rg = 0; rg < 4; ++rg) { const int trow = 16 * tt + 4 * lg + rg;
                const float xcv = bf2f(*(const LAS unsigned short*)(lds + trow * RG_ROW + 2 * chl));
                const float rr = __builtin_amdgcn_rcpf(1.f + __builtin_amdgcn_exp2f(-(ar[rg] * LOG2E + brv)));
                const float ig = __builtin_amdgcn_rcpf(1.f + __builtin_amdgcn_exp2f(-(ai[rg] * LOG2E + biv)));
                const float a = __builtin_amdgcn_exp2f(rr * L2);
                const float u = __builtin_amdgcn_sqrtf(fmaxf(fmaf(-a, a, 1.f), 0.f)) * (ig * xcv);
                H = a * H + u; P = a * P; pl[rg] = P; hl[rg] = H; }
            float myP = Prun, myH = Hrun, Pst = Prun, Hst = Hrun;
#pragma unroll
            for (int x = 0; x < 4; ++x) { const float Ax = __shfl(P, l15 + 16 * x), Hx = __shfl(H, l15 + 16 * x);
                if (x == lg) { myP = Pst; myH = Hst; }
                Hst = Ax * Hst + Hx; Pst = Ax * Pst; }
            Prun = Pst; Hrun = Hst;
#pragma unroll
            for (int rg = 0; rg < 4; ++rg) *(LAS unsigned*)(lds + RG_HP_OFF + (16 * tt + 4 * lg + rg) * RG_HP_ROW + 4 * chl) = cvtpk(hl[rg] + pl[rg] * myH, pl[rg] * myP);
        }
    }
    unsigned gwv[RG_TOK / 8];
    { const size_t tbq = T0 + wave * (RG_TOK / 8);
#pragma unroll
      for (int i = 0; i < RG_TOK / 8; ++i) gwv[i] = *(const unsigned*)(h + (tbq + i) * INW + OFF_CG + hd * 128 + 2 * lane); }
    if (lg == 0) { unsigned long long* gp = gran + ((((size_t)b * 8 + hd) * 16 + c) * 128 + chl) * 2;
        __hip_atomic_store(gp, ((unsigned long long)epoch << 32) | __builtin_bit_cast(unsigned, Prun), __ATOMIC_RELAXED, __HIP_MEMORY_SCOPE_AGENT);
        __hip_atomic_store(gp + 1, ((unsigned long long)epoch << 32) | __builtin_bit_cast(unsigned, Hrun), __ATOMIC_RELAXED, __HIP_MEMORY_SCOPE_AGENT); }
    if (tid < 128) {
        const unsigned long long* gq = gran + (((size_t)b * 8 + hd) * 16 * 128 + tid) * 2;
        float Av[15], Hv[15]; unsigned spins = 0;
        for (;;) { bool ok = true;
#pragma unroll
            for (int cp = 0; cp < 15; ++cp) { Av[cp] = 1.f; Hv[cp] = 0.f;
                if (cp < c) { const unsigned long long xa = __hip_atomic_load(gq + cp * 256, __ATOMIC_RELAXED, __HIP_MEMORY_SCOPE_AGENT), xh = __hip_atomic_load(gq + cp * 256 + 1, __ATOMIC_RELAXED, __HIP_MEMORY_SCOPE_AGENT);
                    ok = ok && ((unsigned)(xa >> 32) == epoch) && ((unsigned)(xh >> 32) == epoch); Av[cp] = __builtin_bit_cast(float, (unsigned)xa); Hv[cp] = __builtin_bit_cast(float, (unsigned)xh); } }
            if (ok) break;
            if (++spins > 40000u) { __hip_atomic_store(tmo, 1u, __ATOMIC_RELAXED, __HIP_MEMORY_SCOPE_AGENT); break; }
            __builtin_amdgcn_s_sleep(2); }
        float carry = 0.f;
#pragma unroll
        for (int cp = 0; cp < 15; ++cp) if (cp < c) carry = Av[cp] * carry + Hv[cp];
        ((LAS float*)(lds + RG_CARRY_OFF))[tid] = carry;
    }
    __syncthreads();
    {
        const float n0 = nrm[hd * 128 + 2 * lane], n1 = nrm[hd * 128 + 2 * lane + 1];
        const float c0 = ((const LAS float*)(lds + RG_CARRY_OFF))[2 * lane], c1 = ((const LAS float*)(lds + RG_CARRY_OFF))[2 * lane + 1];
        const size_t tb = T0 + wave * (RG_TOK / 8);
        float ssq[RG_TOK / 8];
#pragma unroll
        for (int i = 0; i < RG_TOK / 8; ++i) { const int row = wave * (RG_TOK / 8) + i;
            const v2u hw = *(const LAS v2u*)(lds + RG_HP_OFF + row * RG_HP_ROW + 8 * lane);
            const float y0 = bflo(hw.x) + bfhi(hw.x) * c0, y1 = bflo(hw.y) + bfhi(hw.y) * c1;
            ssq[i] = y0 * y0 + y1 * y1;
            *(unsigned*)(mix + (tb + i) * LDK + MIX_C + hd * 128 + 2 * lane) = cvtpk(y0 * n0 * silu(bflo(gwv[i])), y1 * n1 * silu(bfhi(gwv[i]))); }
#pragma unroll
        for (int st = 0; st < 4; ++st) { const int hm = 8 >> st, bit = 1 << st;
            const bool up = (lane & bit) != 0;
#pragma unroll
            for (int k = 0; k < hm; ++k) { const float mine = up ? ssq[k + hm] : ssq[k], other = up ? ssq[k] : ssq[k + hm]; ssq[k] = mine + __shfl_xor(other, bit); } }
        float tot = ssq[0]; tot += __shfl_xor(tot, 16); tot += __shfl_xor(tot, 32);
        if (lane < 16) { const int row = 8 * (lane & 1) + 4 * ((lane >> 1) & 1) + 2 * ((lane >> 2) & 1) + ((lane >> 3) & 1); pg8::fx_add(ssc + tb + row, tot); }
    }
    __syncthreads();
}
__device__ __forceinline__ void final_ln_token(const bf16* __restrict__ yb, const fx_t* __restrict__ st, const float* __restrict__ g, const float* __restrict__ bta, float* __restrict__ xo, int t, int lane) {
    const float s = pg8::fx_get(st + 2 * (size_t)t), q = pg8::fx_get(st + 2 * (size_t)t + 1);
    const float mean = s * (1.f / DM), rstd = rsqrtf(fmaxf(q * (1.f / DM) - mean * mean, 0.f) + LN_EPS);
#pragma unroll
    for (int j = 0; j < 8; ++j) { const int cc = 8 * (lane + 64 * j);
        const v4u hw = *(const v4u*)(yb + (size_t)t * LDK + cc);
        const f32x4 g0 = *(const f32x4*)(g + cc), g1 = *(const f32x4*)(g + cc + 4), b0 = *(const f32x4*)(bta + cc), b1 = *(const f32x4*)(bta + cc + 4);
        f32x4 o0, o1;
        o0[0] = (bflo(hw[0]) - mean) * rstd * g0[0] + b0[0]; o0[1] = (bfhi(hw[0]) - mean) * rstd * g0[1] + b0[1];
        o0[2] = (bflo(hw[1]) - mean) * rstd * g0[2] + b0[2]; o0[3] = (bfhi(hw[1]) - mean) * rstd * g0[3] + b0[3];
        o1[0] = (bflo(hw[2]) - mean) * rstd * g1[0] + b1[0]; o1[1] = (bfhi(hw[2]) - mean) * rstd * g1[1] + b1[1];
        o1[2] = (bflo(hw[3]) - mean) * rstd * g1[2] + b1[2]; o1[3] = (bfhi(hw[3]) - mean) * rstd * g1[3] + b1[3];
        __builtin_nontemporal_store(o0, (f32x4*)(xo + (size_t)t * DM + cc)); __builtin_nontemporal_store(o1, (f32x4*)(xo + (size_t)t * DM + cc + 4)); }
}

struct Args { const float* in[17]; float* out; unsigned char* ws; };
#define KA_AS __attribute__((address_space(4)))
#define AIN(k) (*(const float* const KA_AS*)(ka_ + 8 * (k)))
#define AOUT (*(float* const KA_AS*)(ka_ + 8 * 17))
#define AWS (*(unsigned char* const KA_AS*)(ka_ + 8 * 18))
#define TZ_INIT() const KA_AS unsigned char* ka_ = (const KA_AS unsigned char*)__builtin_amdgcn_kernarg_segment_ptr(); asm volatile("" : "+s"(ka_)); int lz = l_; asm volatile("" : "+s"(lz)); const int l = lz; (void)l; int tz = threadIdx.x; asm volatile("" : "+v"(tz)); const int tid = tz, lane = tz & 63, wave = __builtin_amdgcn_readfirstlane(tz >> 6); const int G = gridDim.x, gw = blockIdx.x * NWAVES + wave, NGW = G * NWAVES; (void)tid; (void)lane; (void)gw; (void)NGW
__global__ void __launch_bounds__(NTHR, 2) fwd(Args args) {
    extern __shared__ __attribute__((aligned(16))) unsigned char lds_raw[];
    LAS unsigned char* lds = (LAS unsigned char*)lds_raw;
    volatile LAS unsigned* MISC = (volatile LAS unsigned*)(lds + LDS_MISC);
    for (int u = threadIdx.x; u < (LDS_BYTES - 131072) / 4; u += NTHR) ((LAS unsigned*)(lds + 131072))[u] = 0u;
    __syncthreads();
    (void)xcd_barrier_post((unsigned*)(args.ws + WS_CTL) + 4096, MISC + 8);
#define GRID_BARRIER() do { XcdBarrier b_; b_.bar = (unsigned*)(args.ws + WS_CTL) + 4096; b_.x = xb_xcc_id(); b_.st = (volatile LAS unsigned*)(lds + LDS_MISC) + 8; xcd_barrier(b_); } while (0)
#define WSP(T, off) ((T*)(AWS + (off)))

    {
        const int l_ = 0; TZ_INIT();
        LAS float* scr = (LAS float*)(lds + wave * 16384);
        for (int ll = 0; ll < DEPTH; ++ll) convert_layer(AIN(1), AIN(14), AIN(15), AIN(16), AWS, ll, scr, gw, NGW, lane);
        for (int it = gw; it < DEPTH * 2 * 8 * 2; it += NGW) {
            const int nb = it & 1, hd = (it >> 1) & 7, gate = (it >> 4) & 1, ll = it >> 5;
            convert_task<false, false>(AIN(gate ? 8 : 6) + ((size_t)ll * 8 + hd) * 128 * 128, WSP(bf16, WS_WG) + (((size_t)ll * 2 + gate) * 8 + hd) * 128 * 128, 128, 128, scr, nb, 0, 2, lane, nullptr, nullptr, nullptr, nullptr); }
        const float* x = AIN(0); bf16* xb = WSP(bf16, WS_XB);
        { const size_t total = (size_t)M * DM / 8, S = (size_t)G * NTHR;
          for (size_t i = (size_t)blockIdx.x * NTHR + tid; i < total; i += 4 * S) {
            f32x4 a[4], b[4];
#pragma unroll
            for (int u = 0; u < 4; ++u) { const size_t iu = i + u * S; if (iu < total) { a[u] = __builtin_nontemporal_load((const f32x4*)x + 2 * iu); b[u] = __builtin_nontemporal_load((const f32x4*)x + 2 * iu + 1); } }
#pragma unroll
            for (int u = 0; u < 4; ++u) { const size_t iu = i + u * S; if (iu < total) {
                v4u o; o.x = pk2(a[u][0], a[u][1]); o.y = pk2(a[u][2], a[u][3]); o.z = pk2(b[u][0], b[u][1]); o.w = pk2(b[u][2], b[u][3]);
                const size_t row = iu / (DM / 8), cc = iu % (DM / 8);
                *(v4u*)(xb + row * LDK + 8 * cc) = o; } } } }
    }
    GRID_BARRIER();
    for (int l_ = 0; l_ < DEPTH; ++l_) {
#define GEMM1_TABLES(S_) do { const fx_t* stp = WSP(fx_t, WS_CTL + CTL_ST) + (size_t)(l > 0 ? l - 1 : 0) * M * 2; const fx_t* Gv = WSP(fx_t, WS_CTL + CTL_GV) + (size_t)l * INW; const fx_t* Bvv = WSP(fx_t, WS_CTL + CTL_BV) + (size_t)l * INW; \
            _Pragma("unroll") for (int i = 0; i < 6; ++i) { pg8::Unit u; if ((S_).next(i, u)) { \
                if (tid < 256) { float mu = 0.f, rs = 1.f; \
                    if (l > 0) { const float s = pg8::fx_get(stp + 2 * (size_t)(u.pm * 256 + tid)), q = pg8::fx_get(stp + 2 * (size_t)(u.pm * 256 + tid) + 1); mu = s * (1.f / DM); rs = rsqrtf(fmaxf(q * (1.f / DM) - mu * mu, 0.f) + LN_EPS); } \
                    ((LAS pg8::f32x2*)(lds + pg8::TBL_ROW))[i * 256 + tid] = (pg8::f32x2){mu, rs}; } \
                else { const int cidx = u.pn * 256 + tid - 256; float gg = 0.f, bb = 0.f; if (l > 0) { gg = pg8::fx_get(Gv + cidx); bb = pg8::fx_get(Bvv + cidx); } \
                    ((LAS pg8::f32x2*)(lds + pg8::TBL_COL))[i * 256 + tid - 256] = (pg8::f32x2){gg, bb}; } } } \
            __syncthreads(); } while (0)
        { TZ_INIT();
          pg8::Gemm g; g.A = WSP(bf16, WS_XB); g.Bt = WSP(bf16, WS_WIN) + (size_t)l * WIN_L; g.M = M; g.N = INW - 512; g.K = DM; g.ld = LDK; pg8::EpiBf16LN E; E.O = WSP(bf16, WS_H); E.ldc = INW; E.pad = 0;
          pg8::StaticOrder S; S.init(M, INW - 512, G, (int)blockIdx.x);
          GEMM1_TABLES(S);
          pg8::gemm_phase<pg8::EpiBf16LN, pg8::StaticOrder, true, true>(lds, g, S, E, tid); }
        GRID_BARRIER();
        { TZ_INIT();
          pg8::Gemm g; g.A = WSP(bf16, WS_XB); g.Bt = WSP(bf16, WS_WIN) + (size_t)l * WIN_L; g.M = M; g.N = INW; g.K = DM; g.ld = LDK; pg8::EpiBf16LN E; E.O = WSP(bf16, WS_H); E.ldc = INW; E.pad = 0;
          pg8::OneUnit S; { const int bx = (int)blockIdx.x, x = bx & 7, idx = bx >> 3; S.has = (bx < 64) ? 1 : 0; S.pm = 4 * x + (idx >> 1); S.pn = (INW / 256 - 2) + (idx & 1); }
          if (S.has) { GEMM1_TABLES(S); pg8::gemm_phase<pg8::EpiBf16LN, pg8::OneUnit, false, true>(lds, g, S, E, tid); } }
#define Q_NEXT() do { if (tid == 0) *qw = __hip_atomic_fetch_add(qctr, 1u, __ATOMIC_RELAXED, __HIP_MEMORY_SCOPE_AGENT); __syncthreads(); tk = (int)__builtin_amdgcn_readfirstlane((int)*qw); __syncthreads(); } while (0)
        { TZ_INIT();
          unsigned* qctr = WSP(unsigned, WS_CTL + CTL_Q) + 64 * l; LAS unsigned* qw = (LAS unsigned*)(lds + LDS_MISC) + 16; int tk;
          fx_t* ssb = WSP(fx_t, WS_CTL + CTL_SS) + (size_t)(2 * l) * M;
          Q_NEXT();
          while (tk < 256) { attn_unit(WSP(bf16, WS_H), AIN(3) + (size_t)l * NQH, AIN(12) + (size_t)l * WB, WSP(bf16, WS_MIX), ssb, lds, tk, tid); Q_NEXT(); } }
        { TZ_INIT();
          unsigned* qctr = WSP(unsigned, WS_CTL + CTL_Q) + 64 * l; LAS unsigned* qw = (LAS unsigned*)(lds + LDS_MISC) + 16; int tk = (int)__builtin_amdgcn_readfirstlane((int)*qw);
          fx_t* ssc = WSP(fx_t, WS_CTL + CTL_SS) + (size_t)(2 * l + 1) * M;
          while (tk < 512) { const int r = tk - 256;
              rg_unit(WSP(bf16, WS_H), AIN(4) + (size_t)l * 4 * WC, AIN(5) + (size_t)l * WC, WSP(bf16, WS_WG) + (size_t)l * 2 * 8 * 128 * 128, AIN(7) + (size_t)l * WC, AIN(9) + (size_t)l * WC,
                      AIN(10) + (size_t)l * WC, AIN(13) + (size_t)l * WC, WSP(bf16, WS_MIX), ssc, WSP(unsigned long long, WS_CTL + CTL_GR), WSP(unsigned, WS_CTL) + 8, (unsigned)(l + 1), lds, r >> 4, r & 3, (r >> 2) & 3, tid);
              Q_NEXT(); } }
        { TZ_INIT();
          unsigned* qctr = WSP(unsigned, WS_CTL + CTL_Q) + 64 * l; LAS unsigned* qw = (LAS unsigned*)(lds + LDS_MISC) + 16; int tk = (int)__builtin_amdgcn_readfirstlane((int)*qw);
          while (tk < 768) { const int t0 = 32 * (tk - 512) + 4 * wave;
              branch_a_pair(WSP(bf16, WS_H), AIN(2) + (size_t)l * 3 * WA, AIN(11) + (size_t)l * WA, WSP(bf16, WS_MIX), t0, lane);
              branch_a_pair(WSP(bf16, WS_H), AIN(2) + (size_t)l * 3 * WA, AIN(11) + (size_t)l * WA, WSP(bf16, WS_MIX), t0 + 2, lane);
              Q_NEXT(); } }
        GRID_BARRIER();
        { TZ_INIT();
          fx_t* ssc = WSP(fx_t, WS_CTL + CTL_SS) + (size_t)(2 * l + 1) * M;
          for (int r = blockIdx.x; r < 256; r += G)
              rg_unit(WSP(bf16, WS_H), AIN(4) + (size_t)l * 4 * WC, AIN(5) + (size_t)l * WC, WSP(bf16, WS_WG) + (size_t)l * 2 * 8 * 128 * 128, AIN(7) + (size_t)l * WC, AIN(9) + (size_t)l * WC,
                      AIN(10) + (size_t)l * WC, AIN(13) + (size_t)l * WC, WSP(bf16, WS_MIX), ssc, WSP(unsigned long long, WS_CTL + CTL_GR), WSP(unsigned, WS_CTL) + 8, (unsigned)(l + 1), lds, r >> 4, 4 + (r & 3), (r >> 2) & 3, tid); }
        GRID_BARRIER();
        { TZ_INIT();
          pg8::Gemm g; g.A = WSP(bf16, WS_MIX); g.Bt = WSP(bf16, WS_WOUT) + (size_t)l * WOUT_L; g.M = M; g.N = DM; g.K = DMIX; g.ld = LDK;
          pg8::EpiResLN E; E.Yb = WSP(bf16, WS_XB); const float* lng = AIN(15) + (size_t)(l > 0 ? l - 1 : 0) * DM; const float* lnb = AIN(16) + (size_t)(l > 0 ? l - 1 : 0) * DM;
          E.st = WSP(fx_t, WS_CTL + CTL_ST) + (size_t)l * M * 2; E.alpha = ALPHA; E.ldb = LDK;
          pg8::StaticOrder S; S.init(M, DM, G, (int)blockIdx.x);
          { const fx_t* ssb = WSP(fx_t, WS_CTL + CTL_SS) + (size_t)(2 * l) * M; const fx_t* ssc = ssb + M; const fx_t* stp = WSP(fx_t, WS_CTL + CTL_ST) + (size_t)(l > 0 ? l - 1 : 0) * M * 2;
            pg8::Unit u; if (S.next(wave >> 2, u)) { const int grow = u.pm * 256 + (tid & 255);
                const float rb = rsqrtf(pg8::fx_get(ssb + grow) * (1.f / WB) + RMS_EPS), rc = rsqrtf(pg8::fx_get(ssc + grow) * (1.f / WC) + RMS_EPS); float mu = 0.f, rs = 1.f;
                if (l > 0) { const float s = pg8::fx_get(stp + 2 * (size_t)grow), q = pg8::fx_get(stp + 2 * (size_t)grow + 1); mu = s * (1.f / DM); rs = rsqrtf(fmaxf(q * (1.f / DM) - mu * mu, 0.f) + LN_EPS); }
                ((LAS pg8::f32x4*)(lds + pg8::TBL_ROW))[tid] = (pg8::f32x4){rc / rb, rb, mu, rs};
                float gg = 1.f, bb = 0.f; if (l > 0) { gg = lng[u.pn * 256 + (tid & 255)]; bb = lnb[u.pn * 256 + (tid & 255)]; }
                ((LAS pg8::f32x2*)(lds + pg8::TBL_COL))[tid] = (pg8::f32x2){gg, bb}; }
            __syncthreads(); }
          pg8::gemm_phase<pg8::EpiResLN, pg8::StaticOrder, true, true>(lds, g, S, E, tid); }
        GRID_BARRIER();
    }
    { const int l_ = DEPTH - 1; TZ_INIT();
      for (int t = gw; t < M; t += NGW) final_ln_token(WSP(bf16, WS_XB), WSP(fx_t, WS_CTL + CTL_ST) + (size_t)l * M * 2, AIN(15) + (size_t)l * DM, AIN(16) + (size_t)l * DM, AOUT, t, lane); }
}

extern "C" void kernel_launch(void* const* d_in, const int* in_sizes, int n_in, void* d_out, int out_size, void* d_ws, size_t ws_size, hipStream_t stream) {
    static int grid = 0;
    if (grid == 0) {
        if (n_in != 17 || in_sizes[0] != M * DM || out_size != M * DM || ws_size < WS_END) { fprintf(stderr, "kernel_launch: unexpected shapes/workspace (n_in %d, ws %zu)\n", n_in, ws_size); grid = -1; return; }
        int dev = 0, cus = 0, per_cu = 0;
        if (hipGetDevice(&dev) != hipSuccess || hipDeviceGetAttribute(&cus, hipDeviceAttributeMultiprocessorCount, dev) != hipSuccess) { grid = -1; return; }
        if (hipFuncSetAttribute((const void*)fwd, hipFuncAttributeMaxDynamicSharedMemorySize, LDS_BYTES) != hipSuccess) { fprintf(stderr, "kernel_launch: hipFuncSetAttribute failed\n"); grid = -1; return; }
        if (hipOccupancyMaxActiveBlocksPerMultiprocessor(&per_cu, (const void*)fwd, NTHR, LDS_BYTES) != hipSuccess || per_cu < 1) fprintf(stderr, "kernel_launch: occupancy query reports %d\n", per_cu);
        (void)hipGetLastError();
        grid = cus > 0 ? cus : 256;
        if (grid < 256) { fprintf(stderr, "kernel_launch: this kernel's unit tables assume at least 256 workgroups (one per CU of a 256-CU device); found %d CUs: nothing launched\n", grid); grid = -1; return; }
    }
    if (grid < 0) return;
    (void)hipMemsetAsync((char*)d_ws + WS_CTL, 0, CTL_BYTES, stream);
    Args a{};
    for (int i = 0; i < 17; ++i) a.in[i] = (const float*)d_in[i];
    a.out = (float*)d_out; a.ws = (unsigned char*)d_ws;
    hipLaunchKernelGGL(fwd, dim3(grid), dim3(NTHR), LDS_BYTES, stream, a);
}
```

```cpp
#include <hip/hip_runtime.h>
#include <cstdio>
#include <cstdint>
namespace pg8 {
#define PG8_LAS __attribute__((address_space(3)))
typedef unsigned short bf16_t;
typedef short bf16x8 __attribute__((ext_vector_type(8)));
typedef float f32x4 __attribute__((ext_vector_type(4)));
typedef float f32x2 __attribute__((ext_vector_type(2)));
typedef unsigned u32x4 __attribute__((ext_vector_type(4)));
constexpr int BM = 256, BK = 64, HALF = 128, HTB = HALF * BK * 2  , STAGE_BYTES = 8 * HTB, NXCD = 8, WGM = 8;

__host__ __device__ __forceinline__ int lds_byte(int r, int c) { const int st = (r >> 4) * 2 + (c >> 5), rr = r & 15, cc = c & 31, ob = rr * 64 + cc * 2; return st * 1024 + (ob ^ (((ob >> 9) & 1) << 5)); }
__host__ __device__ __forceinline__ void stage_rc(int b, int& R, int& C) { const int st = b / 1024, sb = b % 1024, swz = sb ^ (((sb >> 9) & 1) << 5); R = (st >> 1) * 16 + swz / 64; C = (st & 1) * 32 + (swz % 64) / 2; }
__host__ __device__ __forceinline__ int perm32(int rho) { const int n = rho >> 4, i = rho & 15; return 8 * (i >> 2) + 4 * n + (i & 3); }

struct Unit { int pm, pn; };
struct Gemm { const bf16_t* A; const bf16_t* Bt; int M, N, K, ld; };

struct StaticOrder {
    int nM, nN, nwg, G, c;
    __host__ __device__ void init(int M, int N, int G_, int c_) { nM = M / BM; nN = N / BM; nwg = nM * nN; G = G_; c = c_; }
    __host__ __device__ bool next(int i, Unit& u) const {
        const long L = (long)i * G + c; if (L >= nwg) return false;
        int wgid = (int)L; { const int q = nwg / NXCD, r = nwg % NXCD, xcd = wgid % NXCD, off = wgid / NXCD; wgid = (xcd < r ? xcd * (q + 1) : r * (q + 1) + (xcd - r) * q) + off; }
        const int nig = WGM * nN, gid = wgid / nig, fm = gid * WGM, gsz = (nM - fm) < WGM ? (nM - fm) : WGM;
        u.pm = fm + ((wgid % nig) % gsz); u.pn = (wgid % nig) / gsz; return true;
    }
    __device__ __forceinline__ void a_ready(const Unit&) const {}
    __device__ __forceinline__ void done(const Unit&) const {}
};

struct OneUnit {
    int pm, pn, has;
    __host__ __device__ bool next(int i, Unit& u) const { if (i != 0 || !has) return false; u.pm = pm; u.pn = pn; return true; }
    __device__ __forceinline__ void a_ready(const Unit&) const {}
    __device__ __forceinline__ void done(const Unit&) const {}
};

__device__ __forceinline__ void fx_add(unsigned long long* p, float v) { atomicAdd(p, (unsigned long long)__float2ll_rn(v * 4294967296.f)); }
__device__ __forceinline__ float fx_get(const unsigned long long* p) { return (float)(long long)(*p) * 2.3283064365386963e-10f; }
__device__ __forceinline__ unsigned cvt_pk_bf16(float lo, float hi) { unsigned r; asm volatile("v_cvt_pk_bf16_f32 %0, %1, %2" : "=v"(r) : "v"(lo), "v"(hi)); return r; }

constexpr int TBL_ROW = 131072 + 2048;
constexpr int TBL_COL = TBL_ROW + 6 * 256 * 8;
struct EpiBf16LN {
    static constexpr bool PERM = true, AFTER_DRAIN = false, KSCALE = false;
    bf16_t* O; int ldc, pad;
    __device__ __forceinline__ void operator()(const f32x4 (&acc)[2][2][4][2], const Unit& u, int wr, int wc, int fr, int fq, int ui, PG8_LAS unsigned char* lds) const {
        const int row0 = u.pm * BM + wr * 64 + fr; const int col0 = u.pn * BM + wc * 32 + 8 * fq;
        const PG8_LAS f32x2* rt = (const PG8_LAS f32x2*)(lds + TBL_ROW) + ui * 256 + wr * 64 + fr;
        const PG8_LAS f32x4* ct = (const PG8_LAS f32x4*)(lds + TBL_COL + (ui * 256 + wc * 32 + 8 * fq) * 8);
        f32x4 cq[2][2][2];
#pragma unroll
        for (int bj = 0; bj < 2; ++bj)
#pragma unroll
            for (int n = 0; n < 2; ++n) { cq[bj][n][0] = ct[(bj * HALF + 4 * n) / 2]; cq[bj][n][1] = ct[(bj * HALF + 4 * n) / 2 + 1]; }
#pragma unroll
        for (int ai = 0; ai < 2; ++ai)
#pragma unroll
            for (int m = 0; m < 4; ++m) { bf16_t* rowp = O + (size_t)(row0 + ai * HALF + m * 16) * ldc + col0; const f32x2 ms = rt[ai * HALF + m * 16]; const float mu = ms.x, rs = ms.y;
#pragma unroll
                for (int bj = 0; bj < 2; ++bj) { float o[8];
#pragma unroll
                    for (int n = 0; n < 2; ++n) { const f32x4 v = acc[ai][bj][m][n];
                        o[4 * n + 0] = rs * (v[0] - mu * cq[bj][n][0][0]) + cq[bj][n][0][1]; o[4 * n + 1] = rs * (v[1] - mu * cq[bj][n][0][2]) + cq[bj][n][0][3];
                        o[4 * n + 2] = rs * (v[2] - mu * cq[bj][n][1][0]) + cq[bj][n][1][1]; o[4 * n + 3] = rs * (v[3] - mu * cq[bj][n][1][2]) + cq[bj][n][1][3]; }
                    u32x4 w; w.x = cvt_pk_bf16(o[0], o[1]); w.y = cvt_pk_bf16(o[2], o[3]); w.z = cvt_pk_bf16(o[4], o[5]); w.w = cvt_pk_bf16(o[6], o[7]);
                    *(u32x4*)(rowp + bj * HALF) = w; } }
    }
};
struct EpiResLN {
    static constexpr bool PERM = true, AFTER_DRAIN = false, KSCALE = true;
    static constexpr int KS1 = 16, KS2 = 48;
    bf16_t* Yb; unsigned long long* st; float alpha; int ldb;
    __device__ __forceinline__ void kscale(f32x4 (&acc)[2][2][4][2], int ui, int which, int wr, int fr, PG8_LAS unsigned char* lds) const {
        const PG8_LAS f32x4* tbl = (const PG8_LAS f32x4*)(lds + TBL_ROW) + ui * 256 + wr * 64 + fr;
#pragma unroll
        for (int ai = 0; ai < 2; ++ai)
#pragma unroll
            for (int m = 0; m < 4; ++m) { const f32x4 fv = tbl[ai * HALF + m * 16]; const float f = which ? fv[1] : fv[0];
#pragma unroll
                for (int bj = 0; bj < 2; ++bj)
#pragma unroll
                    for (int n = 0; n < 2; ++n) acc[ai][bj][m][n] = acc[ai][bj][m][n] * f; }
    }
    static __device__ __forceinline__ float lo16(unsigned w) { return __builtin_bit_cast(float, w << 16); }
    static __device__ __forceinline__ float hi16(unsigned w) { return __builtin_bit_cast(float, w & 0xffff0000u); }
    __device__ __forceinline__ void operator()(const f32x4 (&acc)[2][2][4][2], const Unit& u, int wr, int wc, int fr, int fq, int ui, PG8_LAS unsigned char* lds) const {
        const int row0 = u.pm * BM + wr * 64 + fr, col0 = u.pn * BM + wc * 32 + 8 * fq;
        const PG8_LAS f32x4* rt = (const PG8_LAS f32x4*)(lds + TBL_ROW) + ui * 256 + wr * 64 + fr;
        const PG8_LAS f32x4* ct = (const PG8_LAS f32x4*)(lds + TBL_COL + (ui * 256 + wc * 32 + 8 * fq) * 8);
        u32x4 A0[4][2];
#define EPI_LOAD(buf, stg) do { _Pragma("unroll") for (int bj_ = 0; bj_ < 2; ++bj_) { const int row_ = row0 + ((stg) >> 2) * HALF + ((stg) & 3) * 16; \
            A0[buf][bj_] = *(const u32x4*)(Yb + (size_t)row_ * ldb + col0 + bj_ * HALF); } } while (0)
        EPI_LOAD(0, 0); EPI_LOAD(1, 1); EPI_LOAD(2, 2);
        float sq[2][2];
#pragma unroll
        for (int stg = 0; stg < 8; ++stg) {
            const int ai = stg >> 2, m = stg & 3, mi = m & 1;
            if (stg + 3 < 8) { if (((stg + 3) & 3) == 0) EPI_LOAD(0, stg + 3); else if (((stg + 3) & 3) == 1) EPI_LOAD(1, stg + 3); else if (((stg + 3) & 3) == 2) EPI_LOAD(2, stg + 3); else EPI_LOAD(3, stg + 3); }
            asm volatile("" ::: "memory");
            { const int row = row0 + ai * HALF + m * 16; const f32x4 tv = rt[ai * HALF + m * 16]; const float mu = tv[2], rs = tv[3];
                float s = 0.f, q = 0.f;
#pragma unroll
                for (int bj = 0; bj < 2; ++bj) { const size_t oh = (size_t)row * ldb + col0 + bj * HALF;
                    const u32x4 w0 = ((stg & 3) == 0) ? A0[0][bj] : (((stg & 3) == 1) ? A0[1][bj] : (((stg & 3) == 2) ? A0[2][bj] : A0[3][bj]));
                    float xr[8];
#pragma unroll
                    for (int j = 0; j < 4; ++j) { const float ye = lo16(w0[j]), yo = hi16(w0[j]);
                        const f32x4 gb = ct[(bj * HALF) / 2 + j];
                        xr[2 * j] = (ye - mu) * rs * gb[0] + gb[1]; xr[2 * j + 1] = (yo - mu) * rs * gb[2] + gb[3]; }
                    float y[8];
#pragma unroll
                    for (int j = 0; j < 4; ++j) { y[j] = xr[j] * alpha + acc[ai][bj][m][0][j]; y[4 + j] = xr[4 + j] * alpha + acc[ai][bj][m][1][j]; }
#pragma unroll
                    for (int j = 0; j < 8; ++j) { s += y[j]; q += y[j] * y[j]; }
                    u32x4 hn;
#pragma unroll
                    for (int j = 0; j < 4; ++j) hn[j] = cvt_pk_bf16(y[2 * j], y[2 * j + 1]);
                    *(u32x4*)(Yb + oh) = hn; }
                s += __shfl_xor(s, 16); s += __shfl_xor(s, 32); q += __shfl_xor(q, 16); q += __shfl_xor(q, 32);
                sq[mi][0] = s; sq[mi][1] = q; }
            if (mi == 1) {
                const int mi2 = fq >> 1, wh = fq & 1; const int row = row0 + ai * HALF + ((m & 2) + mi2) * 16;
                const float v = mi2 ? (wh ? sq[1][1] : sq[1][0]) : (wh ? sq[0][1] : sq[0][0]);
                fx_add(st + 2 * (size_t)row + wh, v); }
        }
#undef EPI_LOAD
    }
};

template <class Epi, class Sched, bool ALIGN_EPI = false, bool SP2 = false>
__device__ __forceinline__ void gemm_phase(PG8_LAS unsigned char* lds, const Gemm g, const Sched& S, const Epi& E, const int tid) {
    const int wid = __builtin_amdgcn_readfirstlane(tid >> 6), lane = tid & 63, wr = wid >> 2, wc = wid & 3, fr = lane & 15, fq = lane >> 4;
    const int K = g.ld, nt = g.K / BK;
    unsigned voffA[2], voffB[2];
#pragma unroll
    for (int i = 0; i < 2; ++i) { int R, C; stage_rc(tid * 16 + i * 8192, R, C); const int Rb = Epi::PERM ? ((R & ~31) + perm32(R & 31)) : R;
        voffA[i] = (unsigned)(R * K + C) * 2u; voffB[i] = (unsigned)(Rb * K + C) * 2u; }
    const size_t kstep = (size_t)(BK * 2);
    const size_t hstep = (size_t)HALF * K * 2;
    const size_t tstep = 2 * hstep;
    const unsigned ldsw = (unsigned)wid * 1024u;
    const int aoff = lds_byte(wr * 64 + fr, fq * 8), boff = lds_byte(wc * 32 + fr, fq * 8);
#define PG8_SA(b, h) (((b) * 2 + (h)) * HTB)
#define PG8_SB(b, h) ((4 + (b) * 2 + (h)) * HTB)
#define PG8_STAGE(bufoff, gbase, voff) do { _Pragma("unroll") for (int _i = 0; _i < 2; ++_i) \
        __builtin_amdgcn_global_load_lds((const unsigned*)((const char*)(gbase) + (voff)[_i]), (PG8_LAS unsigned*)(lds + (bufoff) + ldsw + _i * 8192), 16, 0, 0); } while (0)
#define PG8_LDA(dst, b, h) do { _Pragma("unroll") for (int m = 0; m < 4; ++m) _Pragma("unroll") for (int k = 0; k < 2; ++k) dst[m][k] = *(const PG8_LAS bf16x8*)(lds + PG8_SA(b, h) + aoff + m * 2048 + k * 1024); } while (0)
#define PG8_LDB(dst, b, h) do { _Pragma("unroll") for (int n = 0; n < 2; ++n) _Pragma("unroll") for (int k = 0; k < 2; ++k) dst[n][k] = *(const PG8_LAS bf16x8*)(lds + PG8_SB(b, h) + boff + n * 2048 + k * 1024); } while (0)
#define PG8_MMA(ai, bj, At, Bt) do { __builtin_amdgcn_s_setprio(1); _Pragma("unroll") for (int m = 0; m < 4; ++m) _Pragma("unroll") for (int n = 0; n < 2; ++n) _Pragma("unroll") for (int k = 0; k < 2; ++k) \
        acc[ai][bj][m][n] = __builtin_amdgcn_mfma_f32_16x16x32_bf16(Bt[n][k], At[m][k], acc[ai][bj][m][n], 0, 0, 0); __builtin_amdgcn_s_setprio(0); } while (0)
#define PG8_WAIT_V(n) asm volatile("s_waitcnt vmcnt(" #n ")" ::: "memory")
#define PG8_WAIT_L(n) asm volatile("s_waitcnt lgkmcnt(" #n ")" ::: "memory")
#define PG8_BAR __builtin_amdgcn_s_barrier()
#define PG8_SCHED __builtin_amdgcn_sched_barrier(0)
    Unit cur, nxt; int ui = 0;
    if (!S.next(0, cur)) return;
    f32x4 acc[2][2][4][2];
#pragma unroll
    for (int a = 0; a < 2; ++a)
#pragma unroll
        for (int b = 0; b < 2; ++b)
#pragma unroll
            for (int m = 0; m < 4; ++m)
#pragma unroll
                for (int n = 0; n < 2; ++n) acc[a][b][m][n] = (f32x4){0.f, 0.f, 0.f, 0.f};
    bf16x8 At[4][2], B0[2][2], B1[2][2];
    const char* cA = (const char*)g.A + (size_t)cur.pm * tstep; const char* cB = (const char*)g.Bt + (size_t)cur.pn * tstep;
    S.a_ready(cur);
    if constexpr (SP2) {
        PG8_STAGE(PG8_SB(0, 0), cB, voffB); PG8_STAGE(PG8_SB(0, 1), cB + hstep, voffB); PG8_STAGE(PG8_SA(0, 0), cA, voffA); PG8_STAGE(PG8_SA(0, 1), cA + hstep, voffA);
        if (wr == 1) PG8_BAR;
        PG8_WAIT_V(2); PG8_BAR;
        PG8_STAGE(PG8_SB(1, 0), cB + kstep, voffB); PG8_STAGE(PG8_SA(1, 0), cA + kstep, voffA); PG8_STAGE(PG8_SB(1, 1), cB + hstep + kstep, voffB);
        PG8_WAIT_V(6); PG8_BAR;
    } else {
        PG8_STAGE(PG8_SB(0, 0), cB, voffB); PG8_STAGE(PG8_SA(0, 0), cA, voffA); PG8_STAGE(PG8_SB(0, 1), cB + hstep, voffB); PG8_STAGE(PG8_SA(0, 1), cA + hstep, voffA);
        if (wr == 1) PG8_BAR;
        PG8_WAIT_V(4); PG8_BAR;
        PG8_STAGE(PG8_SB(1, 0), cB + kstep, voffB); PG8_STAGE(PG8_SA(1, 0), cA + kstep, voffA); PG8_STAGE(PG8_SB(1, 1), cB + hstep + kstep, voffB);
        PG8_WAIT_V(6); PG8_BAR;
    }
    for (;;) {
        const bool has_next = S.next(ui + 1, nxt);
        const char* nA = has_next ? (const char*)g.A + (size_t)nxt.pm * tstep : cA; const char* nB = has_next ? (const char*)g.Bt + (size_t)nxt.pn * tstep : cB;
        for (int t = 0; t < nt; t += 2) {
            const bool last = (t == nt - 2);
            const char* a1 = cA + (size_t)(t + 1) * kstep;
            const char* a2 = last ? nA : cA + (size_t)(t + 2) * kstep; const char* b2 = last ? nB : cB + (size_t)(t + 2) * kstep;
            const char* a3 = a2 + kstep; const char* b3 = b2 + kstep;
            if (last && has_next) S.a_ready(nxt);
            if constexpr (Epi::KSCALE) { if (t == Epi::KS1 || t == Epi::KS2) E.kscale(acc, ui, t == Epi::KS1 ? 0 : 1, wr, fr, lds); }
            if constexpr (SP2) {
            PG8_LDB(B0, 0, 0); PG8_LDB(B1, 0, 1); PG8_SCHED; PG8_LDA(At, 0, 0); PG8_STAGE(PG8_SA(1, 1), a1 + hstep, voffA);
            PG8_WAIT_V(8); PG8_WAIT_L(0); PG8_BAR; PG8_MMA(0, 0, At, B0); PG8_MMA(0, 1, At, B1); PG8_BAR; PG8_SCHED;
            PG8_LDA(At, 0, 1); PG8_STAGE(PG8_SB(0, 0), b2, voffB); PG8_STAGE(PG8_SB(0, 1), b2 + hstep, voffB); PG8_STAGE(PG8_SA(0, 0), a2, voffA);
            PG8_WAIT_V(8); PG8_WAIT_L(0); PG8_BAR; PG8_MMA(1, 0, At, B0); PG8_MMA(1, 1, At, B1); PG8_BAR; PG8_SCHED;
            PG8_LDB(B0, 1, 0); PG8_LDB(B1, 1, 1); PG8_SCHED; PG8_LDA(At, 1, 0); PG8_STAGE(PG8_SA(0, 1), a2 + hstep, voffA);
            PG8_WAIT_V(8); PG8_WAIT_L(0); PG8_BAR; PG8_MMA(0, 0, At, B0); PG8_MMA(0, 1, At, B1); PG8_BAR; PG8_SCHED;
            PG8_LDA(At, 1, 1); PG8_STAGE(PG8_SB(1, 0), b3, voffB); PG8_STAGE(PG8_SB(1, 1), b3 + hstep, voffB); PG8_STAGE(PG8_SA(1, 0), a3, voffA);
            PG8_WAIT_V(8); PG8_WAIT_L(0); PG8_BAR; PG8_MMA(1, 0, At, B0); PG8_MMA(1, 1, At, B1); PG8_BAR; PG8_SCHED;
            } else {
            PG8_LDB(B0, 0, 0); PG8_SCHED; PG8_LDA(At, 0, 0); PG8_STAGE(PG8_SA(1, 1), a1 + hstep, voffA);
            PG8_WAIT_L(8); PG8_BAR; PG8_WAIT_L(0); PG8_MMA(0, 0, At, B0); PG8_BAR; PG8_SCHED;
            PG8_LDB(B1, 0, 1); PG8_STAGE(PG8_SB(0, 0), b2, voffB);
            PG8_BAR; PG8_WAIT_L(0); PG8_MMA(0, 1, At, B1); PG8_BAR;
            PG8_LDA(At, 0, 1); PG8_STAGE(PG8_SA(0, 0), a2, voffA);
            PG8_BAR; PG8_WAIT_L(0); PG8_MMA(1, 0, At, B0); PG8_BAR; PG8_SCHED;
            PG8_STAGE(PG8_SB(0, 1), b2 + hstep, voffB);
            PG8_WAIT_V(6); PG8_BAR; PG8_MMA(1, 1, At, B1); PG8_BAR;
            PG8_LDB(B0, 1, 0); PG8_SCHED; PG8_LDA(At, 1, 0); PG8_STAGE(PG8_SA(0, 1), a2 + hstep, voffA);
            PG8_WAIT_L(8); PG8_BAR; PG8_WAIT_L(0); PG8_MMA(0, 0, At, B0); PG8_BAR; PG8_SCHED;
            PG8_LDB(B1, 1, 1); PG8_STAGE(PG8_SB(1, 0), b3, voffB);
            PG8_BAR; PG8_WAIT_L(0); PG8_MMA(0, 1, At, B1); PG8_BAR;
            PG8_LDA(At, 1, 1); PG8_STAGE(PG8_SA(1, 0), a3, voffA);
            PG8_BAR; PG8_WAIT_L(0); PG8_MMA(1, 0, At, B0); PG8_BAR; PG8_SCHED;
            PG8_STAGE(PG8_SB(1, 1), b3 + hstep, voffB);
            PG8_WAIT_V(6); PG8_BAR; PG8_MMA(1, 1, At, B1); PG8_BAR;
            }
        }
        if constexpr (ALIGN_EPI) { if (wr == 0) PG8_BAR; }
        if constexpr (!Epi::AFTER_DRAIN) { E(acc, cur, wr, wc, fr, fq, ui, lds); S.done(cur); }
        if (!has_next) break;
#pragma unroll
        for (int a = 0; a < 2; ++a)
#pragma unroll
            for (int b = 0; b < 2; ++b)
#pragma unroll
                for (int m = 0; m < 4; ++m)
#pragma unroll
                    for (int n = 0; n < 2; ++n) acc[a][b][m][n] = (f32x4){0.f, 0.f, 0.f, 0.f};
        cur = nxt; cA = nA; cB = nB; ++ui;
        if constexpr (ALIGN_EPI) { if (wr == 1) PG8_BAR; }
    }
    PG8_WAIT_V(0);
    if constexpr (!ALIGN_EPI) { if (wr == 0) PG8_BAR; }
    PG8_BAR;
    if constexpr (Epi::AFTER_DRAIN) { E.fused(acc, cur, wr, wc, fr, fq, lds, wid, lane); S.done(cur); }
#undef PG8_SA
#undef PG8_SB
#undef PG8_STAGE
#undef PG8_LDA
#undef PG8_LDB
#undef PG8_MMA
#undef PG8_WAIT_V
#undef PG8_WAIT_L
#undef PG8_BAR
#undef PG8_SCHED
}
}

typedef unsigned short bf16;
typedef unsigned v4u __attribute__((ext_vector_type(4)));
typedef unsigned v2u __attribute__((ext_vector_type(2)));
typedef float f32x4 __attribute__((ext_vector_type(4)));
constexpr int DM = 4096, NB = 4, SEQ = 2048, M = NB * SEQ, DEPTH = 4;
constexpr int WA = 1024, WB = 2048, WC = 1024, DMIX = 4096, HD = 64, NQH = 32, KVG = 8, NKV = 4;
constexpr int INW = 10752;
constexpr int LDK = 4096 + 64;
constexpr int OFF_AB = 0, OFF_AC = 1024, OFF_AX = 2048, OFF_AG = 3072, OFF_Q = 4096, OFF_K = 6144, OFF_V = 6400, OFF_BG = 6656, OFF_CX = 8704, OFF_CG = 9728;
constexpr int MIX_C = 0, MIX_B = 1024, MIX_A = 3072;
constexpr size_t CTL_SS = 65536;
constexpr size_t CTL_BYTES = 3u << 20, CTL_GR = 2u << 20;
constexpr size_t WS_WG = 8u << 20;
constexpr size_t CTL_GV = CTL_SS + (size_t)DEPTH * 2 * M * 8, CTL_BV = CTL_GV + (size_t)DEPTH * INW * 8, CTL_ST = CTL_BV + (size_t)DEPTH * INW * 8;
static_assert(CTL_ST + (size_t)DEPTH * M * 2 * 8 <= CTL_GR, "CTL map");
typedef unsigned long long fx_t;
constexpr size_t CTL_Q = 4096;
constexpr float ALPHA = 1.6817928305074290861f;
constexpr float LN_EPS = 1e-5f, RMS_EPS = 1e-6f;
constexpr size_t MiB = 1u << 20;
constexpr size_t WS_CTL = 0, WS_WIN = 16 * MiB, WS_WOUT = 360 * MiB, WS_XB = 492 * MiB, WS_H = 558 * MiB, WS_MIX = 726 * MiB, WS_Y = 792 * MiB, WS_END = 920 * MiB;
constexpr size_t WIN_L = (size_t)INW * LDK, WOUT_L = (size_t)DM * LDK;

__device__ __forceinline__ unsigned f2bf(float f) { unsigned u = __builtin_bit_cast(unsigned, f); return (u + 0x7fffu + ((u >> 16) & 1u)) >> 16; }
__device__ __forceinline__ unsigned pk2(float lo, float hi) { return f2bf(lo) | (f2bf(hi) << 16); }
__device__ __forceinline__ float bf2f(unsigned short b) { return __builtin_bit_cast(float, (unsigned)b << 16); }
__device__ __forceinline__ float bflo(unsigned w) { return __builtin_bit_cast(float, w << 16); }
__device__ __forceinline__ float bfhi(unsigned w) { return __builtin_bit_cast(float, w & 0xffff0000u); }
__device__ __forceinline__ float wave_sum(float v) {
#pragma unroll
    for (int o = 1; o < 64; o <<= 1) v += __shfl_xor(v, o);
    return v;
}
__device__ __forceinline__ float wave_max(float v) {
#pragma unroll
    for (int o = 1; o < 64; o <<= 1) v = fmaxf(v, __shfl_xor(v, o));
    return v;
}
__device__ __forceinline__ float silu(float x) { return x * __builtin_amdgcn_rcpf(1.f + __builtin_amdgcn_exp2f(x * -1.44269504088896341f)); }
__device__ __forceinline__ float sigmoidf(float x) { return 1.f / (1.f + __expf(-x)); }
#define LDS_WAIT() asm volatile("s_waitcnt lgkmcnt(0)" ::: "memory")

static_assert(WS_WIN + DEPTH * WIN_L * 2 <= WS_WOUT && WS_WOUT + DEPTH * WOUT_L * 2 <= WS_XB && WS_XB + (size_t)M * LDK * 2 <= WS_H && WS_H + (size_t)M * INW * 2 <= WS_MIX && WS_MIX + (size_t)M * LDK * 2 <= WS_Y && WS_Y + (size_t)M * DM * 4 <= WS_END, "workspace map");
#define XB_TMO      128
#define XB_XCNT(j)  (256  + 64 * (j))
#define XB_XSUB(j)  (1280 + 64 * (j))
#define XB_XGEN(j)  (2304 + 64 * (j))
#define XB_TOP      3328
#define XB_TOPGEN   3392
#define XCD_BAR_WORDS 3456
#define XB_SPIN_CAP (1u << 18)
#define LAS __attribute__((address_space(3)))

__device__ __forceinline__ unsigned xb_ld(unsigned* p)              { return __hip_atomic_load(p, __ATOMIC_RELAXED, __HIP_MEMORY_SCOPE_AGENT); }
__device__ __forceinline__ unsigned xb_add(unsigned* p, unsigned v) { return __hip_atomic_fetch_add(p, v, __ATOMIC_RELAXED, __HIP_MEMORY_SCOPE_AGENT); }
__device__ __forceinline__ unsigned xb_xcc_id() { return (unsigned)__builtin_amdgcn_s_getreg((3 << 11) | 20) & 0xFu; }
#define XB_SPIN(cond, bar) do { unsigned _sp = 0; while (cond) { __builtin_amdgcn_s_sleep(1); \
    if ((++_sp & 255u) == 0u) { if (xb_ld(&(bar)[XB_TMO])) break; if (_sp > XB_SPIN_CAP) { atomicAdd(&(bar)[XB_TMO], 1u); break; } } } } while (0)

struct XcdBarrier {
    unsigned* bar; unsigned x;
    volatile LAS unsigned* st;
};

__device__ __forceinline__ XcdBarrier xcd_barrier_post(unsigned* bar, volatile LAS unsigned* st) {
    XcdBarrier b; b.bar = bar; b.x = xb_xcc_id(); b.st = st;
    if (threadIdx.x == 0) (void)xb_add(&bar[XB_XCNT(b.x)], 1u);
    return b;
}
__device__ __forceinline__ void xcd_barrier_complete(unsigned* bar, unsigned x, unsigned& nloc, unsigned& nx) {
    const unsigned G = gridDim.x * gridDim.y * gridDim.z;
    unsigned sum, cnt, mine, sp = 0u;
    for (;;) {
        sum = 0u; cnt = 0u; mine = 0u;
#pragma unroll
        for (unsigned j = 0; j < 16; ++j) { const unsigned c = xb_ld(&bar[XB_XCNT(j)]); sum += c; cnt += (c > 0u) ? 1u : 0u; mine = (j == x) ? c : mine; }
        if (sum == G) break;
        __builtin_amdgcn_s_sleep(1);
        if ((++sp & 255u) == 0u) { if (xb_ld(&bar[XB_TMO])) break; if (sp > XB_SPIN_CAP) { atomicAdd(&bar[XB_TMO], 1u); break; } }
    }
    nloc = mine > 0u ? mine : 1u; nx = cnt > 0u ? cnt : 1u;
}

__device__ __forceinline__ void xcd_barrier(const XcdBarrier& b) {
    asm volatile("s_waitcnt vmcnt(0)" ::: "memory");
    __syncthreads();
    if (threadIdx.x == 0) {
        unsigned* bar = b.bar;
        __builtin_amdgcn_s_waitcnt(0);
        unsigned nloc = b.st[0], nx = b.st[1];
        if (nloc == 0u) { xcd_barrier_complete(bar, b.x, nloc, nx); b.st[0] = nloc; b.st[1] = nx; }
        const unsigned old = xb_add(&bar[XB_XSUB(b.x)], 1u);
        const unsigned gen = old / nloc;
        if (old + 1u == (gen + 1u) * nloc) {
            __builtin_amdgcn_fence(__ATOMIC_RELEASE, "agent");
            asm volatile("s_waitcnt vmcnt(0)" ::: "memory");
            const unsigned og = xb_add(&bar[XB_TOP], 1u);
            const unsigned tg = og / nx;
            if (og + 1u == (tg + 1u) * nx) xb_add(&bar[XB_TOPGEN], 1u);
            else XB_SPIN(xb_ld(&bar[XB_TOPGEN]) == tg, bar);
            __builtin_amdgcn_fence(__ATOMIC_ACQUIRE, "agent");
            xb_add(&bar[XB_XGEN(b.x)], 1u);
            asm volatile("s_waitcnt vmcnt(0)" ::: "memory");
        } else {
            XB_SPIN(xb_ld(&bar[XB_XGEN(b.x)]) == gen, bar);
            __builtin_amdgcn_fence(__ATOMIC_ACQUIRE, "agent");
            asm volatile("s_waitcnt vmcnt(0)" ::: "memory");
        }
    }
    __syncthreads();
}
constexpr int NWAVES = 8, NTHR = 512;
constexpr int LDS_MISC = 131072 + 320, LDS_BYTES = 163840;
#define VM_WAIT() asm volatile("s_waitcnt vmcnt(0)" ::: "memory")

template <bool KPERM, bool GFOLD> __device__ __forceinline__ void convert_task(const float* __restrict__ W, bf16* __restrict__ WT, int ldt, int N, LAS float* scr, int nb, int kb0, int nkb, int lane,
                                                                               const float* __restrict__ gvec, const float* __restrict__ bvec, fx_t* __restrict__ Gout, fx_t* __restrict__ Bout) {
    const int n0 = 64 * nb, c = lane & 7, nr = lane >> 3;
    const __amdgpu_buffer_rsrc_t rsW = __builtin_amdgcn_make_buffer_rsrc((void*)W, (short)0, 0x7ffffff0, 0x00020000);
    float gacc[8], bacc[8];
#pragma unroll
    for (int j = 0; j < 8; ++j) { gacc[j] = 0.f; bacc[j] = 0.f; }
    for (int kb = kb0; kb < kb0 + nkb; ++kb) {
        const int k0 = 64 * kb;
        const int ks = KPERM ? (k0 < 1024 ? k0 + 3072 : (k0 < 3072 ? k0 : k0 - 3072)) : k0;
        const int kr = lane >> 4, cq = lane & 15;
        const int voff = (kr * N + 4 * cq) * 4;
        f32x4 r[16];
#pragma unroll
        for (int i = 0; i < 16; ++i) r[i] = __builtin_bit_cast(f32x4, __builtin_amdgcn_raw_buffer_load_b128(rsW, voff, ((ks + 4 * i) * N + n0) * 4, 2));
#pragma unroll
        for (int i = 0; i < 16; ++i) { const int row = 4 * i + kr; *(LAS f32x4*)(scr + row * 64 + ((4 * cq) ^ (8 * (row >> 3)))) = r[i]; }
        LDS_WAIT();
        float gk[8], bk[8];
        if (GFOLD) { const f32x4 g0 = *(const f32x4*)(gvec + k0 + 8 * c), g1 = *(const f32x4*)(gvec + k0 + 8 * c + 4), b0 = *(const f32x4*)(bvec + k0 + 8 * c), b1 = *(const f32x4*)(bvec + k0 + 8 * c + 4);
#pragma unroll
            for (int e = 0; e < 4; ++e) { gk[e] = g0[e]; gk[4 + e] = g1[e]; bk[e] = b0[e]; bk[4 + e] = b1[e]; } }
#pragma unroll
        for (int j = 0; j < 8; ++j) { const int n = nr + 8 * j; const LAS float* s = scr + (8 * c) * 64 + (n ^ (8 * c));
            float v[8];
#pragma unroll
            for (int e = 0; e < 8; ++e) { v[e] = s[e * 64]; if (GFOLD) { bacc[j] += bk[e] * v[e]; v[e] *= gk[e]; } }
            v4u o; o.x = pk2(v[0], v[1]); o.y = pk2(v[2], v[3]); o.z = pk2(v[4], v[5]); o.w = pk2(v[6], v[7]);
            *(v4u*)(WT + (size_t)(n0 + n) * ldt + k0 + 8 * c) = o;
            if (GFOLD) gacc[j] += ((bflo(o.x) + bfhi(o.x)) + (bflo(o.y) + bfhi(o.y))) + ((bflo(o.z) + bfhi(o.z)) + (bflo(o.w) + bfhi(o.w))); }
        LDS_WAIT();
    }
    if (GFOLD) {
#pragma unroll
        for (int j = 0; j < 8; ++j) { float gp = gacc[j], bp = bacc[j];
            gp += __shfl_xor(gp, 1); gp += __shfl_xor(gp, 2); gp += __shfl_xor(gp, 4); bp += __shfl_xor(bp, 1); bp += __shfl_xor(bp, 2); bp += __shfl_xor(bp, 4);
            if (c == 0) { pg8::fx_add(Gout + n0 + nr + 8 * j, gp); pg8::fx_add(Bout + n0 + nr + 8 * j, bp); } } }
}
constexpr int CV_NK = 2, CV_KQ = DM / 64 / CV_NK, CV_T_IN = (INW / 64) * CV_KQ, CV_T_OUT = (DM / 64) * CV_KQ, CV_T_L = CV_T_IN + CV_T_OUT;
__device__ __forceinline__ void convert_layer(const float* __restrict__ w_in, const float* __restrict__ w_out, const float* __restrict__ ln_g, const float* __restrict__ ln_b, unsigned char* ws, int ll, LAS float* scr, int wv, int nwv, int lane) {
    for (int r = wv; r < CV_T_L; r += nwv) {
        if (r < CV_T_IN) { const int kq = r % CV_KQ, nb = r / CV_KQ;
            if (ll == 0) convert_task<false, false>(w_in, (bf16*)(ws + WS_WIN), LDK, INW, scr, nb, kq * CV_NK, CV_NK, lane, nullptr, nullptr, nullptr, nullptr);
            else convert_task<false, true>(w_in + (size_t)ll * DM * INW, (bf16*)(ws + WS_WIN) + (size_t)ll * WIN_L, LDK, INW, scr, nb, kq * CV_NK, CV_NK, lane, ln_g + (size_t)(ll - 1) * DM, ln_b + (size_t)(ll - 1) * DM,
                                                (fx_t*)(ws + WS_CTL + CTL_GV) + (size_t)ll * INW, (fx_t*)(ws + WS_CTL + CTL_BV) + (size_t)ll * INW); }
        else { const int r2 = r - CV_T_IN, kq = r2 % CV_KQ, nb = r2 / CV_KQ;
            convert_task<true, false>(w_out + (size_t)ll * DMIX * DM, (bf16*)(ws + WS_WOUT) + (size_t)ll * WOUT_L, LDK, DM, scr, nb, kq * CV_NK, CV_NK, lane, nullptr, nullptr, nullptr, nullptr); }
    }
}

__device__ __forceinline__ void branch_a_pair(const bf16* __restrict__ h, const float* __restrict__ cw, const float* __restrict__ nrm, bf16* __restrict__ mix, int t0, int lane) {
    const int s0 = t0 % SEQ;
    const bf16* hr = h + (size_t)t0 * INW;
    float y[2][16], ss[2] = {0.f, 0.f}; v4u agk[2][2];
#pragma unroll
    for (int j = 0; j < 2; ++j) {
        const int ch0 = j * 512 + lane * 8;
        v4u cr[4], xr[4], ab[2];
#pragma unroll
        for (int i = 0; i < 4; ++i) { cr[i] = (v4u){0u, 0u, 0u, 0u}; xr[i] = (v4u){0u, 0u, 0u, 0u};
            if (i >= 2 || s0 > 0) { cr[i] = *(const v4u*)(hr + (long)(i - 2) * INW + OFF_AC + ch0); xr[i] = *(const v4u*)(hr + (long)(i - 2) * INW + OFF_AX + ch0); } }
#pragma unroll
        for (int i = 0; i < 2; ++i) { ab[i] = *(const v4u*)(hr + (size_t)i * INW + OFF_AB + ch0); agk[i][j] = *(const v4u*)(hr + (size_t)i * INW + OFF_AG + ch0); }
        float w0[8], w1[8], w2[8];
        { const f32x4 a0 = *(const f32x4*)(cw + ch0), a1 = *(const f32x4*)(cw + ch0 + 4), b0 = *(const f32x4*)(cw + 1024 + ch0), b1 = *(const f32x4*)(cw + 1024 + ch0 + 4),
                      c0 = *(const f32x4*)(cw + 2048 + ch0), c1 = *(const f32x4*)(cw + 2048 + ch0 + 4);
#pragma unroll
          for (int e = 0; e < 4; ++e) { w0[e] = a0[e]; w0[4 + e] = a1[e]; w1[e] = b0[e]; w1[4 + e] = b1[e]; w2[e] = c0[e]; w2[4 + e] = c1[e]; } }
        float p[4][8];
#pragma unroll
        for (int i = 0; i < 4; ++i)
#pragma unroll
            for (int e = 0; e < 8; ++e) { const int w = e >> 1; p[i][e] = (e & 1) ? bfhi(cr[i][w]) * bfhi(xr[i][w]) : bflo(cr[i][w]) * bflo(xr[i][w]); }
#pragma unroll
        for (int i = 0; i < 2; ++i)
#pragma unroll
            for (int e = 0; e < 8; ++e) { const int w = e >> 1;
                const float cv = w0[e] * p[i][e] + w1[e] * p[i + 1][e] + w2[e] * p[i + 2][e];
                const float yv = ((e & 1) ? bfhi(ab[i][w]) : bflo(ab[i][w])) * cv; y[i][j * 8 + e] = yv; ss[i] += yv * yv; }
    }
#pragma unroll
    for (int i = 0; i < 2; ++i) { const float rstd = rsqrtf(wave_sum(ss[i]) * (1.f / WA) + RMS_EPS);
#pragma unroll
        for (int j = 0; j < 2; ++j) { const int ch0 = j * 512 + lane * 8; const f32x4 n0 = *(const f32x4*)(nrm + ch0), n1 = *(const f32x4*)(nrm + ch0 + 4); const v4u ag = agk[i][j]; float ov[8];
#pragma unroll
            for (int e = 0; e < 8; ++e) { const int w = e >> 1; ov[e] = y[i][j * 8 + e] * rstd * ((e < 4) ? n0[e & 3] : n1[e & 3]) * silu((e & 1) ? bfhi(ag[w]) : bflo(ag[w])); }
            v4u o; o.x = pk2(ov[0], ov[1]); o.y = pk2(ov[2], ov[3]); o.z = pk2(ov[4], ov[5]); o.w = pk2(ov[6], ov[7]);
            *(v4u*)(mix + (size_t)(t0 + i) * LDK + MIX_A + ch0) = o; } }
}
typedef short s16x8 __attribute__((ext_vector_type(8)));
typedef float f32x16 __attribute__((ext_vector_type(16)));
typedef __bf16 bf16x2_t __attribute__((ext_vector_type(2)));
typedef float f32x2_t __attribute__((ext_vector_type(2)));
__device__ __forceinline__ unsigned cvtpk(float lo, float hi) { const f32x2_t v = {lo, hi}; return __builtin_bit_cast(unsigned, __builtin_convertvector(v, bf16x2_t)); }
constexpr int ATT_KROW = 144, ATT_VROW = 520, ATT_K_OFF = 0, ATT_V_OFF = 256 * ATT_KROW;
__device__ __forceinline__ void attn_unit(const bf16* __restrict__ h, const float* __restrict__ sinks, const float* __restrict__ nrm, bf16* __restrict__ mix, fx_t* __restrict__ ssb, LAS unsigned char* lds, int task, const int tid) {
    const int n = task & 15, kvh = (task >> 4) & 3, b = task >> 6;
    const int lane = tid & 63, wave = tid >> 6;
    for (int pc = tid; pc < 2048; pc += NTHR) {
        const int j = pc >> 3, q = pc & 7, pos = 128 * n - 128 + j;
        v4u kv = {0u, 0u, 0u, 0u}, vv = {0u, 0u, 0u, 0u};
        if (pos >= 0) { const bf16* row = h + (size_t)(b * SEQ + pos) * INW; kv = *(const v4u*)(row + OFF_K + kvh * 64 + 8 * q); vv = *(const v4u*)(row + OFF_V + kvh * 64 + 8 * q); }
        *(LAS v4u*)(lds + ATT_K_OFF + j * ATT_KROW + 16 * q) = kv;
        LAS unsigned short* vt = (LAS unsigned short*)(lds + ATT_V_OFF) + (8 * q) * (ATT_VROW / 2) + j;
#pragma unroll
        for (int e = 0; e < 8; ++e) vt[e * (ATT_VROW / 2)] = (unsigned short)((e & 1) ? (vv[e >> 1] >> 16) : (vv[e >> 1] & 0xffffu));
    }
    __syncthreads();
    const int hq = kvh * 8 + wave; const float sink = sinks[hq];
    const int r = lane & 31, hh = lane >> 5; const bool first_blk = (n == 0);
    constexpr float LOG2E = 1.44269504088896341f, SC = 0.125f * LOG2E;
    const size_t tq0 = (size_t)b * SEQ + 128 * n + r;
    s16x8 qf[4];
    { const bf16* hrow = h + tq0 * INW;
#pragma unroll
      for (int s = 0; s < 4; ++s) qf[s] = *(const s16x8*)(hrow + OFF_Q + hq * 64 + 8 * hh + 16 * s); }
#pragma unroll 1
    for (int qs = 0; qs < 4; ++qs) {
        const size_t t = tq0 + 32 * qs;
        s16x8 qn[4]; v2u gw[2][4];
        { const bf16* hrow = h + (t + (qs < 3 ? 32 : 0)) * INW;
#pragma unroll
          for (int s = 0; s < 4; ++s) qn[s] = *(const s16x8*)(hrow + OFF_Q + hq * 64 + 8 * hh + 16 * s);
          const bf16* grow = h + t * INW;
#pragma unroll
          for (int dt = 0; dt < 2; ++dt)
#pragma unroll
              for (int g = 0; g < 4; ++g) gw[dt][g] = *(const v2u*)(grow + OFF_BG + hq * 64 + 32 * dt + 8 * g + 4 * hh); }
        f32x16 sc[5];
#pragma unroll
        for (int ci = 0; ci < 5; ++ci) {
            const LAS unsigned char* kp = lds + ATT_K_OFF + (32 * (qs + ci) + r) * ATT_KROW + 16 * hh;
            f32x16 acc;
#pragma unroll
            for (int i = 0; i < 16; ++i) acc[i] = 0.f;
#pragma unroll
            for (int s = 0; s < 4; ++s) { const s16x8 kf = *(const LAS s16x8*)(kp + 32 * s); acc = __builtin_amdgcn_mfma_f32_32x32x16_bf16(kf, qf[s], acc, 0, 0, 0); }
            sc[ci] = acc;
        }
        float mx = -1e30f;
#pragma unroll
        for (int ci = 0; ci < 5; ++ci)
#pragma unroll
            for (int i = 0; i < 16; ++i) { const int kk = (i & 3) + 8 * (i >> 2) + 4 * hh;
                const bool valid = ((ci == 0) ? (kk > r) : ((ci == 4) ? (kk <= r) : true)) && !(first_blk && qs + ci < 4);
                const float v = valid ? sc[ci][i] : -1e30f; sc[ci][i] = v; mx = fmaxf(mx, v); }
        mx = fmaxf(mx, __shfl_xor(mx, 32));
        const float m = fmaxf(mx * 0.125f, sink), mb = m * LOG2E;
        float sum = 0.f;
#pragma unroll
        for (int ci = 0; ci < 5; ++ci)
#pragma unroll
            for (int i = 0; i < 16; ++i) { const float p = __builtin_amdgcn_exp2f(sc[ci][i] * SC - mb); sc[ci][i] = p; sum += p; }
        sum += __shfl_xor(sum, 32);
        const float inv = 1.f / (sum + __builtin_amdgcn_exp2f((sink - m) * LOG2E));
        f32x16 o[2];
#pragma unroll
        for (int i = 0; i < 16; ++i) { o[0][i] = 0.f; o[1][i] = 0.f; }
#pragma unroll
        for (int ci = 0; ci < 5; ++ci)
#pragma unroll
            for (int s2 = 0; s2 < 2; ++s2) {
                v4u pw; pw.x = cvtpk(sc[ci][8 * s2 + 0], sc[ci][8 * s2 + 1]); pw.y = cvtpk(sc[ci][8 * s2 + 2], sc[ci][8 * s2 + 3]); pw.z = cvtpk(sc[ci][8 * s2 + 4], sc[ci][8 * s2 + 5]); pw.w = cvtpk(sc[ci][8 * s2 + 6], sc[ci][8 * s2 + 7]);
                const s16x8 pf = __builtin_bit_cast(s16x8, pw);
                const int key0 = 32 * (qs + ci) + 16 * s2 + 4 * hh;
#pragma unroll
                for (int dt = 0; dt < 2; ++dt) { const LAS unsigned char* vp = lds + ATT_V_OFF + (32 * dt + r) * ATT_VROW + 2 * key0;
                    const v2u lo = *(const LAS v2u*)vp, hi = *(const LAS v2u*)(vp + 16);
                    v4u vw; vw.x = lo.x; vw.y = lo.y; vw.z = hi.x; vw.w = hi.y;
                    o[dt] = __builtin_amdgcn_mfma_f32_32x32x16_bf16(__builtin_bit_cast(s16x8, vw), pf, o[dt], 0, 0, 0); }
            }
        float ssq = 0.f;
#pragma unroll
        for (int dt = 0; dt < 2; ++dt)
#pragma unroll
            for (int i = 0; i < 16; ++i) { const float y = o[dt][i] * inv; o[dt][i] = y; ssq += y * y; }
        ssq += __shfl_xor(ssq, 32);
        if (hh == 0) pg8::fx_add(ssb + t, ssq);
#pragma unroll
        for (int dt = 0; dt < 2; ++dt)
#pragma unroll
            for (int g = 0; g < 4; ++g) { const int cc = hq * 64 + 32 * dt + 8 * g + 4 * hh;
                const v2u gwv = gw[dt][g]; const f32x4 nv = *(const f32x4*)(nrm + cc);
                v2u ov; ov.x = cvtpk(o[dt][4 * g + 0] * nv[0] * silu(bflo(gwv.x)), o[dt][4 * g + 1] * nv[1] * silu(bfhi(gwv.x)));
                ov.y = cvtpk(o[dt][4 * g + 2] * nv[2] * silu(bflo(gwv.y)), o[dt][4 * g + 3] * nv[3] * silu(bfhi(gwv.y)));
                *(v2u*)(mix + t * LDK + MIX_B + cc) = ov; }
#pragma unroll
        for (int s = 0; s < 4; ++s) qf[s] = qn[s];
    }
    __syncthreads();
}
constexpr int RG_TOK = 128, RG_ROW = 272, RG_HP_OFF = RG_TOK * RG_ROW, RG_HP_ROW = 576, RG_CARRY_OFF = RG_HP_OFF + RG_TOK * RG_HP_ROW;
__device__ __forceinline__ void rg_unit(const bf16* __restrict__ h, const float* __restrict__ ccw, const float* __restrict__ ccb, const bf16* __restrict__ wg, const float* __restrict__ br, const float* __restrict__ bi,
                                        const float* __restrict__ lam, const float* __restrict__ nrm, bf16* __restrict__ mix, fx_t* __restrict__ ssc, unsigned long long* gran, unsigned* tmo, const unsigned epoch,
                                        LAS unsigned char* lds, const int c, const int hd, const int b, const int tid) {
    const int lane = tid & 63, wave = tid >> 6;
    const size_t T0 = (size_t)b * SEQ + RG_TOK * c;
    constexpr float LOG2E = 1.44269504088896341f;
    const int l15 = lane & 15, lg = lane >> 4, chl = 16 * wave + l15, ch = hd * 128 + chl;
    s16x8 Br[4], Bi[4];
    { const bf16* wrp = wg + ((size_t)hd * 128 + chl) * 128 + 8 * lg; const bf16* wip = wrp + (size_t)8 * 128 * 128;
#pragma unroll
      for (int s = 0; s < 4; ++s) { Br[s] = *(const s16x8*)(wrp + 32 * s); Bi[s] = *(const s16x8*)(wip + 32 * s); } }
    const float brv = br[ch] * LOG2E, biv = bi[ch] * LOG2E, L2 = -8.f * log1pf(expf(-lam[ch])) * LOG2E;
    {
        const int g = tid & 15, tr = tid >> 4, ch = hd * 128 + 8 * g;
        float w[4][8], bs[8];
#pragma unroll
        for (int k = 0; k < 4; ++k) { const f32x4 a = *(const f32x4*)(ccw + k * 1024 + ch), q = *(const f32x4*)(ccw + k * 1024 + ch + 4);
#pragma unroll
            for (int e = 0; e < 4; ++e) { w[k][e] = a[e]; w[k][4 + e] = q[e]; } }
        { const f32x4 a = *(const f32x4*)(ccb + ch), q = *(const f32x4*)(ccb + ch + 4);
#pragma unroll
          for (int e = 0; e < 4; ++e) { bs[e] = a[e]; bs[4 + e] = q[e]; } }
        v4u rows[7];
#pragma unroll
        for (int i = 0; i < 7; ++i) { const int trow = 4 * tr - 3 + i; const bool ok = (c > 0) || (trow >= 0);
            v4u z = {0u, 0u, 0u, 0u}; if (ok) z = *(const v4u*)(h + (size_t)((long)T0 + trow) * INW + OFF_CX + ch); rows[i] = z; }
#pragma unroll
        for (int i = 0; i < 4; ++i) { float o[8];
#pragma unroll
            for (int e = 0; e < 8; ++e) { float acc = bs[e];
#pragma unroll
                for (int k = 0; k < 4; ++k) { const unsigned wd = rows[i + k][e >> 1]; acc += w[k][e] * ((e & 1) ? bfhi(wd) : bflo(wd)); }
                o[e] = acc; }
            v4u ov; ov.x = cvtpk(o[0], o[1]); ov.y = cvtpk(o[2], o[3]); ov.z = cvtpk(o[4], o[5]); ov.w = cvtpk(o[6], o[7]);
            *(LAS v4u*)(lds + (4 * tr + i) * RG_ROW + 16 * g) = ov; }
    }
    __syncthreads();
    float Prun = 1.f, Hrun = 0.f;
    {
#pragma unroll 2
        for (int tt = 0; tt < RG_TOK / 16; ++tt) {
            const LAS unsigned char* ap = lds + (16 * tt + l15) * RG_ROW + 16 * lg;
            pg8::f32x4 ar = {0.f, 0.f, 0.f, 0.f}, ai = {0.f, 0.f, 0.f, 0.f};
#pragma unroll
            for (int s = 0; s < 4; ++s) { const s16x8 af = *(const LAS s16x8*)(ap + 64 * s);
                ar = __builtin_amdgcn_mfma_f32_16x16x32_bf16(af, Br[s], ar, 0, 0, 0); ai = __builtin_amdgcn_mfma_f32_16x16x32_bf16(af, Bi[s], ai, 0, 0, 0); }
            float pl[4], hl[4]; float P = 1.f, H = 0.f;
#pragma unroll
            for (int rg = 0; rg < 4; ++rg) { const int trow = 16 * tt + 4 * lg + rg;
                const float xcv = bf2f(*(const LAS unsigned short*)(lds + trow * RG_ROW + 2 * chl));
                const float rr = __builtin_amdgcn_rcpf(1.f + __builtin_amdgcn_exp2f(-(ar[rg] * LOG2E + brv)));
                const float ig = __builtin_amdgcn_rcpf(1.f + __builtin_amdgcn_exp2f(-(ai[rg] * LOG2E + biv)));
                const float a = __builtin_amdgcn_exp2f(rr * L2);
                const float u = __builtin_amdgcn_sqrtf(fmaxf(fmaf(-a, a, 1.f), 0.f)) * (ig * xcv);
                H = a * H + u; P = a * P; pl[rg] = P; hl[rg] = H; }
            float myP = Prun, myH = Hrun, Pst = Prun, Hst = Hrun;
#pragma unroll
            for (int x = 0; x < 4; ++x) { const float Ax = __shfl(P, l15 + 16 * x), Hx = __shfl(H, l15 + 16 * x);
                if (x == lg) { myP = Pst; myH = Hst; }
                Hst = Ax * Hst + Hx; Pst = Ax * Pst; }
            Prun = Pst; Hrun = Hst;
#pragma unroll
            for (int rg = 0; rg < 4; ++rg) *(LAS unsigned*)(lds + RG_HP_OFF + (16 * tt + 4 * lg + rg) * RG_HP_ROW + 4 * chl) = cvtpk(hl[rg] + pl[rg] * myH, pl[rg] * myP);
        }
    }
    unsigned gwv[RG_TOK / 8];
    { const size_t tbq = T0 + wave * (RG_TOK / 8);
#pragma unroll
      for (int i = 0; i < RG_TOK / 8; ++i) gwv[i] = *(const unsigned*)(h + (tbq + i) * INW + OFF_CG + hd * 128 + 2 * lane); }
    if (lg == 0) { unsigned long long* gp = gran + ((((size_t)b * 8 + hd) * 16 + c) * 128 + chl) * 2;
        __hip_atomic_store(gp, ((unsigned long long)epoch << 32) | __builtin_bit_cast(unsigned, Prun), __ATOMIC_RELAXED, __HIP_MEMORY_SCOPE_AGENT);
        __hip_atomic_store(gp + 1, ((unsigned long long)epoch << 32) | __builtin_bit_cast(unsigned, Hrun), __ATOMIC_RELAXED, __HIP_MEMORY_SCOPE_AGENT); }
    if (tid < 128) {
        const unsigned long long* gq = gran + (((size_t)b * 8 + hd) * 16 * 128 + tid) * 2;
        float Av[15], Hv[15]; unsigned spins = 0;
        for (;;) { bool ok = true;
#pragma unroll
            for (int cp = 0; cp < 15; ++cp) { Av[cp] = 1.f; Hv[cp] = 0.f;
                if (cp < c) { const unsigned long long xa = __hip_atomic_load(gq + cp * 256, __ATOMIC_RELAXED, __HIP_MEMORY_SCOPE_AGENT), xh = __hip_atomic_load(gq + cp * 256 + 1, __ATOMIC_RELAXED, __HIP_MEMORY_SCOPE_AGENT);
                    ok = ok && ((unsigned)(xa >> 32) == epoch) && ((unsigned)(xh >> 32) == epoch); Av[cp] = __builtin_bit_cast(float, (unsigned)xa); Hv[cp] = __builtin_bit_cast(float, (unsigned)xh); } }
            if (ok) break;
            if (++spins > 40000u) { __hip_atomic_store(tmo, 1u, __ATOMIC_RELAXED, __HIP_MEMORY_SCOPE_AGENT); break; }
            __builtin_amdgcn_s_sleep(2); }
        float carry = 0.f;
#pragma unroll
        for (int cp = 0; cp < 15; ++cp) if (cp < c) carry = Av[cp] * carry + Hv[cp];
        ((LAS float*)(lds + RG_CARRY_OFF))[tid] = carry;
    }
    __syncthreads();
    {
        const float n0 = nrm[hd * 128 + 2 * lane], n1 = nrm[hd * 128 + 2 * lane + 1];
        const float c0 = ((const LAS float*)(lds + RG_CARRY_OFF))[2 * lane], c1 = ((const LAS float*)(lds + RG_CARRY_OFF))[2 * lane + 1];
        const size_t tb = T0 + wave * (RG_TOK / 8);
        float ssq[RG_TOK / 8];
#pragma unroll
        for (int i = 0; i < RG_TOK / 8; ++i) { const int row = wave * (RG_TOK / 8) + i;
            const v2u hw = *(const LAS v2u*)(lds + RG_HP_OFF + row * RG_HP_ROW + 8 * lane);
            const float y0 = bflo(hw.x) + bfhi(hw.x) * c0, y1 = bflo(hw.y) + bfhi(hw.y) * c1;
            ssq[i] = y0 * y0 + y1 * y1;
            *(unsigned*)(mix + (tb + i) * LDK + MIX_C + hd * 128 + 2 * lane) = cvtpk(y0 * n0 * silu(bflo(gwv[i])), y1 * n1 * silu(bfhi(gwv[i]))); }
#pragma unroll
        for (int st = 0; st < 4; ++st) { const int hm = 8 >> st, bit = 1 << st;
            const bool up = (lane & bit) != 0;
#pragma unroll
            for (int k = 0; k < hm; ++k) { const float mine = up ? ssq[k + hm] : ssq[k], other = up ? ssq[k] : ssq[k + hm]; ssq[k] = mine + __shfl_xor(other, bit); } }
        float tot = ssq[0]; tot += __shfl_xor(tot, 16); tot += __shfl_xor(tot, 32);
        if (lane < 16) { const int row = 8 * (lane & 1) + 4 * ((lane >> 1) & 1) + 2 * ((lane >> 2) & 1) + ((lane >> 3) & 1); pg8::fx_add(ssc + tb + row, tot); }
    }
    __syncthreads();
}
__device__ __forceinline__ void final_ln_token(const bf16* __restrict__ yb, const fx_t* __restrict__ st, const float* __restrict__ g, const float* __restrict__ bta, float* __restrict__ xo, int t, int lane) {
    const float s = pg8::fx_get(st + 2 * (size_t)t), q = pg8::fx_get(st + 2 * (size_t)t + 1);
    const float mean = s * (1.f / DM), rstd = rsqrtf(fmaxf(q * (1.f / DM) - mean * mean, 0.f) + LN_EPS);
#pragma unroll
    for (int j = 0; j < 8; ++j) { const int cc = 8 * (lane + 64 * j);
        const v4u hw = *(const v4u*)(yb + (size_t)t * LDK + cc);
        const f32x4 g0 = *(const f32x4*)(g + cc), g1 = *(const f32x4*)(g + cc + 4), b0 = *(const f32x4*)(bta + cc), b1 = *(const f32x4*)(bta + cc + 4);
        f32x4 o0, o1;
        o0[0] = (bflo(hw[0]) - mean) * rstd * g0[0] + b0[0]; o0[1] = (bfhi(hw[0]) - mean) * rstd * g0[1] + b0[1];
        o0[2] = (bflo(hw[1]) - mean) * rstd * g0[2] + b0[2]; o0[3] = (bfhi(hw[1]) - mean) * rstd * g0[3] + b0[3];
        o1[0] = (bflo(hw[2]) - mean) * rstd * g1[0] + b1[0]; o1[1] = (bfhi(hw[2]) - mean) * rstd * g1[1] + b1[1];
        o1[2] = (bflo(hw[3]) - mean) * rstd * g1[2] + b1[2]; o1[3] = (bfhi(hw[3]) - mean) * rstd * g1[3] + b1[3];
        __builtin_nontemporal_store(o0, (f32x4*)(xo + (size_t)t * DM + cc)); __builtin_nontemporal_store(o1, (f32x4*)(xo + (size_t)t * DM + cc + 4)); }
}

struct Args { const float* in[17]; float* out; unsigned char* ws; };
#define KA_AS __attribute__((address_space(4)))
#define AIN(k) (*(const float* const KA_AS*)(ka_ + 8 * (k)))
#define AOUT (*(float* const KA_AS*)(ka_ + 8 * 17))
#define AWS (*(unsigned char* const KA_AS*)(ka_ + 8 * 18))
#define TZ_INIT() const KA_AS unsigned char* ka_ = (const KA_AS unsigned char*)__builtin_amdgcn_kernarg_segment_ptr(); asm volatile("" : "+s"(ka_)); int lz = l_; asm volatile("" : "+s"(lz)); const int l = lz; (void)l; int tz = threadIdx.x; asm volatile("" : "+v"(tz)); const int tid = tz, lane = tz & 63, wave = __builtin_amdgcn_readfirstlane(tz >> 6); const int G = gridDim.x, gw = blockIdx.x * NWAVES + wave, NGW = G * NWAVES; (void)tid; (void)lane; (void)gw; (void)NGW
__global__ void __launch_bounds__(NTHR, 2) fwd(Args args) {
    extern __shared__ __attribute__((aligned(16))) unsigned char lds_raw[];
    LAS unsigned char* lds = (LAS unsigned char*)lds_raw;
    volatile LAS unsigned* MISC = (volatile LAS unsigned*)(lds + LDS_MISC);
    for (int u = threadIdx.x; u < (LDS_BYTES - 131072) / 4; u += NTHR) ((LAS unsigned*)(lds + 131072))[u] = 0u;
    __syncthreads();
    (void)xcd_barrier_post((unsigned*)(args.ws + WS_CTL) + 4096, MISC + 8);
#define GRID_BARRIER() do { XcdBarrier b_; b_.bar = (unsigned*)(args.ws + WS_CTL) + 4096; b_.x = xb_xcc_id(); b_.st = (volatile LAS unsigned*)(lds + LDS_MISC) + 8; xcd_barrier(b_); } while (0)
#define WSP(T, off) ((T*)(AWS + (off)))

    {
        const int l_ = 0; TZ_INIT();
        LAS float* scr = (LAS float*)(lds + wave * 16384);
        for (int ll = 0; ll < DEPTH; ++ll) convert_layer(AIN(1), AIN(14), AIN(15), AIN(16), AWS, ll, scr, gw, NGW, lane);
        for (int it = gw; it < DEPTH * 2 * 8 * 2; it += NGW) {
            const int nb = it & 1, hd = (it >> 1) & 7, gate = (it >> 4) & 1, ll = it >> 5;
            convert_task<false, false>(AIN(gate ? 8 : 6) + ((size_t)ll * 8 + hd) * 128 * 128, WSP(bf16, WS_WG) + (((size_t)ll * 2 + gate) * 8 + hd) * 128 * 128, 128, 128, scr, nb, 0, 2, lane, nullptr, nullptr, nullptr, nullptr); }
        const float* x = AIN(0); bf16* xb = WSP(bf16, WS_XB);
        for (size_t i = (size_t)blockIdx.x * NTHR + tid; i < (size_t)M * DM / 8; i += (size_t)G * NTHR) {
            const f32x4 a = ((const f32x4*)x)[2 * i], b = ((const f32x4*)x)[2 * i + 1];
            v4u o; o.x = pk2(a[0], a[1]); o.y = pk2(a[2], a[3]); o.z = pk2(b[0], b[1]); o.w = pk2(b[2], b[3]);
            const size_t row = i / (DM / 8), cc = i % (DM / 8);
            *(v4u*)(xb + row * LDK + 8 * cc) = o; }
    }
    GRID_BARRIER();
    for (int l_ = 0; l_ < DEPTH; ++l_) {
#define GEMM1_TABLES(S_) do { const fx_t* stp = WSP(fx_t, WS_CTL + CTL_ST) + (size_t)(l > 0 ? l - 1 : 0) * M * 2; const fx_t* Gv = WSP(fx_t, WS_CTL + CTL_GV) + (size_t)l * INW; const fx_t* Bvv = WSP(fx_t, WS_CTL + CTL_BV) + (size_t)l * INW; \
            _Pragma("unroll") for (int i = 0; i < 6; ++i) { pg8::Unit u; if ((S_).next(i, u)) { \
                if (tid < 256) { float mu = 0.f, rs = 1.f; \
                    if (l > 0) { const float s = pg8::fx_get(stp + 2 * (size_t)(u.pm * 256 + tid)), q = pg8::fx_get(stp + 2 * (size_t)(u.pm * 256 + tid) + 1); mu = s * (1.f / DM); rs = rsqrtf(fmaxf(q * (1.f / DM) - mu * mu, 0.f) + LN_EPS); } \
                    ((LAS pg8::f32x2*)(lds + pg8::TBL_ROW))[i * 256 + tid] = (pg8::f32x2){mu, rs}; } \
                else { const int cidx = u.pn * 256 + tid - 256; float gg = 0.f, bb = 0.f; if (l > 0) { gg = pg8::fx_get(Gv + cidx); bb = pg8::fx_get(Bvv + cidx); } \
                    ((LAS pg8::f32x2*)(lds + pg8::TBL_COL))[i * 256 + tid - 256] = (pg8::f32x2){gg, bb}; } } } \
            __syncthreads(); } while (0)
        { TZ_INIT();
          pg8::Gemm g; g.A = WSP(bf16, WS_XB); g.Bt = WSP(bf16, WS_WIN) + (size_t)l * WIN_L; g.M = M; g.N = INW - 512; g.K = DM; g.ld = LDK; pg8::EpiBf16LN E; E.O = WSP(bf16, WS_H); E.ldc = INW; E.pad = 0;
          pg8::StaticOrder S; S.init(M, INW - 512, G, (int)blockIdx.x);
          GEMM1_TABLES(S);
          pg8::gemm_phase<pg8::EpiBf16LN, pg8::StaticOrder, true, true>(lds, g, S, E, tid); }
        GRID_BARRIER();
        { TZ_INIT();
          pg8::Gemm g; g.A = WSP(bf16, WS_XB); g.Bt = WSP(bf16, WS_WIN) + (size_t)l * WIN_L; g.M = M; g.N = INW; g.K = DM; g.ld = LDK; pg8::EpiBf16LN E; E.O = WSP(bf16, WS_H); E.ldc = INW; E.pad = 0;
          pg8::OneUnit S; { const int bx = (int)blockIdx.x, x = bx & 7, idx = bx >> 3; S.has = (bx < 64) ? 1 : 0; S.pm = 4 * x + (idx >> 1); S.pn = (INW / 256 - 2) + (idx & 1); }
          if (S.has) { GEMM1_TABLES(S); pg8::gemm_phase<pg8::EpiBf16LN, pg8::OneUnit, false, true>(lds, g, S, E, tid); } }
#define Q_NEXT() do { if (tid == 0) *qw = __hip_atomic_fetch_add(qctr, 1u, __ATOMIC_RELAXED, __HIP_MEMORY_SCOPE_AGENT); __syncthreads(); tk = (int)__builtin_amdgcn_readfirstlane((int)*qw); __syncthreads(); } while (0)
        { TZ_INIT();
          unsigned* qctr = WSP(unsigned, WS_CTL + CTL_Q) + 64 * l; LAS unsigned* qw = (LAS unsigned*)(lds + LDS_MISC) + 16; int tk;
          fx_t* ssb = WSP(fx_t, WS_CTL + CTL_SS) + (size_t)(2 * l) * M;
          Q_NEXT();
          while (tk < 256) { attn_unit(WSP(bf16, WS_H), AIN(3) + (size_t)l * NQH, AIN(12) + (size_t)l * WB, WSP(bf16, WS_MIX), ssb, lds, tk, tid); Q_NEXT(); } }
        { TZ_INIT();
          unsigned* qctr = WSP(unsigned, WS_CTL + CTL_Q) + 64 * l; LAS unsigned* qw = (LAS unsigned*)(lds + LDS_MISC) + 16; int tk = (int)__builtin_amdgcn_readfirstlane((int)*qw);
          fx_t* ssc = WSP(fx_t, WS_CTL + CTL_SS) + (size_t)(2 * l + 1) * M;
          while (tk < 512) { const int r = tk - 256;
              rg_unit(WSP(bf16, WS_H), AIN(4) + (size_t)l * 4 * WC, AIN(5) + (size_t)l * WC, WSP(bf16, WS_WG) + (size_t)l * 2 * 8 * 128 * 128, AIN(7) + (size_t)l * WC, AIN(9) + (size_t)l * WC,
                      AIN(10) + (size_t)l * WC, AIN(13) + (size_t)l * WC, WSP(bf16, WS_MIX), ssc, WSP(unsigned long long, WS_CTL + CTL_GR), WSP(unsigned, WS_CTL) + 8, (unsigned)(l + 1), lds, r >> 4, r & 3, (r >> 2) & 3, tid);
              Q_NEXT(); } }
        { TZ_INIT();
          unsigned* qctr = WSP(unsigned, WS_CTL + CTL_Q) + 64 * l; LAS unsigned* qw = (LAS unsigned*)(lds + LDS_MISC) + 16; int tk = (int)__builtin_amdgcn_readfirstlane((int)*qw);
          while (tk < 768) { const int t0 = 32 * (tk - 512) + 4 * wave;
              branch_a_pair(WSP(bf16, WS_H), AIN(2) + (size_t)l * 3 * WA, AIN(11) + (size_t)l * WA, WSP(bf16, WS_MIX), t0, lane);
              branch_a_pair(WSP(bf16, WS_H), AIN(2) + (size_t)l * 3 * WA, AIN(11) + (size_t)l * WA, WSP(bf16, WS_MIX), t0 + 2, lane);
              Q_NEXT(); } }
        GRID_BARRIER();
        { TZ_INIT();
          fx_t* ssc = WSP(fx_t, WS_CTL + CTL_SS) + (size_t)(2 * l + 1) * M;
          for (int r = blockIdx.x; r < 256; r += G)
              rg_unit(WSP(bf16, WS_H), AIN(4) + (size_t)l * 4 * WC, AIN(5) + (size_t)l * WC, WSP(bf16, WS_WG) + (size_t)l * 2 * 8 * 128 * 128, AIN(7) + (size_t)l * WC, AIN(9) + (size_t)l * WC,
                      AIN(10) + (size_t)l * WC, AIN(13) + (size_t)l * WC, WSP(bf16, WS_MIX), ssc, WSP(unsigned long long, WS_CTL + CTL_GR), WSP(unsigned, WS_CTL) + 8, (unsigned)(l + 1), lds, r >> 4, 4 + (r & 3), (r >> 2) & 3, tid); }
        GRID_BARRIER();
        { TZ_INIT();
          pg8::Gemm g; g.A = WSP(bf16, WS_MIX); g.Bt = WSP(bf16, WS_WOUT) + (size_t)l * WOUT_L; g.M = M; g.N = DM; g.K = DMIX; g.ld = LDK;
          pg8::EpiResLN E; E.Yb = WSP(bf16, WS_XB); const float* lng = AIN(15) + (size_t)(l > 0 ? l - 1 : 0) * DM; const float* lnb = AIN(16) + (size_t)(l > 0 ? l - 1 : 0) * DM;
          E.st = WSP(fx_t, WS_CTL + CTL_ST) + (size_t)l * M * 2; E.alpha = ALPHA; E.ldb = LDK;
          pg8::StaticOrder S; S.init(M, DM, G, (int)blockIdx.x);
          { const fx_t* ssb = WSP(fx_t, WS_CTL + CTL_SS) + (size_t)(2 * l) * M; const fx_t* ssc = ssb + M; const fx_t* stp = WSP(fx_t, WS_CTL + CTL_ST) + (size_t)(l > 0 ? l - 1 : 0) * M * 2;
            pg8::Unit u; if (S.next(wave >> 2, u)) { const int grow = u.pm * 256 + (tid & 255);
                const float rb = rsqrtf(pg8::fx_get(ssb + grow) * (1.f / WB) + RMS_EPS), rc = rsqrtf(pg8::fx_get(ssc + grow) * (1.f / WC) + RMS_EPS); float mu = 0.f, rs = 1.f;
                if (l > 0) { const float s = pg8::fx_get(stp + 2 * (size_t)grow), q = pg8::fx_get(stp + 2 * (size_t)grow + 1); mu = s * (1.f / DM); rs = rsqrtf(fmaxf(q * (1.f / DM) - mu * mu, 0.f) + LN_EPS); }
                ((LAS pg8::f32x4*)(lds + pg8::TBL_ROW))[tid] = (pg8::f32x4){rc / rb, rb, mu, rs};
                float gg = 1.f, bb = 0.f; if (l > 0) { gg = lng[u.pn * 256 + (tid & 255)]; bb = lnb[u.pn * 256 + (tid & 255)]; }
                ((LAS pg8::f32x2*)(lds + pg8::TBL_COL))[tid] = (pg8::f32x2){gg, bb}; }
            __syncthreads(); }
          pg8::gemm_phase<pg8::EpiResLN, pg8::StaticOrder, true, true>(lds, g, S, E, tid); }
        GRID_BARRIER();
    }
    { const int l_ = DEPTH - 1; TZ_INIT();
      for (int t = gw; t < M; t += NGW) final_ln_token(WSP(bf16, WS_XB), WSP(fx_t, WS_CTL + CTL_ST) + (size_t)l * M * 2, AIN(15) + (size_t)l * DM, AIN(16) + (size_t)l * DM, AOUT, t, lane); }
}

extern "C" void kernel_launch(void* const* d_in, const int* in_sizes, int n_in, void* d_out, int out_size, void* d_ws, size_t ws_size, hipStream_t stream) {
    static int grid = 0;
    if (grid == 0) {
        if (n_in != 17 || in_sizes[0] != M * DM || out_size != M * DM || ws_size < WS_END) { fprintf(stderr, "kernel_launch: unexpected shapes/workspace (n_in %d, ws %zu)\n", n_in, ws_size); grid = -1; return; }
        int dev = 0, cus = 0, per_cu = 0;
        if (hipGetDevice(&dev) != hipSuccess || hipDeviceGetAttribute(&cus, hipDeviceAttributeMultiprocessorCount, dev) != hipSuccess) { grid = -1; return; }
        if (hipFuncSetAttribute((const void*)fwd, hipFuncAttributeMaxDynamicSharedMemorySize, LDS_BYTES) != hipSuccess) { fprintf(stderr, "kernel_launch: hipFuncSetAttribute failed\n"); grid = -1; return; }
        if (hipOccupancyMaxActiveBlocksPerMultiprocessor(&per_cu, (const void*)fwd, NTHR, LDS_BYTES) != hipSuccess || per_cu < 1) fprintf(stderr, "kernel_launch: occupancy query reports %d\n", per_cu);
        (void)hipGetLastError();
        grid = cus > 0 ? cus : 256;
        if (grid < 256) { fprintf(stderr, "kernel_launch: this kernel's unit tables assume at least 256 workgroups (one per CU of a 256-CU device); found %d CUs: nothing launched\n", grid); grid = -1; return; }
    }
    if (grid < 0) return;
    (void)hipMemsetAsync((char*)d_ws + WS_CTL, 0, CTL_BYTES, stream);
    Args a{};
    for (int i = 0; i < 17; ++i) a.in[i] = (const float*)d_in[i];
    a.out = (float*)d_out; a.ws = (unsigned char*)d_ws;
    hipLaunchKernelGGL(fwd, dim3(grid), dim3(NTHR), LDS_BYTES, stream, a);
}
```

```cpp
#include <hip/hip_runtime.h>
#include <cstdio>
#include <cstdint>
namespace pg8 {
#define PG8_LAS __attribute__((address_space(3)))
typedef unsigned short bf16_t;
typedef short bf16x8 __attribute__((ext_vector_type(8)));
typedef float f32x4 __attribute__((ext_vector_type(4)));
typedef float f32x2 __attribute__((ext_vector_type(2)));
typedef unsigned u32x4 __attribute__((ext_vector_type(4)));
constexpr int BM = 256, BK = 64, HALF = 128, HTB = HALF * BK * 2  , STAGE_BYTES = 8 * HTB, NXCD = 8, WGM = 8;

__host__ __device__ __forceinline__ int lds_byte(int r, int c) { const int st = (r >> 4) * 2 + (c >> 5), rr = r & 15, cc = c & 31, ob = rr * 64 + cc * 2; return st * 1024 + (ob ^ (((ob >> 9) & 1) << 5)); }
__host__ __device__ __forceinline__ void stage_rc(int b, int& R, int& C) { const int st = b / 1024, sb = b % 1024, swz = sb ^ (((sb >> 9) & 1) << 5); R = (st >> 1) * 16 + swz / 64; C = (st & 1) * 32 + (swz % 64) / 2; }
__host__ __device__ __forceinline__ int perm32(int rho) { const int n = rho >> 4, i = rho & 15; return 8 * (i >> 2) + 4 * n + (i & 3); }

struct Unit { int pm, pn; };
struct Gemm { const bf16_t* A; const bf16_t* Bt; int M, N, K, ld; };

struct StaticOrder {
    int nM, nN, nwg, G, c;
    __host__ __device__ void init(int M, int N, int G_, int c_) { nM = M / BM; nN = N / BM; nwg = nM * nN; G = G_; c = c_; }
    __host__ __device__ bool next(int i, Unit& u) const {
        const long L = (long)i * G + c; if (L >= nwg) return false;
        int wgid = (int)L; { const int q = nwg / NXCD, r = nwg % NXCD, xcd = wgid % NXCD, off = wgid / NXCD; wgid = (xcd < r ? xcd * (q + 1) : r * (q + 1) + (xcd - r) * q) + off; }
        const int nig = WGM * nN, gid = wgid / nig, fm = gid * WGM, gsz = (nM - fm) < WGM ? (nM - fm) : WGM;
        u.pm = fm + ((wgid % nig) % gsz); u.pn = (wgid % nig) / gsz; return true;
    }
    __device__ __forceinline__ void a_ready(const Unit&) const {}
    __device__ __forceinline__ void done(const Unit&) const {}
};

struct OneUnit {
    int pm, pn, has;
    __host__ __device__ bool next(int i, Unit& u) const { if (i != 0 || !has) return false; u.pm = pm; u.pn = pn; return true; }
    __device__ __forceinline__ void a_ready(const Unit&) const {}
    __device__ __forceinline__ void done(const Unit&) const {}
};

__device__ __forceinline__ void fx_add(unsigned long long* p, float v) { atomicAdd(p, (unsigned long long)__float2ll_rn(v * 4294967296.f)); }
__device__ __forceinline__ float fx_get(const unsigned long long* p) { return (float)(long long)(*p) * 2.3283064365386963e-10f; }
__device__ __forceinline__ unsigned cvt_pk_bf16(float lo, float hi) { unsigned r; asm volatile("v_cvt_pk_bf16_f32 %0, %1, %2" : "=v"(r) : "v"(lo), "v"(hi)); return r; }

constexpr int TBL_ROW = 131072 + 2048;
constexpr int TBL_COL = TBL_ROW + 6 * 256 * 8;
struct EpiBf16LN {
    static constexpr bool PERM = true, AFTER_DRAIN = false, KSCALE = false;
    bf16_t* O; int ldc, pad;
    __device__ __forceinline__ void operator()(const f32x4 (&acc)[2][2][4][2], const Unit& u, int wr, int wc, int fr, int fq, int ui, PG8_LAS unsigned char* lds) const {
        const int row0 = u.pm * BM + wr * 64 + fr; const int col0 = u.pn * BM + wc * 32 + 8 * fq;
        const PG8_LAS f32x2* rt = (const PG8_LAS f32x2*)(lds + TBL_ROW) + ui * 256 + wr * 64 + fr;
        const PG8_LAS f32x4* ct = (const PG8_LAS f32x4*)(lds + TBL_COL + (ui * 256 + wc * 32 + 8 * fq) * 8);
        f32x4 cq[2][2][2];
#pragma unroll
        for (int bj = 0; bj < 2; ++bj)
#pragma unroll
            for (int n = 0; n < 2; ++n) { cq[bj][n][0] = ct[(bj * HALF + 4 * n) / 2]; cq[bj][n][1] = ct[(bj * HALF + 4 * n) / 2 + 1]; }
#pragma unroll
        for (int ai = 0; ai < 2; ++ai)
#pragma unroll
            for (int m = 0; m < 4; ++m) { bf16_t* rowp = O + (size_t)(row0 + ai * HALF + m * 16) * ldc + col0; const f32x2 ms = rt[ai * HALF + m * 16]; const float mu = ms.x, rs = ms.y;
#pragma unroll
                for (int bj = 0; bj < 2; ++bj) { float o[8];
#pragma unroll
                    for (int n = 0; n < 2; ++n) { const f32x4 v = acc[ai][bj][m][n];
                        o[4 * n + 0] = rs * (v[0] - mu * cq[bj][n][0][0]) + cq[bj][n][0][1]; o[4 * n + 1] = rs * (v[1] - mu * cq[bj][n][0][2]) + cq[bj][n][0][3];
                        o[4 * n + 2] = rs * (v[2] - mu * cq[bj][n][1][0]) + cq[bj][n][1][1]; o[4 * n + 3] = rs * (v[3] - mu * cq[bj][n][1][2]) + cq[bj][n][1][3]; }
                    u32x4 w; w.x = cvt_pk_bf16(o[0], o[1]); w.y = cvt_pk_bf16(o[2], o[3]); w.z = cvt_pk_bf16(o[4], o[5]); w.w = cvt_pk_bf16(o[6], o[7]);
                    *(u32x4*)(rowp + bj * HALF) = w; } }
    }
};
struct EpiResLN {
    static constexpr bool PERM = true, AFTER_DRAIN = false, KSCALE = true;
    static constexpr int KS1 = 16, KS2 = 48;
    bf16_t* Yb; unsigned long long* st; float alpha; int ldb;
    __device__ __forceinline__ void kscale(f32x4 (&acc)[2][2][4][2], int ui, int which, int wr, int fr, PG8_LAS unsigned char* lds) const {
        const PG8_LAS f32x4* tbl = (const PG8_LAS f32x4*)(lds + TBL_ROW) + ui * 256 + wr * 64 + fr;
#pragma unroll
        for (int ai = 0; ai < 2; ++ai)
#pragma unroll
            for (int m = 0; m < 4; ++m) { const f32x4 fv = tbl[ai * HALF + m * 16]; const float f = which ? fv[1] : fv[0];
#pragma unroll
                for (int bj = 0; bj < 2; ++bj)
#pragma unroll
                    for (int n = 0; n < 2; ++n) acc[ai][bj][m][n] = acc[ai][bj][m][n] * f; }
    }
    static __device__ __forceinline__ float lo16(unsigned w) { return __builtin_bit_cast(float, w << 16); }
    static __device__ __forceinline__ float hi16(unsigned w) { return __builtin_bit_cast(float, w & 0xffff0000u); }
    __device__ __forceinline__ void operator()(const f32x4 (&acc)[2][2][4][2], const Unit& u, int wr, int wc, int fr, int fq, int ui, PG8_LAS unsigned char* lds) const {
        const int row0 = u.pm * BM + wr * 64 + fr, col0 = u.pn * BM + wc * 32 + 8 * fq;
        const PG8_LAS f32x4* rt = (const PG8_LAS f32x4*)(lds + TBL_ROW) + ui * 256 + wr * 64 + fr;
        const PG8_LAS f32x4* ct = (const PG8_LAS f32x4*)(lds + TBL_COL + (ui * 256 + wc * 32 + 8 * fq) * 8);
        u32x4 A0[4][2];
#define EPI_LOAD(buf, stg) do { _Pragma("unroll") for (int bj_ = 0; bj_ < 2; ++bj_) { const int row_ = row0 + ((stg) >> 2) * HALF + ((stg) & 3) * 16; \
            A0[buf][bj_] = *(const u32x4*)(Yb + (size_t)row_ * ldb + col0 + bj_ * HALF); } } while (0)
        EPI_LOAD(0, 0); EPI_LOAD(1, 1); EPI_LOAD(2, 2);
        float sq[2][2];
#pragma unroll
        for (int stg = 0; stg < 8; ++stg) {
            const int ai = stg >> 2, m = stg & 3, mi = m & 1;
            if (stg + 3 < 8) { if (((stg + 3) & 3) == 0) EPI_LOAD(0, stg + 3); else if (((stg + 3) & 3) == 1) EPI_LOAD(1, stg + 3); else if (((stg + 3) & 3) == 2) EPI_LOAD(2, stg + 3); else EPI_LOAD(3, stg + 3); }
            asm volatile("" ::: "memory");
            { const int row = row0 + ai * HALF + m * 16; const f32x4 tv = rt[ai * HALF + m * 16]; const float mu = tv[2], rs = tv[3];
                float s = 0.f, q = 0.f;
#pragma unroll
                for (int bj = 0; bj < 2; ++bj) { const size_t oh = (size_t)row * ldb + col0 + bj * HALF;
                    const u32x4 w0 = ((stg & 3) == 0) ? A0[0][bj] : (((stg & 3) == 1) ? A0[1][bj] : (((stg & 3) == 2) ? A0[2][bj] : A0[3][bj]));
                    float xr[8];
#pragma unroll
                    for (int j = 0; j < 4; ++j) { const float ye = lo16(w0[j]), yo = hi16(w0[j]);
                        const f32x4 gb = ct[(bj * HALF) / 2 + j];
                        xr[2 * j] = (ye - mu) * rs * gb[0] + gb[1]; xr[2 * j + 1] = (yo - mu) * rs * gb[2] + gb[3]; }
                    float y[8];
#pragma unroll
                    for (int j = 0; j < 4; ++j) { y[j] = xr[j] * alpha + acc[ai][bj][m][0][j]; y[4 + j] = xr[4 + j] * alpha + acc[ai][bj][m][1][j]; }
#pragma unroll
                    for (int j = 0; j < 8; ++j) { s += y[j]; q += y[j] * y[j]; }
                    u32x4 hn;
#pragma unroll
                    for (int j = 0; j < 4; ++j) hn[j] = cvt_pk_bf16(y[2 * j], y[2 * j + 1]);
                    *(u32x4*)(Yb + oh) = hn; }
                s += __shfl_xor(s, 16); s += __shfl_xor(s, 32); q += __shfl_xor(q, 16); q += __shfl_xor(q, 32);
                sq[mi][0] = s; sq[mi][1] = q; }
            if (mi == 1) {
                const int mi2 = fq >> 1, wh = fq & 1; const int row = row0 + ai * HALF + ((m & 2) + mi2) * 16;
                const float v = mi2 ? (wh ? sq[1][1] : sq[1][0]) : (wh ? sq[0][1] : sq[0][0]);
                fx_add(st + 2 * (size_t)row + wh, v); }
        }
#undef EPI_LOAD
    }
};

template <class Epi, class Sched, bool ALIGN_EPI = false, bool SP2 = false, class Pre>
__device__ __forceinline__ void gemm_phase(PG8_LAS unsigned char* lds, const Gemm g, const Sched& S, const Epi& E, const int tid, const Pre& pre) {
    const int wid = __builtin_amdgcn_readfirstlane(tid >> 6), lane = tid & 63, wr = wid >> 2, wc = wid & 3, fr = lane & 15, fq = lane >> 4;
    const int K = g.ld, nt = g.K / BK;
    unsigned voffA[2], voffB[2];
#pragma unroll
    for (int i = 0; i < 2; ++i) { int R, C; stage_rc(tid * 16 + i * 8192, R, C); const int Rb = Epi::PERM ? ((R & ~31) + perm32(R & 31)) : R;
        voffA[i] = (unsigned)(R * K + C) * 2u; voffB[i] = (unsigned)(Rb * K + C) * 2u; }
    const size_t kstep = (size_t)(BK * 2);
    const size_t hstep = (size_t)HALF * K * 2;
    const size_t tstep = 2 * hstep;
    const unsigned ldsw = (unsigned)wid * 1024u;
    const int aoff = lds_byte(wr * 64 + fr, fq * 8), boff = lds_byte(wc * 32 + fr, fq * 8);
#define PG8_SA(b, h) (((b) * 2 + (h)) * HTB)
#define PG8_SB(b, h) ((4 + (b) * 2 + (h)) * HTB)
#define PG8_STAGE(bufoff, gbase, voff) do { _Pragma("unroll") for (int _i = 0; _i < 2; ++_i) \
        __builtin_amdgcn_global_load_lds((const unsigned*)((const char*)(gbase) + (voff)[_i]), (PG8_LAS unsigned*)(lds + (bufoff) + ldsw + _i * 8192), 16, 0, 0); } while (0)
#define PG8_LDA(dst, b, h) do { _Pragma("unroll") for (int m = 0; m < 4; ++m) _Pragma("unroll") for (int k = 0; k < 2; ++k) dst[m][k] = *(const PG8_LAS bf16x8*)(lds + PG8_SA(b, h) + aoff + m * 2048 + k * 1024); } while (0)
#define PG8_LDB(dst, b, h) do { _Pragma("unroll") for (int n = 0; n < 2; ++n) _Pragma("unroll") for (int k = 0; k < 2; ++k) dst[n][k] = *(const PG8_LAS bf16x8*)(lds + PG8_SB(b, h) + boff + n * 2048 + k * 1024); } while (0)
#define PG8_MMA(ai, bj, At, Bt) do { __builtin_amdgcn_s_setprio(1); _Pragma("unroll") for (int m = 0; m < 4; ++m) _Pragma("unroll") for (int n = 0; n < 2; ++n) _Pragma("unroll") for (int k = 0; k < 2; ++k) \
        acc[ai][bj][m][n] = __builtin_amdgcn_mfma_f32_16x16x32_bf16(Bt[n][k], At[m][k], acc[ai][bj][m][n], 0, 0, 0); __builtin_amdgcn_s_setprio(0); } while (0)
#define PG8_WAIT_V(n) asm volatile("s_waitcnt vmcnt(" #n ")" ::: "memory")
#define PG8_WAIT_L(n) asm volatile("s_waitcnt lgkmcnt(" #n ")" ::: "memory")
#define PG8_BAR __builtin_amdgcn_s_barrier()
#define PG8_SCHED __builtin_amdgcn_sched_barrier(0)
    Unit cur, nxt; int ui = 0;
    if (!S.next(0, cur)) return;
    f32x4 acc[2][2][4][2];
#pragma unroll
    for (int a = 0; a < 2; ++a)
#pragma unroll
        for (int b = 0; b < 2; ++b)
#pragma unroll
            for (int m = 0; m < 4; ++m)
#pragma unroll
                for (int n = 0; n < 2; ++n) acc[a][b][m][n] = (f32x4){0.f, 0.f, 0.f, 0.f};
    bf16x8 At[4][2], B0[2][2], B1[2][2];
    const char* cA = (const char*)g.A + (size_t)cur.pm * tstep; const char* cB = (const char*)g.Bt + (size_t)cur.pn * tstep;
    S.a_ready(cur);
    if constexpr (SP2) {
        PG8_STAGE(PG8_SB(0, 0), cB, voffB); PG8_STAGE(PG8_SB(0, 1), cB + hstep, voffB); PG8_STAGE(PG8_SA(0, 0), cA, voffA); PG8_STAGE(PG8_SA(0, 1), cA + hstep, voffA);
        pre();
        if (wr == 1) PG8_BAR;
        PG8_WAIT_V(2); PG8_BAR;
        PG8_STAGE(PG8_SB(1, 0), cB + kstep, voffB); PG8_STAGE(PG8_SA(1, 0), cA + kstep, voffA); PG8_STAGE(PG8_SB(1, 1), cB + hstep + kstep, voffB);
        PG8_WAIT_V(6); PG8_BAR;
    } else {
        PG8_STAGE(PG8_SB(0, 0), cB, voffB); PG8_STAGE(PG8_SA(0, 0), cA, voffA); PG8_STAGE(PG8_SB(0, 1), cB + hstep, voffB); PG8_STAGE(PG8_SA(0, 1), cA + hstep, voffA);
        if (wr == 1) PG8_BAR;
        PG8_WAIT_V(4); PG8_BAR;
        PG8_STAGE(PG8_SB(1, 0), cB + kstep, voffB); PG8_STAGE(PG8_SA(1, 0), cA + kstep, voffA); PG8_STAGE(PG8_SB(1, 1), cB + hstep + kstep, voffB);
        PG8_WAIT_V(6); PG8_BAR;
    }
    for (;;) {
        const bool has_next = S.next(ui + 1, nxt);
        const char* nA = has_next ? (const char*)g.A + (size_t)nxt.pm * tstep : cA; const char* nB = has_next ? (const char*)g.Bt + (size_t)nxt.pn * tstep : cB;
        for (int t = 0; t < nt; t += 2) {
            const bool last = (t == nt - 2);
            const char* a1 = cA + (size_t)(t + 1) * kstep;
            const char* a2 = last ? nA : cA + (size_t)(t + 2) * kstep; const char* b2 = last ? nB : cB + (size_t)(t + 2) * kstep;
            const char* a3 = a2 + kstep; const char* b3 = b2 + kstep;
            if (last && has_next) S.a_ready(nxt);
            if constexpr (Epi::KSCALE) { if (t == Epi::KS1 || t == Epi::KS2) E.kscale(acc, ui, t == Epi::KS1 ? 0 : 1, wr, fr, lds); }
            if constexpr (SP2) {
            PG8_LDB(B0, 0, 0); PG8_LDB(B1, 0, 1); PG8_SCHED; PG8_LDA(At, 0, 0); PG8_STAGE(PG8_SA(1, 1), a1 + hstep, voffA);
            PG8_WAIT_V(8); PG8_WAIT_L(0); PG8_BAR; PG8_MMA(0, 0, At, B0); PG8_MMA(0, 1, At, B1); PG8_BAR; PG8_SCHED;
            PG8_LDA(At, 0, 1); PG8_STAGE(PG8_SB(0, 0), b2, voffB); PG8_STAGE(PG8_SB(0, 1), b2 + hstep, voffB); PG8_STAGE(PG8_SA(0, 0), a2, voffA);
            PG8_WAIT_V(8); PG8_WAIT_L(0); PG8_BAR; PG8_MMA(1, 0, At, B0); PG8_MMA(1, 1, At, B1); PG8_BAR; PG8_SCHED;
            PG8_LDB(B0, 1, 0); PG8_LDB(B1, 1, 1); PG8_SCHED; PG8_LDA(At, 1, 0); PG8_STAGE(PG8_SA(0, 1), a2 + hstep, voffA);
            PG8_WAIT_V(8); PG8_WAIT_L(0); PG8_BAR; PG8_MMA(0, 0, At, B0); PG8_MMA(0, 1, At, B1); PG8_BAR; PG8_SCHED;
            PG8_LDA(At, 1, 1); PG8_STAGE(PG8_SB(1, 0), b3, voffB); PG8_STAGE(PG8_SB(1, 1), b3 + hstep, voffB); PG8_STAGE(PG8_SA(1, 0), a3, voffA);
            PG8_WAIT_V(8); PG8_WAIT_L(0); PG8_BAR; PG8_MMA(1, 0, At, B0); PG8_MMA(1, 1, At, B1); PG8_BAR; PG8_SCHED;
            } else {
            PG8_LDB(B0, 0, 0); PG8_SCHED; PG8_LDA(At, 0, 0); PG8_STAGE(PG8_SA(1, 1), a1 + hstep, voffA);
            PG8_WAIT_L(8); PG8_BAR; PG8_WAIT_L(0); PG8_MMA(0, 0, At, B0); PG8_BAR; PG8_SCHED;
            PG8_LDB(B1, 0, 1); PG8_STAGE(PG8_SB(0, 0), b2, voffB);
            PG8_BAR; PG8_WAIT_L(0); PG8_MMA(0, 1, At, B1); PG8_BAR;
            PG8_LDA(At, 0, 1); PG8_STAGE(PG8_SA(0, 0), a2, voffA);
            PG8_BAR; PG8_WAIT_L(0); PG8_MMA(1, 0, At, B0); PG8_BAR; PG8_SCHED;
            PG8_STAGE(PG8_SB(0, 1), b2 + hstep, voffB);
            PG8_WAIT_V(6); PG8_BAR; PG8_MMA(1, 1, At, B1); PG8_BAR;
            PG8_LDB(B0, 1, 0); PG8_SCHED; PG8_LDA(At, 1, 0); PG8_STAGE(PG8_SA(0, 1), a2 + hstep, voffA);
            PG8_WAIT_L(8); PG8_BAR; PG8_WAIT_L(0); PG8_MMA(0, 0, At, B0); PG8_BAR; PG8_SCHED;
            PG8_LDB(B1, 1, 1); PG8_STAGE(PG8_SB(1, 0), b3, voffB);
            PG8_BAR; PG8_WAIT_L(0); PG8_MMA(0, 1, At, B1); PG8_BAR;
            PG8_LDA(At, 1, 1); PG8_STAGE(PG8_SA(1, 0), a3, voffA);
            PG8_BAR; PG8_WAIT_L(0); PG8_MMA(1, 0, At, B0); PG8_BAR; PG8_SCHED;
            PG8_STAGE(PG8_SB(1, 1), b3 + hstep, voffB);
            PG8_WAIT_V(6); PG8_BAR; PG8_MMA(1, 1, At, B1); PG8_BAR;
            }
        }
        if constexpr (ALIGN_EPI) { if (wr == 0) PG8_BAR; }
        if constexpr (!Epi::AFTER_DRAIN) { E(acc, cur, wr, wc, fr, fq, ui, lds); S.done(cur); }
        if (!has_next) break;
#pragma unroll
        for (int a = 0; a < 2; ++a)
#pragma unroll
            for (int b = 0; b < 2; ++b)
#pragma unroll
                for (int m = 0; m < 4; ++m)
#pragma unroll
                    for (int n = 0; n < 2; ++n) acc[a][b][m][n] = (f32x4){0.f, 0.f, 0.f, 0.f};
        cur = nxt; cA = nA; cB = nB; ++ui;
        if constexpr (ALIGN_EPI) { if (wr == 1) PG8_BAR; }
    }
    PG8_WAIT_V(0);
    if constexpr (!ALIGN_EPI) { if (wr == 0) PG8_BAR; }
    PG8_BAR;
    if constexpr (Epi::AFTER_DRAIN) { E.fused(acc, cur, wr, wc, fr, fq, lds, wid, lane); S.done(cur); }
#undef PG8_SA
#undef PG8_SB
#undef PG8_STAGE
#undef PG8_LDA
#undef PG8_LDB
#undef PG8_MMA
#undef PG8_WAIT_V
#undef PG8_WAIT_L
#undef PG8_BAR
#undef PG8_SCHED
}
}

typedef unsigned short bf16;
typedef unsigned v4u __attribute__((ext_vector_type(4)));
typedef unsigned v2u __attribute__((ext_vector_type(2)));
typedef float f32x4 __attribute__((ext_vector_type(4)));
constexpr int DM = 4096, NB = 4, SEQ = 2048, M = NB * SEQ, DEPTH = 4;
constexpr int WA = 1024, WB = 2048, WC = 1024, DMIX = 4096, HD = 64, NQH = 32, KVG = 8, NKV = 4;
constexpr int INW = 10752;
constexpr int LDK = 4096 + 64;
constexpr int OFF_AB = 0, OFF_AC = 1024, OFF_AX = 2048, OFF_AG = 3072, OFF_Q = 4096, OFF_K = 6144, OFF_V = 6400, OFF_BG = 6656, OFF_CX = 8704, OFF_CG = 9728;
constexpr int MIX_C = 0, MIX_B = 1024, MIX_A = 3072;
constexpr size_t CTL_SS = 65536;
constexpr size_t CTL_BYTES = 3u << 20, CTL_GR = 2u << 20;
constexpr size_t WS_WG = 8u << 20;
constexpr size_t CTL_GV = CTL_SS + (size_t)DEPTH * 2 * M * 8, CTL_BV = CTL_GV + (size_t)DEPTH * INW * 8, CTL_ST = CTL_BV + (size_t)DEPTH * INW * 8;
static_assert(CTL_ST + (size_t)DEPTH * M * 2 * 8 <= CTL_GR, "CTL map");
typedef unsigned long long fx_t;
constexpr size_t CTL_Q = 4096;
constexpr float ALPHA = 1.6817928305074290861f;
constexpr float LN_EPS = 1e-5f, RMS_EPS = 1e-6f;
constexpr size_t MiB = 1u << 20;
constexpr size_t WS_CTL = 0, WS_WIN = 16 * MiB, WS_WOUT = 360 * MiB, WS_XB = 492 * MiB, WS_H = 558 * MiB, WS_MIX = 726 * MiB, WS_Y = 792 * MiB, WS_END = 920 * MiB;
constexpr size_t WIN_L = (size_t)INW * LDK, WOUT_L = (size_t)DM * LDK;

__device__ __forceinline__ unsigned f2bf(float f) { unsigned u = __builtin_bit_cast(unsigned, f); return (u + 0x7fffu + ((u >> 16) & 1u)) >> 16; }
__device__ __forceinline__ unsigned pk2(float lo, float hi) { return f2bf(lo) | (f2bf(hi) << 16); }
__device__ __forceinline__ float bf2f(unsigned short b) { return __builtin_bit_cast(float, (unsigned)b << 16); }
__device__ __forceinline__ float bflo(unsigned w) { return __builtin_bit_cast(float, w << 16); }
__device__ __forceinline__ float bfhi(unsigned w) { return __builtin_bit_cast(float, w & 0xffff0000u); }
__device__ __forceinline__ float wave_sum(float v) {
#pragma unroll
    for (int o = 1; o < 64; o <<= 1) v += __shfl_xor(v, o);
    return v;
}
__device__ __forceinline__ float wave_max(float v) {
#pragma unroll
    for (int o = 1; o < 64; o <<= 1) v = fmaxf(v, __shfl_xor(v, o));
    return v;
}
__device__ __forceinline__ float silu(float x) { return x * __builtin_amdgcn_rcpf(1.f + __builtin_amdgcn_exp2f(x * -1.44269504088896341f)); }
__device__ __forceinline__ float sigmoidf(float x) { return 1.f / (1.f + __expf(-x)); }
#define LDS_WAIT() asm volatile("s_waitcnt lgkmcnt(0)" ::: "memory")

static_assert(WS_WIN + DEPTH * WIN_L * 2 <= WS_WOUT && WS_WOUT + DEPTH * WOUT_L * 2 <= WS_XB && WS_XB + (size_t)M * LDK * 2 <= WS_H && WS_H + (size_t)M * INW * 2 <= WS_MIX && WS_MIX + (size_t)M * LDK * 2 <= WS_Y && WS_Y + (size_t)M * DM * 4 <= WS_END, "workspace map");
#define XB_TMO      128
#define XB_XCNT(j)  (256  + 64 * (j))
#define XB_XSUB(j)  (1280 + 64 * (j))
#define XB_XGEN(j)  (2304 + 64 * (j))
#define XB_TOP      3328
#define XB_TOPGEN   3392
#define XCD_BAR_WORDS 3456
#define XB_SPIN_CAP (1u << 18)
#define LAS __attribute__((address_space(3)))

__device__ __forceinline__ unsigned xb_ld(unsigned* p)              { return __hip_atomic_load(p, __ATOMIC_RELAXED, __HIP_MEMORY_SCOPE_AGENT); }
__device__ __forceinline__ unsigned xb_add(unsigned* p, unsigned v) { return __hip_atomic_fetch_add(p, v, __ATOMIC_RELAXED, __HIP_MEMORY_SCOPE_AGENT); }
__device__ __forceinline__ unsigned xb_xcc_id() { return (unsigned)__builtin_amdgcn_s_getreg((3 << 11) | 20) & 0xFu; }
#define XB_SPIN(cond, bar) do { unsigned _sp = 0; while (cond) { __builtin_amdgcn_s_sleep(1); \
    if ((++_sp & 255u) == 0u) { if (xb_ld(&(bar)[XB_TMO])) break; if (_sp > XB_SPIN_CAP) { atomicAdd(&(bar)[XB_TMO], 1u); break; } } } } while (0)

struct XcdBarrier {
    unsigned* bar; unsigned x;
    volatile LAS unsigned* st;
};

__device__ __forceinline__ XcdBarrier xcd_barrier_post(unsigned* bar, volatile LAS unsigned* st) {
    XcdBarrier b; b.bar = bar; b.x = xb_xcc_id(); b.st = st;
    if (threadIdx.x == 0) (void)xb_add(&bar[XB_XCNT(b.x)], 1u);
    return b;
}
__device__ __forceinline__ void xcd_barrier_complete(unsigned* bar, unsigned x, unsigned& nloc, unsigned& nx) {
    const unsigned G = gridDim.x * gridDim.y * gridDim.z;
    unsigned sum, cnt, mine, sp = 0u;
    for (;;) {
        sum = 0u; cnt = 0u; mine = 0u;
#pragma unroll
        for (unsigned j = 0; j < 16; ++j) { const unsigned c = xb_ld(&bar[XB_XCNT(j)]); sum += c; cnt += (c > 0u) ? 1u : 0u; mine = (j == x) ? c : mine; }
        if (sum == G) break;
        __builtin_amdgcn_s_sleep(1);
        if ((++sp & 255u) == 0u) { if (xb_ld(&bar[XB_TMO])) break; if (sp > XB_SPIN_CAP) { atomicAdd(&bar[XB_TMO], 1u); break; } }
    }
    nloc = mine > 0u ? mine : 1u; nx = cnt > 0u ? cnt : 1u;
}

__device__ __forceinline__ void xcd_barrier(const XcdBarrier& b) {
    asm volatile("s_waitcnt vmcnt(0)" ::: "memory");
    __syncthreads();
    if (threadIdx.x == 0) {
        unsigned* bar = b.bar;
        __builtin_amdgcn_s_waitcnt(0);
        unsigned nloc = b.st[0], nx = b.st[1];
        if (nloc == 0u) { xcd_barrier_complete(bar, b.x, nloc, nx); b.st[0] = nloc; b.st[1] = nx; }
        const unsigned old = xb_add(&bar[XB_XSUB(b.x)], 1u);
        const unsigned gen = old / nloc;
        if (old + 1u == (gen + 1u) * nloc) {
            __builtin_amdgcn_fence(__ATOMIC_RELEASE, "agent");
            asm volatile("s_waitcnt vmcnt(0)" ::: "memory");
            const unsigned og = xb_add(&bar[XB_TOP], 1u);
            const unsigned tg = og / nx;
            if (og + 1u == (tg + 1u) * nx) xb_add(&bar[XB_TOPGEN], 1u);
            else XB_SPIN(xb_ld(&bar[XB_TOPGEN]) == tg, bar);
            __builtin_amdgcn_fence(__ATOMIC_ACQUIRE, "agent");
            xb_add(&bar[XB_XGEN(b.x)], 1u);
            asm volatile("s_waitcnt vmcnt(0)" ::: "memory");
        } else {
            XB_SPIN(xb_ld(&bar[XB_XGEN(b.x)]) == gen, bar);
            __builtin_amdgcn_fence(__ATOMIC_ACQUIRE, "agent");
            asm volatile("s_waitcnt vmcnt(0)" ::: "memory");
        }
    }
    __syncthreads();
}
constexpr int NWAVES = 8, NTHR = 512;
constexpr int LDS_MISC = 131072 + 320, LDS_BYTES = 163840;
#define VM_WAIT() asm volatile("s_waitcnt vmcnt(0)" ::: "memory")

template <bool KPERM, bool GFOLD> __device__ __forceinline__ void convert_task(const float* __restrict__ W, bf16* __restrict__ WT, int ldt, int N, LAS float* scr, int nb, int kb0, int nkb, int lane,
                                                                               const float* __restrict__ gvec, const float* __restrict__ bvec, fx_t* __restrict__ Gout, fx_t* __restrict__ Bout) {
    const int n0 = 64 * nb, c = lane & 7, nr = lane >> 3;
    const __amdgpu_buffer_rsrc_t rsW = __builtin_amdgcn_make_buffer_rsrc((void*)W, (short)0, 0x7ffffff0, 0x00020000);
    float gacc[8], bacc[8];
#pragma unroll
    for (int j = 0; j < 8; ++j) { gacc[j] = 0.f; bacc[j] = 0.f; }
    for (int kb = kb0; kb < kb0 + nkb; ++kb) {
        const int k0 = 64 * kb;
        const int ks = KPERM ? (k0 < 1024 ? k0 + 3072 : (k0 < 3072 ? k0 : k0 - 3072)) : k0;
        const int kr = lane >> 4, cq = lane & 15;
        const int voff = (kr * N + 4 * cq) * 4;
        f32x4 r[16];
#pragma unroll
        for (int i = 0; i < 16; ++i) r[i] = __builtin_bit_cast(f32x4, __builtin_amdgcn_raw_buffer_load_b128(rsW, voff, ((ks + 4 * i) * N + n0) * 4, 2));
#pragma unroll
        for (int i = 0; i < 16; ++i) { const int row = 4 * i + kr; *(LAS f32x4*)(scr + row * 64 + ((4 * cq) ^ (8 * (row >> 3)))) = r[i]; }
        LDS_WAIT();
        float gk[8], bk[8];
        if (GFOLD) { const f32x4 g0 = *(const f32x4*)(gvec + k0 + 8 * c), g1 = *(const f32x4*)(gvec + k0 + 8 * c + 4), b0 = *(const f32x4*)(bvec + k0 + 8 * c), b1 = *(const f32x4*)(bvec + k0 + 8 * c + 4);
#pragma unroll
            for (int e = 0; e < 4; ++e) { gk[e] = g0[e]; gk[4 + e] = g1[e]; bk[e] = b0[e]; bk[4 + e] = b1[e]; } }
#pragma unroll
        for (int j = 0; j < 8; ++j) { const int n = nr + 8 * j; const LAS float* s = scr + (8 * c) * 64 + (n ^ (8 * c));
            float v[8];
#pragma unroll
            for (int e = 0; e < 8; ++e) { v[e] = s[e * 64]; if (GFOLD) { bacc[j] += bk[e] * v[e]; v[e] *= gk[e]; } }
            v4u o; o.x = pk2(v[0], v[1]); o.y = pk2(v[2], v[3]); o.z = pk2(v[4], v[5]); o.w = pk2(v[6], v[7]);
            *(v4u*)(WT + (size_t)(n0 + n) * ldt + k0 + 8 * c) = o;
            if (GFOLD) gacc[j] += ((bflo(o.x) + bfhi(o.x)) + (bflo(o.y) + bfhi(o.y))) + ((bflo(o.z) + bfhi(o.z)) + (bflo(o.w) + bfhi(o.w))); }
        LDS_WAIT();
    }
    if (GFOLD) {
#pragma unroll
        for (int j = 0; j < 8; ++j) { float gp = gacc[j], bp = bacc[j];
            gp += __shfl_xor(gp, 1); gp += __shfl_xor(gp, 2); gp += __shfl_xor(gp, 4); bp += __shfl_xor(bp, 1); bp += __shfl_xor(bp, 2); bp += __shfl_xor(bp, 4);
            if (c == 0) { pg8::fx_add(Gout + n0 + nr + 8 * j, gp); pg8::fx_add(Bout + n0 + nr + 8 * j, bp); } } }
}
constexpr int CV_NK = 2, CV_KQ = DM / 64 / CV_NK, CV_T_IN = (INW / 64) * CV_KQ, CV_T_OUT = (DM / 64) * CV_KQ, CV_T_L = CV_T_IN + CV_T_OUT;
__device__ __forceinline__ void convert_layer(const float* __restrict__ w_in, const float* __restrict__ w_out, const float* __restrict__ ln_g, const float* __restrict__ ln_b, unsigned char* ws, int ll, LAS float* scr, int wv, int nwv, int lane) {
    for (int r = wv; r < CV_T_L; r += nwv) {
        if (r < CV_T_IN) { const int kq = r % CV_KQ, nb = r / CV_KQ;
            if (ll == 0) convert_task<false, false>(w_in, (bf16*)(ws + WS_WIN), LDK, INW, scr, nb, kq * CV_NK, CV_NK, lane, nullptr, nullptr, nullptr, nullptr);
            else convert_task<false, true>(w_in + (size_t)ll * DM * INW, (bf16*)(ws + WS_WIN) + (size_t)ll * WIN_L, LDK, INW, scr, nb, kq * CV_NK, CV_NK, lane, ln_g + (size_t)(ll - 1) * DM, ln_b + (size_t)(ll - 1) * DM,
                                                (fx_t*)(ws + WS_CTL + CTL_GV) + (size_t)ll * INW, (fx_t*)(ws + WS_CTL + CTL_BV) + (size_t)ll * INW); }
        else { const int r2 = r - CV_T_IN, kq = r2 % CV_KQ, nb = r2 / CV_KQ;
            convert_task<true, false>(w_out + (size_t)ll * DMIX * DM, (bf16*)(ws + WS_WOUT) + (size_t)ll * WOUT_L, LDK, DM, scr, nb, kq * CV_NK, CV_NK, lane, nullptr, nullptr, nullptr, nullptr); }
    }
}

__device__ __forceinline__ void branch_a_pair(const bf16* __restrict__ h, const float* __restrict__ cw, const float* __restrict__ nrm, bf16* __restrict__ mix, int t0, int lane) {
    const int s0 = t0 % SEQ;
    const bf16* hr = h + (size_t)t0 * INW;
    float y[2][16], ss[2] = {0.f, 0.f}; v4u agk[2][2];
#pragma unroll
    for (int j = 0; j < 2; ++j) {
        const int ch0 = j * 512 + lane * 8;
        v4u cr[4], xr[4], ab[2];
#pragma unroll
        for (int i = 0; i < 4; ++i) { cr[i] = (v4u){0u, 0u, 0u, 0u}; xr[i] = (v4u){0u, 0u, 0u, 0u};
            if (i >= 2 || s0 > 0) { cr[i] = *(const v4u*)(hr + (long)(i - 2) * INW + OFF_AC + ch0); xr[i] = *(const v4u*)(hr + (long)(i - 2) * INW + OFF_AX + ch0); } }
#pragma unroll
        for (int i = 0; i < 2; ++i) { ab[i] = *(const v4u*)(hr + (size_t)i * INW + OFF_AB + ch0); agk[i][j] = *(const v4u*)(hr + (size_t)i * INW + OFF_AG + ch0); }
        float w0[8], w1[8], w2[8];
        { const f32x4 a0 = *(const f32x4*)(cw + ch0), a1 = *(const f32x4*)(cw + ch0 + 4), b0 = *(const f32x4*)(cw + 1024 + ch0), b1 = *(const f32x4*)(cw + 1024 + ch0 + 4),
                      c0 = *(const f32x4*)(cw + 2048 + ch0), c1 = *(const f32x4*)(cw + 2048 + ch0 + 4);
#pragma unroll
          for (int e = 0; e < 4; ++e) { w0[e] = a0[e]; w0[4 + e] = a1[e]; w1[e] = b0[e]; w1[4 + e] = b1[e]; w2[e] = c0[e]; w2[4 + e] = c1[e]; } }
        float p[4][8];
#pragma unroll
        for (int i = 0; i < 4; ++i)
#pragma unroll
            for (int e = 0; e < 8; ++e) { const int w = e >> 1; p[i][e] = (e & 1) ? bfhi(cr[i][w]) * bfhi(xr[i][w]) : bflo(cr[i][w]) * bflo(xr[i][w]); }
#pragma unroll
        for (int i = 0; i < 2; ++i)
#pragma unroll
            for (int e = 0; e < 8; ++e) { const int w = e >> 1;
                const float cv = w0[e] * p[i][e] + w1[e] * p[i + 1][e] + w2[e] * p[i + 2][e];
                const float yv = ((e & 1) ? bfhi(ab[i][w]) : bflo(ab[i][w])) * cv; y[i][j * 8 + e] = yv; ss[i] += yv * yv; }
    }
#pragma unroll
    for (int i = 0; i < 2; ++i) { const float rstd = rsqrtf(wave_sum(ss[i]) * (1.f / WA) + RMS_EPS);
#pragma unroll
        for (int j = 0; j < 2; ++j) { const int ch0 = j * 512 + lane * 8; const f32x4 n0 = *(const f32x4*)(nrm + ch0), n1 = *(const f32x4*)(nrm + ch0 + 4); const v4u ag = agk[i][j]; float ov[8];
#pragma unroll
            for (int e = 0; e < 8; ++e) { const int w = e >> 1; ov[e] = y[i][j * 8 + e] * rstd * ((e < 4) ? n0[e & 3] : n1[e & 3]) * silu((e & 1) ? bfhi(ag[w]) : bflo(ag[w])); }
            v4u o; o.x = pk2(ov[0], ov[1]); o.y = pk2(ov[2], ov[3]); o.z = pk2(ov[4], ov[5]); o.w = pk2(ov[6], ov[7]);
            *(v4u*)(mix + (size_t)(t0 + i) * LDK + MIX_A + ch0) = o; } }
}
typedef short s16x8 __attribute__((ext_vector_type(8)));
typedef float f32x16 __attribute__((ext_vector_type(16)));
typedef __bf16 bf16x2_t __attribute__((ext_vector_type(2)));
typedef float f32x2_t __attribute__((ext_vector_type(2)));
__device__ __forceinline__ unsigned cvtpk(float lo, float hi) { const f32x2_t v = {lo, hi}; return __builtin_bit_cast(unsigned, __builtin_convertvector(v, bf16x2_t)); }
constexpr int ATT_KROW = 144, ATT_VROW = 520, ATT_K_OFF = 0, ATT_V_OFF = 256 * ATT_KROW;
__device__ __forceinline__ void attn_unit(const bf16* __restrict__ h, const float* __restrict__ sinks, const float* __restrict__ nrm, bf16* __restrict__ mix, fx_t* __restrict__ ssb, LAS unsigned char* lds, int task, const int tid) {
    const int n = task & 15, kvh = (task >> 4) & 3, b = task >> 6;
    const int lane = tid & 63, wave = tid >> 6;
    for (int pc = tid; pc < 2048; pc += NTHR) {
        const int j = pc >> 3, q = pc & 7, pos = 128 * n - 128 + j;
        v4u kv = {0u, 0u, 0u, 0u}, vv = {0u, 0u, 0u, 0u};
        if (pos >= 0) { const bf16* row = h + (size_t)(b * SEQ + pos) * INW; kv = *(const v4u*)(row + OFF_K + kvh * 64 + 8 * q); vv = *(const v4u*)(row + OFF_V + kvh * 64 + 8 * q); }
        *(LAS v4u*)(lds + ATT_K_OFF + j * ATT_KROW + 16 * q) = kv;
        LAS unsigned short* vt = (LAS unsigned short*)(lds + ATT_V_OFF) + (8 * q) * (ATT_VROW / 2) + j;
#pragma unroll
        for (int e = 0; e < 8; ++e) vt[e * (ATT_VROW / 2)] = (unsigned short)((e & 1) ? (vv[e >> 1] >> 16) : (vv[e >> 1] & 0xffffu));
    }
    __syncthreads();
    const int hq = kvh * 8 + wave; const float sink = sinks[hq];
    const int r = lane & 31, hh = lane >> 5; const bool first_blk = (n == 0);
    constexpr float LOG2E = 1.44269504088896341f, SC = 0.125f * LOG2E;
    const size_t tq0 = (size_t)b * SEQ + 128 * n + r;
    s16x8 qf[4];
    { const bf16* hrow = h + tq0 * INW;
#pragma unroll
      for (int s = 0; s < 4; ++s) qf[s] = *(const s16x8*)(hrow + OFF_Q + hq * 64 + 8 * hh + 16 * s); }
#pragma unroll 1
    for (int qs = 0; qs < 4; ++qs) {
        const size_t t = tq0 + 32 * qs;
        s16x8 qn[4]; v2u gw[2][4];
        { const bf16* hrow = h + (t + (qs < 3 ? 32 : 0)) * INW;
#pragma unroll
          for (int s = 0; s < 4; ++s) qn[s] = *(const s16x8*)(hrow + OFF_Q + hq * 64 + 8 * hh + 16 * s);
          const bf16* grow = h + t * INW;
#pragma unroll
          for (int dt = 0; dt < 2; ++dt)
#pragma unroll
              for (int g = 0; g < 4; ++g) gw[dt][g] = *(const v2u*)(grow + OFF_BG + hq * 64 + 32 * dt + 8 * g + 4 * hh); }
        f32x16 sc[5];
#pragma unroll
        for (int ci = 0; ci < 5; ++ci) {
            const LAS unsigned char* kp = lds + ATT_K_OFF + (32 * (qs + ci) + r) * ATT_KROW + 16 * hh;
            f32x16 acc;
#pragma unroll
            for (int i = 0; i < 16; ++i) acc[i] = 0.f;
#pragma unroll
            for (int s = 0; s < 4; ++s) { const s16x8 kf = *(const LAS s16x8*)(kp + 32 * s); acc = __builtin_amdgcn_mfma_f32_32x32x16_bf16(kf, qf[s], acc, 0, 0, 0); }
            sc[ci] = acc;
        }
        float mx = -1e30f;
#pragma unroll
        for (int ci = 0; ci < 5; ++ci)
#pragma unroll
            for (int i = 0; i < 16; ++i) { const int kk = (i & 3) + 8 * (i >> 2) + 4 * hh;
                const bool valid = ((ci == 0) ? (kk > r) : ((ci == 4) ? (kk <= r) : true)) && !(first_blk && qs + ci < 4);
                const float v = valid ? sc[ci][i] : -1e30f; sc[ci][i] = v; mx = fmaxf(mx, v); }
        mx = fmaxf(mx, __shfl_xor(mx, 32));
        const float m = fmaxf(mx * 0.125f, sink), mb = m * LOG2E;
        float sum = 0.f;
#pragma unroll
        for (int ci = 0; ci < 5; ++ci)
#pragma unroll
            for (int i = 0; i < 16; ++i) { const float p = __builtin_amdgcn_exp2f(sc[ci][i] * SC - mb); sc[ci][i] = p; sum += p; }
        sum += __shfl_xor(sum, 32);
        const float inv = 1.f / (sum + __builtin_amdgcn_exp2f((sink - m) * LOG2E));
        f32x16 o[2];
#pragma unroll
        for (int i = 0; i < 16; ++i) { o[0][i] = 0.f; o[1][i] = 0.f; }
#pragma unroll
        for (int ci = 0; ci < 5; ++ci)
#pragma unroll
            for (int s2 = 0; s2 < 2; ++s2) {
                v4u pw; pw.x = cvtpk(sc[ci][8 * s2 + 0], sc[ci][8 * s2 + 1]); pw.y = cvtpk(sc[ci][8 * s2 + 2], sc[ci][8 * s2 + 3]); pw.z = cvtpk(sc[ci][8 * s2 + 4], sc[ci][8 * s2 + 5]); pw.w = cvtpk(sc[ci][8 * s2 + 6], sc[ci][8 * s2 + 7]);
                const s16x8 pf = __builtin_bit_cast(s16x8, pw);
                const int key0 = 32 * (qs + ci) + 16 * s2 + 4 * hh;
#pragma unroll
                for (int dt = 0; dt < 2; ++dt) { const LAS unsigned char* vp = lds + ATT_V_OFF + (32 * dt + r) * ATT_VROW + 2 * key0;
                    const v2u lo = *(const LAS v2u*)vp, hi = *(const LAS v2u*)(vp + 16);
                    v4u vw; vw.x = lo.x; vw.y = lo.y; vw.z = hi.x; vw.w = hi.y;
                    o[dt] = __builtin_amdgcn_mfma_f32_32x32x16_bf16(__builtin_bit_cast(s16x8, vw), pf, o[dt], 0, 0, 0); }
            }
        float ssq = 0.f;
#pragma unroll
        for (int dt = 0; dt < 2; ++dt)
#pragma unroll
            for (int i = 0; i < 16; ++i) { const float y = o[dt][i] * inv; o[dt][i] = y; ssq += y * y; }
        ssq += __shfl_xor(ssq, 32);
        if (hh == 0) pg8::fx_add(ssb + t, ssq);
#pragma unroll
        for (int dt = 0; dt < 2; ++dt)
#pragma unroll
            for (int g = 0; g < 4; ++g) { const int cc = hq * 64 + 32 * dt + 8 * g + 4 * hh;
                const v2u gwv = gw[dt][g]; const f32x4 nv = *(const f32x4*)(nrm + cc);
                v2u ov; ov.x = cvtpk(o[dt][4 * g + 0] * nv[0] * silu(bflo(gwv.x)), o[dt][4 * g + 1] * nv[1] * silu(bfhi(gwv.x)));
                ov.y = cvtpk(o[dt][4 * g + 2] * nv[2] * silu(bflo(gwv.y)), o[dt][4 * g + 3] * nv[3] * silu(bfhi(gwv.y)));
                *(v2u*)(mix + t * LDK + MIX_B + cc) = ov; }
#pragma unroll
        for (int s = 0; s < 4; ++s) qf[s] = qn[s];
    }
    __syncthreads();
}
constexpr int RG_TOK = 128, RG_ROW = 272, RG_HP_OFF = RG_TOK * RG_ROW, RG_HP_ROW = 576, RG_CARRY_OFF = RG_HP_OFF + RG_TOK * RG_HP_ROW;
__device__ __forceinline__ void rg_unit(const bf16* __restrict__ h, const float* __restrict__ ccw, const float* __restrict__ ccb, const bf16* __restrict__ wg, const float* __restrict__ br, const float* __restrict__ bi,
                                        const float* __restrict__ lam, const float* __restrict__ nrm, bf16* __restrict__ mix, fx_t* __restrict__ ssc, unsigned long long* gran, unsigned* tmo, const unsigned epoch,
                                        LAS unsigned char* lds, const int c, const int hd, const int b, const int tid) {
    const int lane = tid & 63, wave = tid >> 6;
    const size_t T0 = (size_t)b * SEQ + RG_TOK * c;
    constexpr float LOG2E = 1.44269504088896341f;
    const int l15 = lane & 15, lg = lane >> 4, chl = 16 * wave + l15, ch = hd * 128 + chl;
    s16x8 Br[4], Bi[4];
    { const bf16* wrp = wg + ((size_t)hd * 128 + chl) * 128 + 8 * lg; const bf16* wip = wrp + (size_t)8 * 128 * 128;
#pragma unroll
      for (int s = 0; s < 4; ++s) { Br[s] = *(const s16x8*)(wrp + 32 * s); Bi[s] = *(const s16x8*)(wip + 32 * s); } }
    const float brv = br[ch] * LOG2E, biv = bi[ch] * LOG2E, L2 = -8.f * log1pf(expf(-lam[ch])) * LOG2E;
    {
        const int g = tid & 15, tr = tid >> 4, ch = hd * 128 + 8 * g;
        float w[4][8], bs[8];
#pragma unroll
        for (int k = 0; k < 4; ++k) { const f32x4 a = *(const f32x4*)(ccw + k * 1024 + ch), q = *(const f32x4*)(ccw + k * 1024 + ch + 4);
#pragma unroll
            for (int e = 0; e < 4; ++e) { w[k][e] = a[e]; w[k][4 + e] = q[e]; } }
        { const f32x4 a = *(const f32x4*)(ccb + ch), q = *(const f32x4*)(ccb + ch + 4);
#pragma unroll
          for (int e = 0; e < 4; ++e) { bs[e] = a[e]; bs[4 + e] = q[e]; } }
        v4u rows[7];
#pragma unroll
        for (int i = 0; i < 7; ++i) { const int trow = 4 * tr - 3 + i; const bool ok = (c > 0) || (trow >= 0);
            v4u z = {0u, 0u, 0u, 0u}; if (ok) z = *(const v4u*)(h + (size_t)((long)T0 + trow) * INW + OFF_CX + ch); rows[i] = z; }
#pragma unroll
        for (int i = 0; i < 4; ++i) { float o[8];
#pragma unroll
            for (int e = 0; e < 8; ++e) { float acc = bs[e];
#pragma unroll
                for (int k = 0; k < 4; ++k) { const unsigned wd = rows[i + k][e >> 1]; acc += w[k][e] * ((e & 1) ? bfhi(wd) : bflo(wd)); }
                o[e] = acc; }
            v4u ov; ov.x = cvtpk(o[0], o[1]); ov.y = cvtpk(o[2], o[3]); ov.z = cvtpk(o[4], o[5]); ov.w = cvtpk(o[6], o[7]);
            *(LAS v4u*)(lds + (4 * tr + i) * RG_ROW + 16 * g) = ov; }
    }
    __syncthreads();
    float Prun = 1.f, Hrun = 0.f;
    {
#pragma unroll 2
        for (int tt = 0; tt < RG_TOK / 16; ++tt) {
            const LAS unsigned char* ap = lds + (16 * tt + l15) * RG_ROW + 16 * lg;
            pg8::f32x4 ar = {0.f, 0.f, 0.f, 0.f}, ai = {0.f, 0.f, 0.f, 0.f};
#pragma unroll
            for (int s = 0; s < 4; ++s) { const s16x8 af = *(const LAS s16x8*)(ap + 64 * s);
                ar = __builtin_amdgcn_mfma_f32_16x16x32_bf16(af, Br[s], ar, 0, 0, 0); ai = __builtin_amdgcn_mfma_f32_16x16x32_bf16(af, Bi[s], ai, 0, 0, 0); }
            float pl[4], hl[4]; float P = 1.f, H = 0.f;
#pragma unroll
            for (int rg = 0; rg < 4; ++rg) { const int trow = 16 * tt + 4 * lg + rg;
                const float xcv = bf2f(*(const LAS unsigned short*)(lds + trow * RG_ROW + 2 * chl));
                const float rr = __builtin_amdgcn_rcpf(1.f + __builtin_amdgcn_exp2f(-(ar[rg] * LOG2E + brv)));
                const float ig = __builtin_amdgcn_rcpf(1.f + __builtin_amdgcn_exp2f(-(ai[rg] * LOG2E + biv)));
                const float a = __builtin_amdgcn_exp2f(rr * L2);
                const float u = __builtin_amdgcn_sqrtf(fmaxf(fmaf(-a, a, 1.f), 0.f)) * (ig * xcv);
                H = a * H + u; P = a * P; pl[rg] = P; hl[rg] = H; }
            float myP = Prun, myH = Hrun, Pst = Prun, Hst = Hrun;
#pragma unroll
            for (int x = 0; x < 4; ++x) { const float Ax = __shfl(P, l15 + 16 * x), Hx = __shfl(H, l15 + 16 * x);
                if (x == lg) { myP = Pst; myH = Hst; }
                Hst = Ax * Hst + Hx; Pst = Ax * Pst; }
            Prun = Pst; Hrun = Hst;
#pragma unroll
            for (int rg = 0; rg < 4; ++rg) *(LAS unsigned*)(lds + RG_HP_OFF + (16 * tt + 4 * lg + rg) * RG_HP_ROW + 4 * chl) = cvtpk(hl[rg] + pl[rg] * myH, pl[rg] * myP);
        }
    }
    unsigned gwv[RG_TOK / 8];
    { const size_t tbq = T0 + wave * (RG_TOK / 8);
#pragma unroll
      for (int i = 0; i < RG_TOK / 8; ++i) gwv[i] = *(const unsigned*)(h + (tbq + i) * INW + OFF_CG + hd * 128 + 2 * lane); }
    if (lg == 0) { unsigned long long* gp = gran + ((((size_t)b * 8 + hd) * 16 + c) * 128 + chl) * 2;
        __hip_atomic_store(gp, ((unsigned long long)epoch << 32) | __builtin_bit_cast(unsigned, Prun), __ATOMIC_RELAXED, __HIP_MEMORY_SCOPE_AGENT);
        __hip_atomic_store(gp + 1, ((unsigned long long)epoch << 32) | __builtin_bit_cast(unsigned, Hrun), __ATOMIC_RELAXED, __HIP_MEMORY_SCOPE_AGENT); }
    if (tid < 128) {
        const unsigned long long* gq = gran + (((size_t)b * 8 + hd) * 16 * 128 + tid) * 2;
        float Av[15], Hv[15]; unsigned spins = 0;
        for (;;) { bool ok = true;
#pragma unroll
            for (int cp = 0; cp < 15; ++cp) { Av[cp] = 1.f; Hv[cp] = 0.f;
                if (cp < c) { const unsigned long long xa = __hip_atomic_load(gq + cp * 256, __ATOMIC_RELAXED, __HIP_MEMORY_SCOPE_AGENT), xh = __hip_atomic_load(gq + cp * 256 + 1, __ATOMIC_RELAXED, __HIP_MEMORY_SCOPE_AGENT);
                    ok = ok && ((unsigned)(xa >> 32) == epoch) && ((unsigned)(xh >> 32) == epoch); Av[cp] = __builtin_bit_cast(float, (unsigned)xa); Hv[cp] = __builtin_bit_cast(float, (unsigned)xh); } }
            if (ok) break;
            if (++spins > 40000u) { __hip_atomic_store(tmo, 1u, __ATOMIC_RELAXED, __HIP_MEMORY_SCOPE_AGENT); break; }
            __builtin_amdgcn_s_sleep(2); }
        float carry = 0.f;
#pragma unroll
        for (int cp = 0; cp < 15; ++cp) if (cp < c) carry = Av[cp] * carry + Hv[cp];
        ((LAS float*)(lds + RG_CARRY_OFF))[tid] = carry;
    }
    __syncthreads();
    {
        const float n0 = nrm[hd * 128 + 2 * lane], n1 = nrm[hd * 128 + 2 * lane + 1];
        const float c0 = ((const LAS float*)(lds + RG_CARRY_OFF))[2 * lane], c1 = ((const LAS float*)(lds + RG_CARRY_OFF))[2 * lane + 1];
        const size_t tb = T0 + wave * (RG_TOK / 8);
        float ssq[RG_TOK / 8];
#pragma unroll
        for (int i = 0; i < RG_TOK / 8; ++i) { const int row = wave * (RG_TOK / 8) + i;
            const v2u hw = *(const LAS v2u*)(lds + RG_HP_OFF + row * RG_HP_ROW + 8 * lane);
            const float y0 = bflo(hw.x) + bfhi(hw.x) * c0, y1 = bflo(hw.y) + bfhi(hw.y) * c1;
            ssq[i] = y0 * y0 + y1 * y1;
            *(unsigned*)(mix + (tb + i) * LDK + MIX_C + hd * 128 + 2 * lane) = cvtpk(y0 * n0 * silu(bflo(gwv[i])), y1 * n1 * silu(bfhi(gwv[i]))); }
#pragma unroll
        for (int st = 0; st < 4; ++st) { const int hm = 8 >> st, bit = 1 << st;
            const bool up = (lane & bit) != 0;
#pragma unroll
            for (int k = 0; k < hm; ++k) { const float mine = up ? ssq[k + hm] : ssq[k], other = up ? ssq[k] : ssq[k + hm]; ssq[k] = mine + __shfl_xor(other, bit); } }
        float tot = ssq[0]; tot += __shfl_xor(tot, 16); tot += __shfl_xor(tot, 32);
        if (lane < 16) { const int row = 8 * (lane & 1) + 4 * ((lane >> 1) & 1) + 2 * ((lane >> 2) & 1) + ((lane >> 3) & 1); pg8::fx_add(ssc + tb + row, tot); }
    }
    __syncthreads();
}
__device__ __forceinline__ void final_ln_token(const bf16* __restrict__ yb, const fx_t* __restrict__ st, const float* __restrict__ g, const float* __restrict__ bta, float* __restrict__ xo, int t, int lane) {
    const float s = pg8::fx_get(st + 2 * (size_t)t), q = pg8::fx_get(st + 2 * (size_t)t + 1);
    const float mean = s * (1.f / DM), rstd = rsqrtf(fmaxf(q * (1.f / DM) - mean * mean, 0.f) + LN_EPS);
#pragma unroll
    for (int j = 0; j < 8; ++j) { const int cc = 8 * (lane + 64 * j);
        const v4u hw = *(const v4u*)(yb + (size_t)t * LDK + cc);
        const f32x4 g0 = *(const f32x4*)(g + cc), g1 = *(const f32x4*)(g + cc + 4), b0 = *(const f32x4*)(bta + cc), b1 = *(const f32x4*)(bta + cc + 4);
        f32x4 o0, o1;
        o0[0] = (bflo(hw[0]) - mean) * rstd * g0[0] + b0[0]; o0[1] = (bfhi(hw[0]) - mean) * rstd * g0[1] + b0[1];
        o0[2] = (bflo(hw[1]) - mean) * rstd * g0[2] + b0[2]; o0[3] = (bfhi(hw[1]) - mean) * rstd * g0[3] + b0[3];
        o1[0] = (bflo(hw[2]) - mean) * rstd * g1[0] + b1[0]; o1[1] = (bfhi(hw[2]) - mean) * rstd * g1[1] + b1[1];
        o1[2] = (bflo(hw[3]) - mean) * rstd * g1[2] + b1[2]; o1[3] = (bfhi(hw[3]) - mean) * rstd * g1[3] + b1[3];
        __builtin_nontemporal_store(o0, (f32x4*)(xo + (size_t)t * DM + cc)); __builtin_nontemporal_store(o1, (f32x4*)(xo + (size_t)t * DM + cc + 4)); }
}

struct Args { const float* in[17]; float* out; unsigned char* ws; };
#define KA_AS __attribute__((address_space(4)))
#define AIN(k) (*(const float* const KA_AS*)(ka_ + 8 * (k)))
#define AOUT (*(float* const KA_AS*)(ka_ + 8 * 17))
#define AWS (*(unsigned char* const KA_AS*)(ka_ + 8 * 18))
#define TZ_INIT() const KA_AS unsigned char* ka_ = (const KA_AS unsigned char*)__builtin_amdgcn_kernarg_segment_ptr(); asm volatile("" : "+s"(ka_)); int lz = l_; asm volatile("" : "+s"(lz)); const int l = lz; (void)l; int tz = threadIdx.x; asm volatile("" : "+v"(tz)); const int tid = tz, lane = tz & 63, wave = __builtin_amdgcn_readfirstlane(tz >> 6); const int G = gridDim.x, gw = blockIdx.x * NWAVES + wave, NGW = G * NWAVES; (void)tid; (void)lane; (void)gw; (void)NGW
__global__ void __launch_bounds__(NTHR, 2) fwd(Args args) {
    extern __shared__ __attribute__((aligned(16))) unsigned char lds_raw[];
    LAS unsigned char* lds = (LAS unsigned char*)lds_raw;
    volatile LAS unsigned* MISC = (volatile LAS unsigned*)(lds + LDS_MISC);
    for (int u = threadIdx.x; u < (LDS_BYTES - 131072) / 4; u += NTHR) ((LAS unsigned*)(lds + 131072))[u] = 0u;
    __syncthreads();
    (void)xcd_barrier_post((unsigned*)(args.ws + WS_CTL) + 4096, MISC + 8);
#define GRID_BARRIER() do { XcdBarrier b_; b_.bar = (unsigned*)(args.ws + WS_CTL) + 4096; b_.x = xb_xcc_id(); b_.st = (volatile LAS unsigned*)(lds + LDS_MISC) + 8; xcd_barrier(b_); } while (0)
#define WSP(T, off) ((T*)(AWS + (off)))

    {
        const int l_ = 0; TZ_INIT();
        LAS float* scr = (LAS float*)(lds + wave * 16384);
        for (int ll = 0; ll < DEPTH; ++ll) convert_layer(AIN(1), AIN(14), AIN(15), AIN(16), AWS, ll, scr, gw, NGW, lane);
        for (int it = gw; it < DEPTH * 2 * 8 * 2; it += NGW) {
            const int nb = it & 1, hd = (it >> 1) & 7, gate = (it >> 4) & 1, ll = it >> 5;
            convert_task<false, false>(AIN(gate ? 8 : 6) + ((size_t)ll * 8 + hd) * 128 * 128, WSP(bf16, WS_WG) + (((size_t)ll * 2 + gate) * 8 + hd) * 128 * 128, 128, 128, scr, nb, 0, 2, lane, nullptr, nullptr, nullptr, nullptr); }
        const float* x = AIN(0); bf16* xb = WSP(bf16, WS_XB);
        for (size_t i = (size_t)blockIdx.x * NTHR + tid; i < (size_t)M * DM / 8; i += (size_t)G * NTHR) {
            const f32x4 a = ((const f32x4*)x)[2 * i], b = ((const f32x4*)x)[2 * i + 1];
            v4u o; o.x = pk2(a[0], a[1]); o.y = pk2(a[2], a[3]); o.z = pk2(b[0], b[1]); o.w = pk2(b[2], b[3]);
            const size_t row = i / (DM / 8), cc = i % (DM / 8);
            *(v4u*)(xb + row * LDK + 8 * cc) = o; }
    }
    GRID_BARRIER();
    for (int l_ = 0; l_ < DEPTH; ++l_) {
#define GEMM1_TABLES(S_) do { const fx_t* stp = WSP(fx_t, WS_CTL + CTL_ST) + (size_t)(l > 0 ? l - 1 : 0) * M * 2; const fx_t* Gv = WSP(fx_t, WS_CTL + CTL_GV) + (size_t)l * INW; const fx_t* Bvv = WSP(fx_t, WS_CTL + CTL_BV) + (size_t)l * INW; \
            _Pragma("unroll") for (int i = 0; i < 6; ++i) { pg8::Unit u; if ((S_).next(i, u)) { \
                if (tid < 256) { float mu = 0.f, rs = 1.f; \
                    if (l > 0) { const float s = pg8::fx_get(stp + 2 * (size_t)(u.pm * 256 + tid)), q = pg8::fx_get(stp + 2 * (size_t)(u.pm * 256 + tid) + 1); mu = s * (1.f / DM); rs = rsqrtf(fmaxf(q * (1.f / DM) - mu * mu, 0.f) + LN_EPS); } \
                    ((LAS pg8::f32x2*)(lds + pg8::TBL_ROW))[i * 256 + tid] = (pg8::f32x2){mu, rs}; } \
                else { const int cidx = u.pn * 256 + tid - 256; float gg = 0.f, bb = 0.f; if (l > 0) { gg = pg8::fx_get(Gv + cidx); bb = pg8::fx_get(Bvv + cidx); } \
                    ((LAS pg8::f32x2*)(lds + pg8::TBL_COL))[i * 256 + tid - 256] = (pg8::f32x2){gg, bb}; } } } } while (0)
        { TZ_INIT();
          pg8::Gemm g; g.A = WSP(bf16, WS_XB); g.Bt = WSP(bf16, WS_WIN) + (size_t)l * WIN_L; g.M = M; g.N = INW - 512; g.K = DM; g.ld = LDK; pg8::EpiBf16LN E; E.O = WSP(bf16, WS_H); E.ldc = INW; E.pad = 0;
          pg8::StaticOrder S; S.init(M, INW - 512, G, (int)blockIdx.x);
          auto pre = [&]() { GEMM1_TABLES(S); };
          pg8::gemm_phase<pg8::EpiBf16LN, pg8::StaticOrder, true, true>(lds, g, S, E, tid, pre); }
        GRID_BARRIER();
        { TZ_INIT();
          pg8::Gemm g; g.A = WSP(bf16, WS_XB); g.Bt = WSP(bf16, WS_WIN) + (size_t)l * WIN_L; g.M = M; g.N = INW; g.K = DM; g.ld = LDK; pg8::EpiBf16LN E; E.O = WSP(bf16, WS_H); E.ldc = INW; E.pad = 0;
          pg8::OneUnit S; { const int bx = (int)blockIdx.x, x = bx & 7, idx = bx >> 3; S.has = (bx < 64) ? 1 : 0; S.pm = 4 * x + (idx >> 1); S.pn = (INW / 256 - 2) + (idx & 1); }
          if (S.has) { auto pre = [&]() { GEMM1_TABLES(S); }; pg8::gemm_phase<pg8::EpiBf16LN, pg8::OneUnit, false, true>(lds, g, S, E, tid, pre); } }
#define Q_NEXT() do { if (tid == 0) *qw = __hip_atomic_fetch_add(qctr, 1u, __ATOMIC_RELAXED, __HIP_MEMORY_SCOPE_AGENT); __syncthreads(); tk = (int)__builtin_amdgcn_readfirstlane((int)*qw); __syncthreads(); } while (0)
        { TZ_INIT();
          unsigned* qctr = WSP(unsigned, WS_CTL + CTL_Q) + 64 * l; LAS unsigned* qw = (LAS unsigned*)(lds + LDS_MISC) + 16; int tk;
          fx_t* ssb = WSP(fx_t, WS_CTL + CTL_SS) + (size_t)(2 * l) * M;
          Q_NEXT();
          while (tk < 256) { attn_unit(WSP(bf16, WS_H), AIN(3) + (size_t)l * NQH, AIN(12) + (size_t)l * WB, WSP(bf16, WS_MIX), ssb, lds, tk, tid); Q_NEXT(); } }
        { TZ_INIT();
          unsigned* qctr = WSP(unsigned, WS_CTL + CTL_Q) + 64 * l; LAS unsigned* qw = (LAS unsigned*)(lds + LDS_MISC) + 16; int tk = (int)__builtin_amdgcn_readfirstlane((int)*qw);
          fx_t* ssc = WSP(fx_t, WS_CTL + CTL_SS) + (size_t)(2 * l + 1) * M;
          while (tk < 512) { const int r = tk - 256;
              rg_unit(WSP(bf16, WS_H), AIN(4) + (size_t)l * 4 * WC, AIN(5) + (size_t)l * WC, WSP(bf16, WS_WG) + (size_t)l * 2 * 8 * 128 * 128, AIN(7) + (size_t)l * WC, AIN(9) + (size_t)l * WC,
                      AIN(10) + (size_t)l * WC, AIN(13) + (size_t)l * WC, WSP(bf16, WS_MIX), ssc, WSP(unsigned long long, WS_CTL + CTL_GR), WSP(unsigned, WS_CTL) + 8, (unsigned)(l + 1), lds, r >> 4, r & 3, (r >> 2) & 3, tid);
              Q_NEXT(); } }
        { TZ_INIT();
          unsigned* qctr = WSP(unsigned, WS_CTL + CTL_Q) + 64 * l; LAS unsigned* qw = (LAS unsigned*)(lds + LDS_MISC) + 16; int tk = (int)__builtin_amdgcn_readfirstlane((int)*qw);
          while (tk < 768) { const int t0 = 32 * (tk - 512) + 4 * wave;
              branch_a_pair(WSP(bf16, WS_H), AIN(2) + (size_t)l * 3 * WA, AIN(11) + (size_t)l * WA, WSP(bf16, WS_MIX), t0, lane);
              branch_a_pair(WSP(bf16, WS_H), AIN(2) + (size_t)l * 3 * WA, AIN(11) + (size_t)l * WA, WSP(bf16, WS_MIX), t0 + 2, lane);
              Q_NEXT(); } }
        GRID_BARRIER();
        { TZ_INIT();
          fx_t* ssc = WSP(fx_t, WS_CTL + CTL_SS) + (size_t)(2 * l + 1) * M;
          for (int r = blockIdx.x; r < 256; r += G)
              rg_unit(WSP(bf16, WS_H), AIN(4) + (size_t)l * 4 * WC, AIN(5) + (size_t)l * WC, WSP(bf16, WS_WG) + (size_t)l * 2 * 8 * 128 * 128, AIN(7) + (size_t)l * WC, AIN(9) + (size_t)l * WC,
                      AIN(10) + (size_t)l * WC, AIN(13) + (size_t)l * WC, WSP(bf16, WS_MIX), ssc, WSP(unsigned long long, WS_CTL + CTL_GR), WSP(unsigned, WS_CTL) + 8, (unsigned)(l + 1), lds, r >> 4, 4 + (r & 3), (r >> 2) & 3, tid); }
        GRID_BARRIER();
        { TZ_INIT();
          pg8::Gemm g; g.A = WSP(bf16, WS_MIX); g.Bt = WSP(bf16, WS_WOUT) + (size_t)l * WOUT_L; g.M = M; g.N = DM; g.K = DMIX; g.ld = LDK;
          pg8::EpiResLN E; E.Yb = WSP(bf16, WS_XB); const float* lng = AIN(15) + (size_t)(l > 0 ? l - 1 : 0) * DM; const float* lnb = AIN(16) + (size_t)(l > 0 ? l - 1 : 0) * DM;
          E.st = WSP(fx_t, WS_CTL + CTL_ST) + (size_t)l * M * 2; E.alpha = ALPHA; E.ldb = LDK;
          pg8::StaticOrder S; S.init(M, DM, G, (int)blockIdx.x);
          auto pre = [&]() { const fx_t* ssb = WSP(fx_t, WS_CTL + CTL_SS) + (size_t)(2 * l) * M; const fx_t* ssc = ssb + M; const fx_t* stp = WSP(fx_t, WS_CTL + CTL_ST) + (size_t)(l > 0 ? l - 1 : 0) * M * 2;
            pg8::Unit u; if (S.next(wave >> 2, u)) { const int grow = u.pm * 256 + (tid & 255);
                const float rb = rsqrtf(pg8::fx_get(ssb + grow) * (1.f / WB) + RMS_EPS), rc = rsqrtf(pg8::fx_get(ssc + grow) * (1.f / WC) + RMS_EPS); float mu = 0.f, rs = 1.f;
                if (l > 0) { const float s = pg8::fx_get(stp + 2 * (size_t)grow), q = pg8::fx_get(stp + 2 * (size_t)grow + 1); mu = s * (1.f / DM); rs = rsqrtf(fmaxf(q * (1.f / DM) - mu * mu, 0.f) + LN_EPS); }
                ((LAS pg8::f32x4*)(lds + pg8::TBL_ROW))[tid] = (pg8::f32x4){rc / rb, rb, mu, rs};
                float gg = 1.f, bb = 0.f; if (l > 0) { gg = lng[u.pn * 256 + (tid & 255)]; bb = lnb[u.pn * 256 + (tid & 255)]; }
                ((LAS pg8::f32x2*)(lds + pg8::TBL_COL))[tid] = (pg8::f32x2){gg, bb}; } };
          pg8::gemm_phase<pg8::EpiResLN, pg8::StaticOrder, true, true>(lds, g, S, E, tid, pre); }
        GRID_BARRIER();
    }
    { const int l_ = DEPTH - 1; TZ_INIT();
      for (int t = gw; t < M; t += NGW) final_ln_token(WSP(bf16, WS_XB), WSP(fx_t, WS_CTL + CTL_ST) + (size_t)l * M * 2, AIN(15) + (size_t)l * DM, AIN(16) + (size_t)l * DM, AOUT, t, lane); }
}

extern "C" void kernel_launch(void* const* d_in, const int* in_sizes, int n_in, void* d_out, int out_size, void* d_ws, size_t ws_size, hipStream_t stream) {
    static int grid = 0;
    if (grid == 0) {
        if (n_in != 17 || in_sizes[0] != M * DM || out_size != M * DM || ws_size < WS_END) { fprintf(stderr, "kernel_launch: unexpected shapes/workspace (n_in %d, ws %zu)\n", n_in, ws_size); grid = -1; return; }
        int dev = 0, cus = 0, per_cu = 0;
        if (hipGetDevice(&dev) != hipSuccess || hipDeviceGetAttribute(&cus, hipDeviceAttributeMultiprocessorCount, dev) != hipSuccess) { grid = -1; return; }
        if (hipFuncSetAttribute((const void*)fwd, hipFuncAttributeMaxDynamicSharedMemorySize, LDS_BYTES) != hipSuccess) { fprintf(stderr, "kernel_launch: hipFuncSetAttribute failed\n"); grid = -1; return; }
        if (hipOccupancyMaxActiveBlocksPerMultiprocessor(&per_cu, (const void*)fwd, NTHR, LDS_BYTES) != hipSuccess || per_cu < 1) fprintf(stderr, "kernel_launch: occupancy query reports %d\n", per_cu);
        (void)hipGetLastError();
        grid = cus > 0 ? cus : 256;
        if (grid < 256) { fprintf(stderr, "kernel_launch: this kernel's unit tables assume at least 256 workgroups (one per CU of a 256-CU device); found %d CUs: nothing launched\n", grid); grid = -1; return; }
    }
    if (grid < 0) return;
    (void)hipMemsetAsync((char*)d_ws + WS_CTL, 0, CTL_BYTES, stream);
    Args a{};
    for (int i = 0; i < 17; ++i) a.in[i] = (const float*)d_in[i];
    a.out = (float*)d_out; a.ws = (unsigned char*)d_ws;
    hipLaunchKernelGGL(fwd, dim3(grid), dim3(NTHR), LDS_BYTES, stream, a);
}
```

```cpp
#include <hip/hip_runtime.h>
#include <cstdio>
#include <cstdint>
namespace pg8 {
#define PG8_LAS __attribute__((address_space(3)))
typedef unsigned short bf16_t;
typedef short bf16x8 __attribute__((ext_vector_type(8)));
typedef float f32x4 __attribute__((ext_vector_type(4)));
typedef float f32x2 __attribute__((ext_vector_type(2)));
typedef unsigned u32x4 __attribute__((ext_vector_type(4)));
constexpr int BM = 256, BK = 64, HALF = 128, HTB = HALF * BK * 2  , STAGE_BYTES = 8 * HTB, NXCD = 8, WGM = 8;

__host__ __device__ __forceinline__ int lds_byte(int r, int c) { const int st = (r >> 4) * 2 + (c >> 5), rr = r & 15, cc = c & 31, ob = rr * 64 + cc * 2; return st * 1024 + (ob ^ (((ob >> 9) & 1) << 5)); }
__host__ __device__ __forceinline__ void stage_rc(int b, int& R, int& C) { const int st = b / 1024, sb = b % 1024, swz = sb ^ (((sb >> 9) & 1) << 5); R = (st >> 1) * 16 + swz / 64; C = (st & 1) * 32 + (swz % 64) / 2; }
__host__ __device__ __forceinline__ int perm32(int rho) { const int n = rho >> 4, i = rho & 15; return 8 * (i >> 2) + 4 * n + (i & 3); }

struct Unit { int pm, pn; };
struct Gemm { const bf16_t* A; const bf16_t* Bt; int M, N, K, ld; };

struct StaticOrder {
    int nM, nN, nwg, G, c;
    __host__ __device__ void init(int M, int N, int G_, int c_) { nM = M / BM; nN = N / BM; nwg = nM * nN; G = G_; c = c_; }
    __host__ __device__ bool next(int i, Unit& u) const {
        const long L = (long)i * G + c; if (L >= nwg) return false;
        int wgid = (int)L; { const int q = nwg / NXCD, r = nwg % NXCD, xcd = wgid % NXCD, off = wgid / NXCD; wgid = (xcd < r ? xcd * (q + 1) : r * (q + 1) + (xcd - r) * q) + off; }
        const int nig = WGM * nN, gid = wgid / nig, fm = gid * WGM, gsz = (nM - fm) < WGM ? (nM - fm) : WGM;
        u.pm = fm + ((wgid % nig) % gsz); u.pn = (wgid % nig) / gsz; return true;
    }
    __device__ __forceinline__ void a_ready(const Unit&) const {}
    __device__ __forceinline__ void done(const Unit&) const {}
};

struct OneUnit {
    int pm, pn, has;
    __host__ __device__ bool next(int i, Unit& u) const { if (i != 0 || !has) return false; u.pm = pm; u.pn = pn; return true; }
    __device__ __forceinline__ void a_ready(const Unit&) const {}
    __device__ __forceinline__ void done(const Unit&) const {}
};

__device__ __forceinline__ void fx_add(unsigned long long* p, float v) { atomicAdd(p, (unsigned long long)__float2ll_rn(v * 4294967296.f)); }
__device__ __forceinline__ float fx_get(const unsigned long long* p) { return (float)(long long)(*p) * 2.3283064365386963e-10f; }
__device__ __forceinline__ unsigned cvt_pk_bf16(float lo, float hi) { unsigned r; asm volatile("v_cvt_pk_bf16_f32 %0, %1, %2" : "=v"(r) : "v"(lo), "v"(hi)); return r; }

constexpr int TBL_ROW = 131072 + 2048;
constexpr int TBL_COL = TBL_ROW + 6 * 256 * 8;
struct EpiBf16LN {
    static constexpr bool PERM = true, AFTER_DRAIN = false, KSCALE = false;
    bf16_t* O; int ldc, pad;
    __device__ __forceinline__ void operator()(const f32x4 (&acc)[2][2][4][2], const Unit& u, int wr, int wc, int fr, int fq, int ui, PG8_LAS unsigned char* lds) const {
        const int row0 = u.pm * BM + wr * 64 + fr; const int col0 = u.pn * BM + wc * 32 + 8 * fq;
        const PG8_LAS f32x2* rt = (const PG8_LAS f32x2*)(lds + TBL_ROW) + ui * 256 + wr * 64 + fr;
        const PG8_LAS f32x4* ct = (const PG8_LAS f32x4*)(lds + TBL_COL + (ui * 256 + wc * 32 + 8 * fq) * 8);
        f32x4 cq[2][2][2];
#pragma unroll
        for (int bj = 0; bj < 2; ++bj)
#pragma unroll
            for (int n = 0; n < 2; ++n) { cq[bj][n][0] = ct[(bj * HALF + 4 * n) / 2]; cq[bj][n][1] = ct[(bj * HALF + 4 * n) / 2 + 1]; }
#pragma unroll
        for (int ai = 0; ai < 2; ++ai)
#pragma unroll
            for (int m = 0; m < 4; ++m) { bf16_t* rowp = O + (size_t)(row0 + ai * HALF + m * 16) * ldc + col0; const f32x2 ms = rt[ai * HALF + m * 16]; const float mu = ms.x, rs = ms.y;
#pragma unroll
                for (int bj = 0; bj < 2; ++bj) { float o[8];
#pragma unroll
                    for (int n = 0; n < 2; ++n) { const f32x4 v = acc[ai][bj][m][n];
                        o[4 * n + 0] = rs * (v[0] - mu * cq[bj][n][0][0]) + cq[bj][n][0][1]; o[4 * n + 1] = rs * (v[1] - mu * cq[bj][n][0][2]) + cq[bj][n][0][3];
                        o[4 * n + 2] = rs * (v[2] - mu * cq[bj][n][1][0]) + cq[bj][n][1][1]; o[4 * n + 3] = rs * (v[3] - mu * cq[bj][n][1][2]) + cq[bj][n][1][3]; }
                    u32x4 w; w.x = cvt_pk_bf16(o[0], o[1]); w.y = cvt_pk_bf16(o[2], o[3]); w.z = cvt_pk_bf16(o[4], o[5]); w.w = cvt_pk_bf16(o[6], o[7]);
                    *(u32x4*)(rowp + bj * HALF) = w; } }
    }
};
struct EpiResLN {
    static constexpr bool PERM = true, AFTER_DRAIN = false, KSCALE = true;
    static constexpr int KS1 = 16, KS2 = 48;
    bf16_t* Yb; unsigned long long* st; float alpha; int ldb;
    __device__ __forceinline__ void kscale(f32x4 (&acc)[2][2][4][2], int ui, int which, int wr, int fr, PG8_LAS unsigned char* lds) const {
        const PG8_LAS f32x4* tbl = (const PG8_LAS f32x4*)(lds + TBL_ROW) + ui * 256 + wr * 64 + fr;
#pragma unroll
        for (int ai = 0; ai < 2; ++ai)
#pragma unroll
            for (int m = 0; m < 4; ++m) { const f32x4 fv = tbl[ai * HALF + m * 16]; const float f = which ? fv[1] : fv[0];
#pragma unroll
                for (int bj = 0; bj < 2; ++bj)
#pragma unroll
                    for (int n = 0; n < 2; ++n) acc[ai][bj][m][n] = acc[ai][bj][m][n] * f; }
    }
    static __device__ __forceinline__ float lo16(unsigned w) { return __builtin_bit_cast(float, w << 16); }
    static __device__ __forceinline__ float hi16(unsigned w) { return __builtin_bit_cast(float, w & 0xffff0000u); }
    __device__ __forceinline__ void operator()(const f32x4 (&acc)[2][2][4][2], const Unit& u, int wr, int wc, int fr, int fq, int ui, PG8_LAS unsigned char* lds) const {
        const int row0 = u.pm * BM + wr * 64 + fr, col0 = u.pn * BM + wc * 32 + 8 * fq;
        const PG8_LAS f32x4* rt = (const PG8_LAS f32x4*)(lds + TBL_ROW) + ui * 256 + wr * 64 + fr;
        const PG8_LAS f32x4* ct = (const PG8_LAS f32x4*)(lds + TBL_COL + (ui * 256 + wc * 32 + 8 * fq) * 8);
        u32x4 A0[4][2];
#define EPI_LOAD(buf, stg) do { _Pragma("unroll") for (int bj_ = 0; bj_ < 2; ++bj_) { const int row_ = row0 + ((stg) >> 2) * HALF + ((stg) & 3) * 16; \
            A0[buf][bj_] = *(const u32x4*)(Yb + (size_t)row_ * ldb + col0 + bj_ * HALF); } } while (0)
        EPI_LOAD(0, 0); EPI_LOAD(1, 1); EPI_LOAD(2, 2);
        float sq[2][2];
#pragma unroll
        for (int stg = 0; stg < 8; ++stg) {
            const int ai = stg >> 2, m = stg & 3, mi = m & 1;
            if (stg + 3 < 8) { if (((stg + 3) & 3) == 0) EPI_LOAD(0, stg + 3); else if (((stg + 3) & 3) == 1) EPI_LOAD(1, stg + 3); else if (((stg + 3) & 3) == 2) EPI_LOAD(2, stg + 3); else EPI_LOAD(3, stg + 3); }
            asm volatile("" ::: "memory");
            { const int row = row0 + ai * HALF + m * 16; const f32x4 tv = rt[ai * HALF + m * 16]; const float mu = tv[2], rs = tv[3];
                float s = 0.f, q = 0.f;
#pragma unroll
                for (int bj = 0; bj < 2; ++bj) { const size_t oh = (size_t)row * ldb + col0 + bj * HALF;
                    const u32x4 w0 = ((stg & 3) == 0) ? A0[0][bj] : (((stg & 3) == 1) ? A0[1][bj] : (((stg & 3) == 2) ? A0[2][bj] : A0[3][bj]));
                    float xr[8];
#pragma unroll
                    for (int j = 0; j < 4; ++j) { const float ye = lo16(w0[j]), yo = hi16(w0[j]);
                        const f32x4 gb = ct[(bj * HALF) / 2 + j];
                        xr[2 * j] = (ye - mu) * rs * gb[0] + gb[1]; xr[2 * j + 1] = (yo - mu) * rs * gb[2] + gb[3]; }
                    float y[8];
#pragma unroll
                    for (int j = 0; j < 4; ++j) { y[j] = xr[j] * alpha + acc[ai][bj][m][0][j]; y[4 + j] = xr[4 + j] * alpha + acc[ai][bj][m][1][j]; }
#pragma unroll
                    for (int j = 0; j < 8; ++j) { s += y[j]; q += y[j] * y[j]; }
                    u32x4 hn;
#pragma unroll
                    for (int j = 0; j < 4; ++j) hn[j] = cvt_pk_bf16(y[2 * j], y[2 * j + 1]);
                    *(u32x4*)(Yb + oh) = hn; }
                s += __shfl_xor(s, 16); s += __shfl_xor(s, 32); q += __shfl_xor(q, 16); q += __shfl_xor(q, 32);
                sq[mi][0] = s; sq[mi][1] = q; }
            if (mi == 1) {
                const int mi2 = fq >> 1, wh = fq & 1; const int row = row0 + ai * HALF + ((m & 2) + mi2) * 16;
                const float v = mi2 ? (wh ? sq[1][1] : sq[1][0]) : (wh ? sq[0][1] : sq[0][0]);
                fx_add(st + 2 * (size_t)row + wh, v); }
        }
#undef EPI_LOAD
    }
};

template <class Epi, class Sched, bool ALIGN_EPI = false, bool SP2 = false, class Pre>
__device__ __forceinline__ void gemm_phase(PG8_LAS unsigned char* lds, const Gemm g, const Sched& S, const Epi& E, const int tid, const Pre& pre) {
    const int wid = __builtin_amdgcn_readfirstlane(tid >> 6), lane = tid & 63, wr = wid >> 2, wc = wid & 3, fr = lane & 15, fq = lane >> 4;
    const int K = g.ld, nt = g.K / BK;
    unsigned voffA[2], voffB[2];
#pragma unroll
    for (int i = 0; i < 2; ++i) { int R, C; stage_rc(tid * 16 + i * 8192, R, C); const int Rb = Epi::PERM ? ((R & ~31) + perm32(R & 31)) : R;
        voffA[i] = (unsigned)(R * K + C) * 2u; voffB[i] = (unsigned)(Rb * K + C) * 2u; }
    const size_t kstep = (size_t)(BK * 2);
    const size_t hstep = (size_t)HALF * K * 2;
    const size_t tstep = 2 * hstep;
    const unsigned ldsw = (unsigned)wid * 1024u;
    const int aoff = lds_byte(wr * 64 + fr, fq * 8), boff = lds_byte(wc * 32 + fr, fq * 8);
#define PG8_SA(b, h) (((b) * 2 + (h)) * HTB)
#define PG8_SB(b, h) ((4 + (b) * 2 + (h)) * HTB)
#define PG8_STAGE(bufoff, gbase, voff) do { _Pragma("unroll") for (int _i = 0; _i < 2; ++_i) \
        __builtin_amdgcn_global_load_lds((const unsigned*)((const char*)(gbase) + (voff)[_i]), (PG8_LAS unsigned*)(lds + (bufoff) + ldsw + _i * 8192), 16, 0, 0); } while (0)
#define PG8_LDA(dst, b, h) do { _Pragma("unroll") for (int m = 0; m < 4; ++m) _Pragma("unroll") for (int k = 0; k < 2; ++k) dst[m][k] = *(const PG8_LAS bf16x8*)(lds + PG8_SA(b, h) + aoff + m * 2048 + k * 1024); } while (0)
#define PG8_LDB(dst, b, h) do { _Pragma("unroll") for (int n = 0; n < 2; ++n) _Pragma("unroll") for (int k = 0; k < 2; ++k) dst[n][k] = *(const PG8_LAS bf16x8*)(lds + PG8_SB(b, h) + boff + n * 2048 + k * 1024); } while (0)
#define PG8_MMA(ai, bj, At, Bt) do { __builtin_amdgcn_s_setprio(1); _Pragma("unroll") for (int m = 0; m < 4; ++m) _Pragma("unroll") for (int n = 0; n < 2; ++n) _Pragma("unroll") for (int k = 0; k < 2; ++k) \
        acc[ai][bj][m][n] = __builtin_amdgcn_mfma_f32_16x16x32_bf16(Bt[n][k], At[m][k], acc[ai][bj][m][n], 0, 0, 0); __builtin_amdgcn_s_setprio(0); } while (0)
#define PG8_WAIT_V(n) asm volatile("s_waitcnt vmcnt(" #n ")" ::: "memory")
#define PG8_WAIT_L(n) asm volatile("s_waitcnt lgkmcnt(" #n ")" ::: "memory")
#define PG8_BAR __builtin_amdgcn_s_barrier()
#define PG8_SCHED __builtin_amdgcn_sched_barrier(0)
    Unit cur, nxt; int ui = 0;
    if (!S.next(0, cur)) return;
    f32x4 acc[2][2][4][2];
#pragma unroll
    for (int a = 0; a < 2; ++a)
#pragma unroll
        for (int b = 0; b < 2; ++b)
#pragma unroll
            for (int m = 0; m < 4; ++m)
#pragma unroll
                for (int n = 0; n < 2; ++n) acc[a][b][m][n] = (f32x4){0.f, 0.f, 0.f, 0.f};
    bf16x8 At[4][2], B0[2][2], B1[2][2];
    const char* cA = (const char*)g.A + (size_t)cur.pm * tstep; const char* cB = (const char*)g.Bt + (size_t)cur.pn * tstep;
    S.a_ready(cur);
    if constexpr (SP2) {
        PG8_STAGE(PG8_SB(0, 0), cB, voffB); PG8_STAGE(PG8_SB(0, 1), cB + hstep, voffB); PG8_STAGE(PG8_SA(0, 0), cA, voffA); PG8_STAGE(PG8_SA(0, 1), cA + hstep, voffA);
        pre();
        if (wr == 1) PG8_BAR;
        PG8_WAIT_V(2); PG8_BAR;
        PG8_STAGE(PG8_SB(1, 0), cB + kstep, voffB); PG8_STAGE(PG8_SA(1, 0), cA + kstep, voffA); PG8_STAGE(PG8_SB(1, 1), cB + hstep + kstep, voffB);
        PG8_WAIT_V(6); PG8_BAR;
    } else {
        PG8_STAGE(PG8_SB(0, 0), cB, voffB); PG8_STAGE(PG8_SA(0, 0), cA, voffA); PG8_STAGE(PG8_SB(0, 1), cB + hstep, voffB); PG8_STAGE(PG8_SA(0, 1), cA + hstep, voffA);
        if (wr == 1) PG8_BAR;
        PG8_WAIT_V(4); PG8_BAR;
        PG8_STAGE(PG8_SB(1, 0), cB + kstep, voffB); PG8_STAGE(PG8_SA(1, 0), cA + kstep, voffA); PG8_STAGE(PG8_SB(1, 1), cB + hstep + kstep, voffB);
        PG8_WAIT_V(6); PG8_BAR;
    }
    for (;;) {
        const bool has_next = S.next(ui + 1, nxt);
        const char* nA = has_next ? (const char*)g.A + (size_t)nxt.pm * tstep : cA; const char* nB = has_next ? (const char*)g.Bt + (size_t)nxt.pn * tstep : cB;
        for (int t = 0; t < nt; t += 2) {
            const bool last = (t == nt - 2);
            const char* a1 = cA + (size_t)(t + 1) * kstep;
            const char* a2 = last ? nA : cA + (size_t)(t + 2) * kstep; const char* b2 = last ? nB : cB + (size_t)(t + 2) * kstep;
            const char* a3 = a2 + kstep; const char* b3 = b2 + kstep;
            if (last && has_next) S.a_ready(nxt);
            if constexpr (Epi::KSCALE) { if (t == Epi::KS1 || t == Epi::KS2) E.kscale(acc, ui, t == Epi::KS1 ? 0 : 1, wr, fr, lds); }
            if constexpr (SP2) {
            PG8_LDB(B0, 0, 0); PG8_LDB(B1, 0, 1); PG8_SCHED; PG8_LDA(At, 0, 0); PG8_STAGE(PG8_SA(1, 1), a1 + hstep, voffA);
            PG8_WAIT_V(8); PG8_WAIT_L(0); PG8_BAR; PG8_MMA(0, 0, At, B0); PG8_MMA(0, 1, At, B1); PG8_BAR; PG8_SCHED;
            PG8_LDA(At, 0, 1); PG8_STAGE(PG8_SB(0, 0), b2, voffB); PG8_STAGE(PG8_SB(0, 1), b2 + hstep, voffB); PG8_STAGE(PG8_SA(0, 0), a2, voffA);
            PG8_WAIT_V(8); PG8_WAIT_L(0); PG8_BAR; PG8_MMA(1, 0, At, B0); PG8_MMA(1, 1, At, B1); PG8_BAR; PG8_SCHED;
            PG8_LDB(B0, 1, 0); PG8_LDB(B1, 1, 1); PG8_SCHED; PG8_LDA(At, 1, 0); PG8_STAGE(PG8_SA(0, 1), a2 + hstep, voffA);
            PG8_WAIT_V(8); PG8_WAIT_L(0); PG8_BAR; PG8_MMA(0, 0, At, B0); PG8_MMA(0, 1, At, B1); PG8_BAR; PG8_SCHED;
            PG8_LDA(At, 1, 1); PG8_STAGE(PG8_SB(1, 0), b3, voffB); PG8_STAGE(PG8_SB(1, 1), b3 + hstep, voffB); PG8_STAGE(PG8_SA(1, 0), a3, voffA);
            PG8_WAIT_V(8); PG8_WAIT_L(0); PG8_BAR; PG8_MMA(1, 0, At, B0); PG8_MMA(1, 1, At, B1); PG8_BAR; PG8_SCHED;
            } else {
            PG8_LDB(B0, 0, 0); PG8_SCHED; PG8_LDA(At, 0, 0); PG8_STAGE(PG8_SA(1, 1), a1 + hstep, voffA);
            PG8_WAIT_L(8); PG8_BAR; PG8_WAIT_L(0); PG8_MMA(0, 0, At, B0); PG8_BAR; PG8_SCHED;
            PG8_LDB(B1, 0, 1); PG8_STAGE(PG8_SB(0, 0), b2, voffB);
            PG8_BAR; PG8_WAIT_L(0); PG8_MMA(0, 1, At, B1); PG8_BAR;
            PG8_LDA(At, 0, 1); PG8_STAGE(PG8_SA(0, 0), a2, voffA);
            PG8_BAR; PG8_WAIT_L(0); PG8_MMA(1, 0, At, B0); PG8_BAR; PG8_SCHED;
            PG8_STAGE(PG8_SB(0, 1), b2 + hstep, voffB);
            PG8_WAIT_V(6); PG8_BAR; PG8_MMA(1, 1, At, B1); PG8_BAR;
            PG8_LDB(B0, 1, 0); PG8_SCHED; PG8_LDA(At, 1, 0); PG8_STAGE(PG8_SA(0, 1), a2 + hstep, voffA);
            PG8_WAIT_L(8); PG8_BAR; PG8_WAIT_L(0); PG8_MMA(0, 0, At, B0); PG8_BAR; PG8_SCHED;
            PG8_LDB(B1, 1, 1); PG8_STAGE(PG8_SB(1, 0), b3, voffB);
            PG8_BAR; PG8_WAIT_L(0); PG8_MMA(0, 1, At, B1); PG8_BAR;
            PG8_LDA(At, 1, 1); PG8_STAGE(PG8_SA(1, 0), a3, voffA);
            PG8_BAR; PG8_WAIT_L(0); PG8_MMA(1, 0, At, B0); PG8_BAR; PG8_SCHED;
            PG8_STAGE(PG8_SB(1, 1), b3 + hstep, voffB);
            PG8_WAIT_V(6); PG8_BAR; PG8_MMA(1, 1, At, B1); PG8_BAR;
            }
        }
        if constexpr (ALIGN_EPI) { if (wr == 0) PG8_BAR; }
        if constexpr (!Epi::AFTER_DRAIN) { E(acc, cur, wr, wc, fr, fq, ui, lds); S.done(cur); }
        if (!has_next) break;
#pragma unroll
        for (int a = 0; a < 2; ++a)
#pragma unroll
            for (int b = 0; b < 2; ++b)
#pragma unroll
                for (int m = 0; m < 4; ++m)
#pragma unroll
                    for (int n = 0; n < 2; ++n) acc[a][b][m][n] = (f32x4){0.f, 0.f, 0.f, 0.f};
        cur = nxt; cA = nA; cB = nB; ++ui;
        if constexpr (ALIGN_EPI) { if (wr == 1) PG8_BAR; }
    }
    PG8_WAIT_V(0);
    if constexpr (!ALIGN_EPI) { if (wr == 0) PG8_BAR; }
    PG8_BAR;
    if constexpr (Epi::AFTER_DRAIN) { E.fused(acc, cur, wr, wc, fr, fq, lds, wid, lane); S.done(cur); }
#undef PG8_SA
#undef PG8_SB
#undef PG8_STAGE
#undef PG8_LDA
#undef PG8_LDB
#undef PG8_MMA
#undef PG8_WAIT_V
#undef PG8_WAIT_L
#undef PG8_BAR
#undef PG8_SCHED
}
}

typedef unsigned short bf16;
typedef unsigned v4u __attribute__((ext_vector_type(4)));
typedef unsigned v2u __attribute__((ext_vector_type(2)));
typedef float f32x4 __attribute__((ext_vector_type(4)));
constexpr int DM = 4096, NB = 4, SEQ = 2048, M = NB * SEQ, DEPTH = 4;
constexpr int WA = 1024, WB = 2048, WC = 1024, DMIX = 4096, HD = 64, NQH = 32, KVG = 8, NKV = 4;
constexpr int INW = 10752;
constexpr int LDK = 4096 + 64;
constexpr int OFF_AB = 0, OFF_AC = 1024, OFF_AX = 2048, OFF_AG = 3072, OFF_Q = 4096, OFF_K = 6144, OFF_V = 6400, OFF_BG = 6656, OFF_CX = 8704, OFF_CG = 9728;
constexpr int MIX_C = 0, MIX_B = 1024, MIX_A = 3072;
constexpr size_t CTL_SS = 65536;
constexpr size_t CTL_BYTES = 3u << 20, CTL_GR = 2u << 20;
constexpr size_t WS_WG = 8u << 20;
constexpr size_t CTL_GV = CTL_SS + (size_t)DEPTH * 2 * M * 8, CTL_BV = CTL_GV + (size_t)DEPTH * INW * 8, CTL_ST = CTL_BV + (size_t)DEPTH * INW * 8;
static_assert(CTL_ST + (size_t)DEPTH * M * 2 * 8 <= CTL_GR, "CTL map");
typedef unsigned long long fx_t;
constexpr size_t CTL_RF = 8192;
constexpr size_t CTL_Q = 4096;
constexpr float ALPHA = 1.6817928305074290861f;
constexpr float LN_EPS = 1e-5f, RMS_EPS = 1e-6f;
constexpr size_t MiB = 1u << 20;
constexpr size_t WS_CTL = 0, WS_WIN = 16 * MiB, WS_WOUT = 360 * MiB, WS_XB = 492 * MiB, WS_H = 558 * MiB, WS_MIX = 726 * MiB, WS_Y = 792 * MiB, WS_END = 920 * MiB;
constexpr size_t WIN_L = (size_t)INW * LDK, WOUT_L = (size_t)DM * LDK;

__device__ __forceinline__ unsigned f2bf(float f) { unsigned u = __builtin_bit_cast(unsigned, f); return (u + 0x7fffu + ((u >> 16) & 1u)) >> 16; }
__device__ __forceinline__ unsigned pk2(float lo, float hi) { return f2bf(lo) | (f2bf(hi) << 16); }
__device__ __forceinline__ float bf2f(unsigned short b) { return __builtin_bit_cast(float, (unsigned)b << 16); }
__device__ __forceinline__ float bflo(unsigned w) { return __builtin_bit_cast(float, w << 16); }
__device__ __forceinline__ float bfhi(unsigned w) { return __builtin_bit_cast(float, w & 0xffff0000u); }
__device__ __forceinline__ float wave_sum(float v) {
#pragma unroll
    for (int o = 1; o < 64; o <<= 1) v += __shfl_xor(v, o);
    return v;
}
__device__ __forceinline__ float wave_max(float v) {
#pragma unroll
    for (int o = 1; o < 64; o <<= 1) v = fmaxf(v, __shfl_xor(v, o));
    return v;
}
__device__ __forceinline__ float silu(float x) { return x * __builtin_amdgcn_rcpf(1.f + __builtin_amdgcn_exp2f(x * -1.44269504088896341f)); }
__device__ __forceinline__ float sigmoidf(float x) { return 1.f / (1.f + __expf(-x)); }
#define LDS_WAIT() asm volatile("s_waitcnt lgkmcnt(0)" ::: "memory")

static_assert(WS_WIN + DEPTH * WIN_L * 2 <= WS_WOUT && WS_WOUT + DEPTH * WOUT_L * 2 <= WS_XB && WS_XB + (size_t)M * LDK * 2 <= WS_H && WS_H + (size_t)M * INW * 2 <= WS_MIX && WS_MIX + (size_t)M * LDK * 2 <= WS_Y && WS_Y + (size_t)M * DM * 4 <= WS_END, "workspace map");
#define XB_TMO      128
#define XB_XCNT(j)  (256  + 64 * (j))
#define XB_XSUB(j)  (1280 + 64 * (j))
#define XB_XGEN(j)  (2304 + 64 * (j))
#define XB_TOP      3328
#define XB_TOPGEN   3392
#define XCD_BAR_WORDS 3456
#define XB_SPIN_CAP (1u << 18)
#define LAS __attribute__((address_space(3)))

__device__ __forceinline__ unsigned xb_ld(unsigned* p)              { return __hip_atomic_load(p, __ATOMIC_RELAXED, __HIP_MEMORY_SCOPE_AGENT); }
__device__ __forceinline__ unsigned xb_add(unsigned* p, unsigned v) { return __hip_atomic_fetch_add(p, v, __ATOMIC_RELAXED, __HIP_MEMORY_SCOPE_AGENT); }
__device__ __forceinline__ unsigned xb_xcc_id() { return (unsigned)__builtin_amdgcn_s_getreg((3 << 11) | 20) & 0xFu; }
#define XB_SPIN(cond, bar) do { unsigned _sp = 0; while (cond) { __builtin_amdgcn_s_sleep(1); \
    if ((++_sp & 255u) == 0u) { if (xb_ld(&(bar)[XB_TMO])) break; if (_sp > XB_SPIN_CAP) { atomicAdd(&(bar)[XB_TMO], 1u); break; } } } } while (0)

struct XcdBarrier {
    unsigned* bar; unsigned x;
    volatile LAS unsigned* st;
};

__device__ __forceinline__ XcdBarrier xcd_barrier_post(unsigned* bar, volatile LAS unsigned* st) {
    XcdBarrier b; b.bar = bar; b.x = xb_xcc_id(); b.st = st;
    if (threadIdx.x == 0) (void)xb_add(&bar[XB_XCNT(b.x)], 1u);
    return b;
}
__device__ __forceinline__ void xcd_barrier_complete(unsigned* bar, unsigned x, unsigned& nloc, unsigned& nx) {
    const unsigned G = gridDim.x * gridDim.y * gridDim.z;
    unsigned sum, cnt, mine, sp = 0u;
    for (;;) {
        sum = 0u; cnt = 0u; mine = 0u;
#pragma unroll
        for (unsigned j = 0; j < 16; ++j) { const unsigned c = xb_ld(&bar[XB_XCNT(j)]); sum += c; cnt += (c > 0u) ? 1u : 0u; mine = (j == x) ? c : mine; }
        if (sum == G) break;
        __builtin_amdgcn_s_sleep(1);
        if ((++sp & 255u) == 0u) { if (xb_ld(&bar[XB_TMO])) break; if (sp > XB_SPIN_CAP) { atomicAdd(&bar[XB_TMO], 1u); break; } }
    }
    nloc = mine > 0u ? mine : 1u; nx = cnt > 0u ? cnt : 1u;
}

__device__ __forceinline__ void xcd_barrier(const XcdBarrier& b) {
    asm volatile("s_waitcnt vmcnt(0)" ::: "memory");
    __syncthreads();
    if (threadIdx.x == 0) {
        unsigned* bar = b.bar;
        __builtin_amdgcn_s_waitcnt(0);
        unsigned nloc = b.st[0], nx = b.st[1];
        if (nloc == 0u) { xcd_barrier_complete(bar, b.x, nloc, nx); b.st[0] = nloc; b.st[1] = nx; }
        const unsigned old = xb_add(&bar[XB_XSUB(b.x)], 1u);
        const unsigned gen = old / nloc;
        if (old + 1u == (gen + 1u) * nloc) {
            __builtin_amdgcn_fence(__ATOMIC_RELEASE, "agent");
            asm volatile("s_waitcnt vmcnt(0)" ::: "memory");
            const unsigned og = xb_add(&bar[XB_TOP], 1u);
            const unsigned tg = og / nx;
            if (og + 1u == (tg + 1u) * nx) xb_add(&bar[XB_TOPGEN], 1u);
            else XB_SPIN(xb_ld(&bar[XB_TOPGEN]) == tg, bar);
            __builtin_amdgcn_fence(__ATOMIC_ACQUIRE, "agent");
            xb_add(&bar[XB_XGEN(b.x)], 1u);
            asm volatile("s_waitcnt vmcnt(0)" ::: "memory");
        } else {
            XB_SPIN(xb_ld(&bar[XB_XGEN(b.x)]) == gen, bar);
            __builtin_amdgcn_fence(__ATOMIC_ACQUIRE, "agent");
            asm volatile("s_waitcnt vmcnt(0)" ::: "memory");
        }
    }
    __syncthreads();
}
constexpr int NWAVES = 8, NTHR = 512;
constexpr int LDS_MISC = 131072 + 320, LDS_BYTES = 163840;
#define VM_WAIT() asm volatile("s_waitcnt vmcnt(0)" ::: "memory")

template <bool KPERM, bool GFOLD> __device__ __forceinline__ void convert_task(const float* __restrict__ W, bf16* __restrict__ WT, int ldt, int N, LAS float* scr, int nb, int kb0, int nkb, int lane,
                                                                               const float* __restrict__ gvec, const float* __restrict__ bvec, fx_t* __restrict__ Gout, fx_t* __restrict__ Bout) {
    const int n0 = 64 * nb, c = lane & 7, nr = lane >> 3;
    const __amdgpu_buffer_rsrc_t rsW = __builtin_amdgcn_make_buffer_rsrc((void*)W, (short)0, 0x7ffffff0, 0x00020000);
    float gacc[8], bacc[8];
#pragma unroll
    for (int j = 0; j < 8; ++j) { gacc[j] = 0.f; bacc[j] = 0.f; }
    for (int kb = kb0; kb < kb0 + nkb; ++kb) {
        const int k0 = 64 * kb;
        const int ks = KPERM ? (k0 < 1024 ? k0 + 3072 : (k0 < 3072 ? k0 : k0 - 3072)) : k0;
        const int kr = lane >> 4, cq = lane & 15;
        const int voff = (kr * N + 4 * cq) * 4;
        f32x4 r[16];
#pragma unroll
        for (int i = 0; i < 16; ++i) r[i] = __builtin_bit_cast(f32x4, __builtin_amdgcn_raw_buffer_load_b128(rsW, voff, ((ks + 4 * i) * N + n0) * 4, 2));
#pragma unroll
        for (int i = 0; i < 16; ++i) { const int row = 4 * i + kr; *(LAS f32x4*)(scr + row * 64 + ((4 * cq) ^ (8 * (row >> 3)))) = r[i]; }
        LDS_WAIT();
        float gk[8], bk[8];
        if (GFOLD) { const f32x4 g0 = *(const f32x4*)(gvec + k0 + 8 * c), g1 = *(const f32x4*)(gvec + k0 + 8 * c + 4), b0 = *(const f32x4*)(bvec + k0 + 8 * c), b1 = *(const f32x4*)(bvec + k0 + 8 * c + 4);
#pragma unroll
            for (int e = 0; e < 4; ++e) { gk[e] = g0[e]; gk[4 + e] = g1[e]; bk[e] = b0[e]; bk[4 + e] = b1[e]; } }
#pragma unroll
        for (int j = 0; j < 8; ++j) { const int n = nr + 8 * j; const LAS float* s = scr + (8 * c) * 64 + (n ^ (8 * c));
            float v[8];
#pragma unroll
            for (int e = 0; e < 8; ++e) { v[e] = s[e * 64]; if (GFOLD) { bacc[j] += bk[e] * v[e]; v[e] *= gk[e]; } }
            v4u o; o.x = pk2(v[0], v[1]); o.y = pk2(v[2], v[3]); o.z = pk2(v[4], v[5]); o.w = pk2(v[6], v[7]);
            *(v4u*)(WT + (size_t)(n0 + n) * ldt + k0 + 8 * c) = o;
            if (GFOLD) gacc[j] += ((bflo(o.x) + bfhi(o.x)) + (bflo(o.y) + bfhi(o.y))) + ((bflo(o.z) + bfhi(o.z)) + (bflo(o.w) + bfhi(o.w))); }
        LDS_WAIT();
    }
    if (GFOLD) {
#pragma unroll
        for (int j = 0; j < 8; ++j) { float gp = gacc[j], bp = bacc[j];
            gp += __shfl_xor(gp, 1); gp += __shfl_xor(gp, 2); gp += __shfl_xor(gp, 4); bp += __shfl_xor(bp, 1); bp += __shfl_xor(bp, 2); bp += __shfl_xor(bp, 4);
            if (c == 0) { pg8::fx_add(Gout + n0 + nr + 8 * j, gp); pg8::fx_add(Bout + n0 + nr + 8 * j, bp); } } }
}
constexpr int CV_NK = 2, CV_KQ = DM / 64 / CV_NK, CV_T_IN = (INW / 64) * CV_KQ, CV_T_OUT = (DM / 64) * CV_KQ, CV_T_L = CV_T_IN + CV_T_OUT;
__device__ __forceinline__ void convert_layer(const float* __restrict__ w_in, const float* __restrict__ w_out, const float* __restrict__ ln_g, const float* __restrict__ ln_b, unsigned char* ws, int ll, LAS float* scr, int wv, int nwv, int lane) {
    for (int r = wv; r < CV_T_L; r += nwv) {
        if (r < CV_T_IN) { const int kq = r % CV_KQ, nb = r / CV_KQ;
            if (ll == 0) convert_task<false, false>(w_in, (bf16*)(ws + WS_WIN), LDK, INW, scr, nb, kq * CV_NK, CV_NK, lane, nullptr, nullptr, nullptr, nullptr);
            else convert_task<false, true>(w_in + (size_t)ll * DM * INW, (bf16*)(ws + WS_WIN) + (size_t)ll * WIN_L, LDK, INW, scr, nb, kq * CV_NK, CV_NK, lane, ln_g + (size_t)(ll - 1) * DM, ln_b + (size_t)(ll - 1) * DM,
                                                (fx_t*)(ws + WS_CTL + CTL_GV) + (size_t)ll * INW, (fx_t*)(ws + WS_CTL + CTL_BV) + (size_t)ll * INW); }
        else { const int r2 = r - CV_T_IN, kq = r2 % CV_KQ, nb = r2 / CV_KQ;
            convert_task<true, false>(w_out + (size_t)ll * DMIX * DM, (bf16*)(ws + WS_WOUT) + (size_t)ll * WOUT_L, LDK, DM, scr, nb, kq * CV_NK, CV_NK, lane, nullptr, nullptr, nullptr, nullptr); }
    }
}

__device__ __forceinline__ void branch_a_pair(const bf16* __restrict__ h, const float* __restrict__ cw, const float* __restrict__ nrm, bf16* __restrict__ mix, int t0, int lane) {
    const int s0 = t0 % SEQ;
    const bf16* hr = h + (size_t)t0 * INW;
    float y[2][16], ss[2] = {0.f, 0.f}; v4u agk[2][2];
#pragma unroll
    for (int j = 0; j < 2; ++j) {
        const int ch0 = j * 512 + lane * 8;
        v4u cr[4], xr[4], ab[2];
#pragma unroll
        for (int i = 0; i < 4; ++i) { cr[i] = (v4u){0u, 0u, 0u, 0u}; xr[i] = (v4u){0u, 0u, 0u, 0u};
            if (i >= 2 || s0 > 0) { cr[i] = *(const v4u*)(hr + (long)(i - 2) * INW + OFF_AC + ch0); xr[i] = *(const v4u*)(hr + (long)(i - 2) * INW + OFF_AX + ch0); } }
#pragma unroll
        for (int i = 0; i < 2; ++i) { ab[i] = *(const v4u*)(hr + (size_t)i * INW + OFF_AB + ch0); agk[i][j] = *(const v4u*)(hr + (size_t)i * INW + OFF_AG + ch0); }
        float w0[8], w1[8], w2[8];
        { const f32x4 a0 = *(const f32x4*)(cw + ch0), a1 = *(const f32x4*)(cw + ch0 + 4), b0 = *(const f32x4*)(cw + 1024 + ch0), b1 = *(const f32x4*)(cw + 1024 + ch0 + 4),
                      c0 = *(const f32x4*)(cw + 2048 + ch0), c1 = *(const f32x4*)(cw + 2048 + ch0 + 4);
#pragma unroll
          for (int e = 0; e < 4; ++e) { w0[e] = a0[e]; w0[4 + e] = a1[e]; w1[e] = b0[e]; w1[4 + e] = b1[e]; w2[e] = c0[e]; w2[4 + e] = c1[e]; } }
        float p[4][8];
#pragma unroll
        for (int i = 0; i < 4; ++i)
#pragma unroll
            for (int e = 0; e < 8; ++e) { const int w = e >> 1; p[i][e] = (e & 1) ? bfhi(cr[i][w]) * bfhi(xr[i][w]) : bflo(cr[i][w]) * bflo(xr[i][w]); }
#pragma unroll
        for (int i = 0; i < 2; ++i)
#pragma unroll
            for (int e = 0; e < 8; ++e) { const int w = e >> 1;
                const float cv = w0[e] * p[i][e] + w1[e] * p[i + 1][e] + w2[e] * p[i + 2][e];
                const float yv = ((e & 1) ? bfhi(ab[i][w]) : bflo(ab[i][w])) * cv; y[i][j * 8 + e] = yv; ss[i] += yv * yv; }
    }
#pragma unroll
    for (int i = 0; i < 2; ++i) { const float rstd = rsqrtf(wave_sum(ss[i]) * (1.f / WA) + RMS_EPS);
#pragma unroll
        for (int j = 0; j < 2; ++j) { const int ch0 = j * 512 + lane * 8; const f32x4 n0 = *(const f32x4*)(nrm + ch0), n1 = *(const f32x4*)(nrm + ch0 + 4); const v4u ag = agk[i][j]; float ov[8];
#pragma unroll
            for (int e = 0; e < 8; ++e) { const int w = e >> 1; ov[e] = y[i][j * 8 + e] * rstd * ((e < 4) ? n0[e & 3] : n1[e & 3]) * silu((e & 1) ? bfhi(ag[w]) : bflo(ag[w])); }
            v4u o; o.x = pk2(ov[0], ov[1]); o.y = pk2(ov[2], ov[3]); o.z = pk2(ov[4], ov[5]); o.w = pk2(ov[6], ov[7]);
            *(v4u*)(mix + (size_t)(t0 + i) * LDK + MIX_A + ch0) = o; } }
}
typedef short s16x8 __attribute__((ext_vector_type(8)));
typedef float f32x16 __attribute__((ext_vector_type(16)));
typedef __bf16 bf16x2_t __attribute__((ext_vector_type(2)));
typedef float f32x2_t __attribute__((ext_vector_type(2)));
__device__ __forceinline__ unsigned cvtpk(float lo, float hi) { const f32x2_t v = {lo, hi}; return __builtin_bit_cast(unsigned, __builtin_convertvector(v, bf16x2_t)); }
constexpr int ATT_KROW = 144, ATT_VROW = 520, ATT_K_OFF = 0, ATT_V_OFF = 256 * ATT_KROW;
__device__ __forceinline__ void attn_unit(const bf16* __restrict__ h, const float* __restrict__ sinks, const float* __restrict__ nrm, bf16* __restrict__ mix, fx_t* __restrict__ ssb, LAS unsigned char* lds, int task, const int tid) {
    const int n = task & 15, kvh = (task >> 4) & 3, b = task >> 6;
    const int lane = tid & 63, wave = tid >> 6;
    for (int pc = tid; pc < 2048; pc += NTHR) {
        const int j = pc >> 3, q = pc & 7, pos = 128 * n - 128 + j;
        v4u kv = {0u, 0u, 0u, 0u}, vv = {0u, 0u, 0u, 0u};
        if (pos >= 0) { const bf16* row = h + (size_t)(b * SEQ + pos) * INW; kv = *(const v4u*)(row + OFF_K + kvh * 64 + 8 * q); vv = *(const v4u*)(row + OFF_V + kvh * 64 + 8 * q); }
        *(LAS v4u*)(lds + ATT_K_OFF + j * ATT_KROW + 16 * q) = kv;
        LAS unsigned short* vt = (LAS unsigned short*)(lds + ATT_V_OFF) + (8 * q) * (ATT_VROW / 2) + j;
#pragma unroll
        for (int e = 0; e < 8; ++e) vt[e * (ATT_VROW / 2)] = (unsigned short)((e & 1) ? (vv[e >> 1] >> 16) : (vv[e >> 1] & 0xffffu));
    }
    __syncthreads();
    const int hq = kvh * 8 + wave; const float sink = sinks[hq];
    const int r = lane & 31, hh = lane >> 5; const bool first_blk = (n == 0);
    constexpr float LOG2E = 1.44269504088896341f, SC = 0.125f * LOG2E;
    const size_t tq0 = (size_t)b * SEQ + 128 * n + r;
    s16x8 qf[4];
    { const bf16* hrow = h + tq0 * INW;
#pragma unroll
      for (int s = 0; s < 4; ++s) qf[s] = *(const s16x8*)(hrow + OFF_Q + hq * 64 + 8 * hh + 16 * s); }
#pragma unroll 1
    for (int qs = 0; qs < 4; ++qs) {
        const size_t t = tq0 + 32 * qs;
        s16x8 qn[4]; v2u gw[2][4];
        { const bf16* hrow = h + (t + (qs < 3 ? 32 : 0)) * INW;
#pragma unroll
          for (int s = 0; s < 4; ++s) qn[s] = *(const s16x8*)(hrow + OFF_Q + hq * 64 + 8 * hh + 16 * s);
          const bf16* grow = h + t * INW;
#pragma unroll
          for (int dt = 0; dt < 2; ++dt)
#pragma unroll
              for (int g = 0; g < 4; ++g) gw[dt][g] = *(const v2u*)(grow + OFF_BG + hq * 64 + 32 * dt + 8 * g + 4 * hh); }
        f32x16 sc[5];
#pragma unroll
        for (int ci = 0; ci < 5; ++ci) {
            const LAS unsigned char* kp = lds + ATT_K_OFF + (32 * (qs + ci) + r) * ATT_KROW + 16 * hh;
            f32x16 acc;
#pragma unroll
            for (int i = 0; i < 16; ++i) acc[i] = 0.f;
#pragma unroll
            for (int s = 0; s < 4; ++s) { const s16x8 kf = *(const LAS s16x8*)(kp + 32 * s); acc = __builtin_amdgcn_mfma_f32_32x32x16_bf16(kf, qf[s], acc, 0, 0, 0); }
            sc[ci] = acc;
        }
        float mx = -1e30f;
#pragma unroll
        for (int ci = 0; ci < 5; ++ci)
#pragma unroll
            for (int i = 0; i < 16; ++i) { const int kk = (i & 3) + 8 * (i >> 2) + 4 * hh;
                const bool valid = ((ci == 0) ? (kk > r) : ((ci == 4) ? (kk <= r) : true)) && !(first_blk && qs + ci < 4);
                const float v = valid ? sc[ci][i] : -1e30f; sc[ci][i] = v; mx = fmaxf(mx, v); }
        mx = fmaxf(mx, __shfl_xor(mx, 32));
        const float m = fmaxf(mx * 0.125f, sink), mb = m * LOG2E;
        float sum = 0.f;
#pragma unroll
        for (int ci = 0; ci < 5; ++ci)
#pragma unroll
            for (int i = 0; i < 16; ++i) { const float p = __builtin_amdgcn_exp2f(sc[ci][i] * SC - mb); sc[ci][i] = p; sum += p; }
        sum += __shfl_xor(sum, 32);
        const float inv = 1.f / (sum + __builtin_amdgcn_exp2f((sink - m) * LOG2E));
        f32x16 o[2];
#pragma unroll
        for (int i = 0; i < 16; ++i) { o[0][i] = 0.f; o[1][i] = 0.f; }
#pragma unroll
        for (int ci = 0; ci < 5; ++ci)
#pragma unroll
            for (int s2 = 0; s2 < 2; ++s2) {
                v4u pw; pw.x = cvtpk(sc[ci][8 * s2 + 0], sc[ci][8 * s2 + 1]); pw.y = cvtpk(sc[ci][8 * s2 + 2], sc[ci][8 * s2 + 3]); pw.z = cvtpk(sc[ci][8 * s2 + 4], sc[ci][8 * s2 + 5]); pw.w = cvtpk(sc[ci][8 * s2 + 6], sc[ci][8 * s2 + 7]);
                const s16x8 pf = __builtin_bit_cast(s16x8, pw);
                const int key0 = 32 * (qs + ci) + 16 * s2 + 4 * hh;
#pragma unroll
                for (int dt = 0; dt < 2; ++dt) { const LAS unsigned char* vp = lds + ATT_V_OFF + (32 * dt + r) * ATT_VROW + 2 * key0;
                    const v2u lo = *(const LAS v2u*)vp, hi = *(const LAS v2u*)(vp + 16);
                    v4u vw; vw.x = lo.x; vw.y = lo.y; vw.z = hi.x; vw.w = hi.y;
                    o[dt] = __builtin_amdgcn_mfma_f32_32x32x16_bf16(__builtin_bit_cast(s16x8, vw), pf, o[dt], 0, 0, 0); }
            }
        float ssq = 0.f;
#pragma unroll
        for (int dt = 0; dt < 2; ++dt)
#pragma unroll
            for (int i = 0; i < 16; ++i) { const float y = o[dt][i] * inv; o[dt][i] = y; ssq += y * y; }
        ssq += __shfl_xor(ssq, 32);
        if (hh == 0) pg8::fx_add(ssb + t, ssq);
#pragma unroll
        for (int dt = 0; dt < 2; ++dt)
#pragma unroll
            for (int g = 0; g < 4; ++g) { const int cc = hq * 64 + 32 * dt + 8 * g + 4 * hh;
                const v2u gwv = gw[dt][g]; const f32x4 nv = *(const f32x4*)(nrm + cc);
                v2u ov; ov.x = cvtpk(o[dt][4 * g + 0] * nv[0] * silu(bflo(gwv.x)), o[dt][4 * g + 1] * nv[1] * silu(bfhi(gwv.x)));
                ov.y = cvtpk(o[dt][4 * g + 2] * nv[2] * silu(bflo(gwv.y)), o[dt][4 * g + 3] * nv[3] * silu(bfhi(gwv.y)));
                *(v2u*)(mix + t * LDK + MIX_B + cc) = ov; }
#pragma unroll
        for (int s = 0; s < 4; ++s) qf[s] = qn[s];
    }
    __syncthreads();
}
constexpr int RG_TOK = 128, RG_ROW = 272, RG_HP_OFF = RG_TOK * RG_ROW, RG_HP_ROW = 576, RG_CARRY_OFF = RG_HP_OFF + RG_TOK * RG_HP_ROW;
__device__ __forceinline__ void rg_unit(const bf16* __restrict__ h, const float* __restrict__ ccw, const float* __restrict__ ccb, const bf16* __restrict__ wg, const float* __restrict__ br, const float* __restrict__ bi,
                                        const float* __restrict__ lam, const float* __restrict__ nrm, bf16* __restrict__ mix, fx_t* __restrict__ ssc, unsigned long long* gran, unsigned* tmo, const unsigned epoch,
                                        LAS unsigned char* lds, const int c, const int hd, const int b, const int tid) {
    const int lane = tid & 63, wave = tid >> 6;
    const size_t T0 = (size_t)b * SEQ + RG_TOK * c;
    constexpr float LOG2E = 1.44269504088896341f;
    const int l15 = lane & 15, lg = lane >> 4, chl = 16 * wave + l15, ch = hd * 128 + chl;
    s16x8 Br[4], Bi[4];
    { const bf16* wrp = wg + ((size_t)hd * 128 + chl) * 128 + 8 * lg; const bf16* wip = wrp + (size_t)8 * 128 * 128;
#pragma unroll
      for (int s = 0; s < 4; ++s) { Br[s] = *(const s16x8*)(wrp + 32 * s); Bi[s] = *(const s16x8*)(wip + 32 * s); } }
    const float brv = br[ch] * LOG2E, biv = bi[ch] * LOG2E, L2 = -8.f * log1pf(expf(-lam[ch])) * LOG2E;
    {
        const int g = tid & 15, tr = tid >> 4, ch = hd * 128 + 8 * g;
        float w[4][8], bs[8];
#pragma unroll
        for (int k = 0; k < 4; ++k) { const f32x4 a = *(const f32x4*)(ccw + k * 1024 + ch), q = *(const f32x4*)(ccw + k * 1024 + ch + 4);
#pragma unroll
            for (int e = 0; e < 4; ++e) { w[k][e] = a[e]; w[k][4 + e] = q[e]; } }
        { const f32x4 a = *(const f32x4*)(ccb + ch), q = *(const f32x4*)(ccb + ch + 4);
#pragma unroll
          for (int e = 0; e < 4; ++e) { bs[e] = a[e]; bs[4 + e] = q[e]; } }
        v4u rows[7];
#pragma unroll
        for (int i = 0; i < 7; ++i) { const int trow = 4 * tr - 3 + i; const bool ok = (c > 0) || (trow >= 0);
            v4u z = {0u, 0u, 0u, 0u}; if (ok) z = *(const v4u*)(h + (size_t)((long)T0 + trow) * INW + OFF_CX + ch); rows[i] = z; }
#pragma unroll
        for (int i = 0; i < 4; ++i) { float o[8];
#pragma unroll
            for (int e = 0; e < 8; ++e) { float acc = bs[e];
#pragma unroll
                for (int k = 0; k < 4; ++k) { const unsigned wd = rows[i + k][e >> 1]; acc += w[k][e] * ((e & 1) ? bfhi(wd) : bflo(wd)); }
                o[e] = acc; }
            v4u ov; ov.x = cvtpk(o[0], o[1]); ov.y = cvtpk(o[2], o[3]); ov.z = cvtpk(o[4], o[5]); ov.w = cvtpk(o[6], o[7]);
            *(LAS v4u*)(lds + (4 * tr + i) * RG_ROW + 16 * g) = ov; }
    }
    __syncthreads();
    float Prun = 1.f, Hrun = 0.f;
    {
#pragma unroll 2
        for (int tt = 0; tt < RG_TOK / 16; ++tt) {
            const LAS unsigned char* ap = lds + (16 * tt + l15) * RG_ROW + 16 * lg;
            pg8::f32x4 ar = {0.f, 0.f, 0.f, 0.f}, ai = {0.f, 0.f, 0.f, 0.f};
#pragma unroll
            for (int s = 0; s < 4; ++s) { const s16x8 af = *(const LAS s16x8*)(ap + 64 * s);
                ar = __builtin_amdgcn_mfma_f32_16x16x32_bf16(af, Br[s], ar, 0, 0, 0); ai = __builtin_amdgcn_mfma_f32_16x16x32_bf16(af, Bi[s], ai, 0, 0, 0); }
            float pl[4], hl[4]; float P = 1.f, H = 0.f;
#pragma unroll
            for (int rg = 0; rg < 4; ++rg) { const int trow = 16 * tt + 4 * lg + rg;
                const float xcv = bf2f(*(const LAS unsigned short*)(lds + trow * RG_ROW + 2 * chl));
                const float rr = __builtin_amdgcn_rcpf(1.f + __builtin_amdgcn_exp2f(-(ar[rg] * LOG2E + brv)));
                const float ig = __builtin_amdgcn_rcpf(1.f + __builtin_amdgcn_exp2f(-(ai[rg] * LOG2E + biv)));
                const float a = __builtin_amdgcn_exp2f(rr * L2);
                const float u = __builtin_amdgcn_sqrtf(fmaxf(fmaf(-a, a, 1.f), 0.f)) * (ig * xcv);
                H = a * H + u; P = a * P; pl[rg] = P; hl[rg] = H; }
            float myP = Prun, myH = Hrun, Pst = Prun, Hst = Hrun;
#pragma unroll
            for (int x = 0; x < 4; ++x) { const float Ax = __shfl(P, l15 + 16 * x), Hx = __shfl(H, l15 + 16 * x);
                if (x == lg) { myP = Pst; myH = Hst; }
                Hst = Ax * Hst + Hx; Pst = Ax * Pst; }
            Prun = Pst; Hrun = Hst;
#pragma unroll
            for (int rg = 0; rg < 4; ++rg) *(LAS unsigned*)(lds + RG_HP_OFF + (16 * tt + 4 * lg + rg) * RG_HP_ROW + 4 * chl) = cvtpk(hl[rg] + pl[rg] * myH, pl[rg] * myP);
        }
    }
    unsigned gwv[RG_TOK / 8];
    { const size_t tbq = T0 + wave * (RG_TOK / 8);
#pragma unroll
      for (int i = 0; i < RG_TOK / 8; ++i) gwv[i] = *(const unsigned*)(h + (tbq + i) * INW + OFF_CG + hd * 128 + 2 * lane); }
    if (lg == 0) { unsigned long long* gp = gran + ((((size_t)b * 8 + hd) * 16 + c) * 128 + chl) * 2;
        __hip_atomic_store(gp, ((unsigned long long)epoch << 32) | __builtin_bit_cast(unsigned, Prun), __ATOMIC_RELAXED, __HIP_MEMORY_SCOPE_AGENT);
        __hip_atomic_store(gp + 1, ((unsigned long long)epoch << 32) | __builtin_bit_cast(unsigned, Hrun), __ATOMIC_RELAXED, __HIP_MEMORY_SCOPE_AGENT); }
    if (tid < 128) {
        const unsigned long long* gq = gran + (((size_t)b * 8 + hd) * 16 * 128 + tid) * 2;
        float Av[15], Hv[15]; unsigned spins = 0;
        for (;;) { bool ok = true;
#pragma unroll
            for (int cp = 0; cp < 15; ++cp) { Av[cp] = 1.f; Hv[cp] = 0.f;
                if (cp < c) { const unsigned long long xa = __hip_atomic_load(gq + cp * 256, __ATOMIC_RELAXED, __HIP_MEMORY_SCOPE_AGENT), xh = __hip_atomic_load(gq + cp * 256 + 1, __ATOMIC_RELAXED, __HIP_MEMORY_SCOPE_AGENT);
                    ok = ok && ((unsigned)(xa >> 32) == epoch) && ((unsigned)(xh >> 32) == epoch); Av[cp] = __builtin_bit_cast(float, (unsigned)xa); Hv[cp] = __builtin_bit_cast(float, (unsigned)xh); } }
            if (ok) break;
            if (++spins > 40000u) { __hip_atomic_store(tmo, 1u, __ATOMIC_RELAXED, __HIP_MEMORY_SCOPE_AGENT); break; }
            __builtin_amdgcn_s_sleep(2); }
        float carry = 0.f;
#pragma unroll
        for (int cp = 0; cp < 15; ++cp) if (cp < c) carry = Av[cp] * carry + Hv[cp];
        ((LAS float*)(lds + RG_CARRY_OFF))[tid] = carry;
    }
    __syncthreads();
    {
        const float n0 = nrm[hd * 128 + 2 * lane], n1 = nrm[hd * 128 + 2 * lane + 1];
        const float c0 = ((const LAS float*)(lds + RG_CARRY_OFF))[2 * lane], c1 = ((const LAS float*)(lds + RG_CARRY_OFF))[2 * lane + 1];
        const size_t tb = T0 + wave * (RG_TOK / 8);
        float ssq[RG_TOK / 8];
#pragma unroll
        for (int i = 0; i < RG_TOK / 8; ++i) { const int row = wave * (RG_TOK / 8) + i;
            const v2u hw = *(const LAS v2u*)(lds + RG_HP_OFF + row * RG_HP_ROW + 8 * lane);
            const float y0 = bflo(hw.x) + bfhi(hw.x) * c0, y1 = bflo(hw.y) + bfhi(hw.y) * c1;
            ssq[i] = y0 * y0 + y1 * y1;
            *(unsigned*)(mix + (tb + i) * LDK + MIX_C + hd * 128 + 2 * lane) = cvtpk(y0 * n0 * silu(bflo(gwv[i])), y1 * n1 * silu(bfhi(gwv[i]))); }
#pragma unroll
        for (int st = 0; st < 4; ++st) { const int hm = 8 >> st, bit = 1 << st;
            const bool up = (lane & bit) != 0;
#pragma unroll
            for (int k = 0; k < hm; ++k) { const float mine = up ? ssq[k + hm] : ssq[k], other = up ? ssq[k] : ssq[k + hm]; ssq[k] = mine + __shfl_xor(other, bit); } }
        float tot = ssq[0]; tot += __shfl_xor(tot, 16); tot += __shfl_xor(tot, 32);
        if (lane < 16) { const int row = 8 * (lane & 1) + 4 * ((lane >> 1) & 1) + 2 * ((lane >> 2) & 1) + ((lane >> 3) & 1); pg8::fx_add(ssc + tb + row, tot); }
    }
    __syncthreads();
}
__device__ __forceinline__ void final_ln_token(const bf16* __restrict__ yb, const fx_t* __restrict__ st, const float* __restrict__ g, const float* __restrict__ bta, float* __restrict__ xo, int t, int lane) {
    const float s = pg8::fx_get(st + 2 * (size_t)t), q = pg8::fx_get(st + 2 * (size_t)t + 1);
    const float mean = s * (1.f / DM), rstd = rsqrtf(fmaxf(q * (1.f / DM) - mean * mean, 0.f) + LN_EPS);
#pragma unroll
    for (int j = 0; j < 8; ++j) { const int cc = 8 * (lane + 64 * j);
        const v4u hw = *(const v4u*)(yb + (size_t)t * LDK + cc);
        const f32x4 g0 = *(const f32x4*)(g + cc), g1 = *(const f32x4*)(g + cc + 4), b0 = *(const f32x4*)(bta + cc), b1 = *(const f32x4*)(bta + cc + 4);
        f32x4 o0, o1;
        o0[0] = (bflo(hw[0]) - mean) * rstd * g0[0] + b0[0]; o0[1] = (bfhi(hw[0]) - mean) * rstd * g0[1] + b0[1];
        o0[2] = (bflo(hw[1]) - mean) * rstd * g0[2] + b0[2]; o0[3] = (bfhi(hw[1]) - mean) * rstd * g0[3] + b0[3];
        o1[0] = (bflo(hw[2]) - mean) * rstd * g1[0] + b1[0]; o1[1] = (bfhi(hw[2]) - mean) * rstd * g1[1] + b1[1];
        o1[2] = (bflo(hw[3]) - mean) * rstd * g1[2] + b1[2]; o1[3] = (bfhi(hw[3]) - mean) * rstd * g1[3] + b1[3];
        __builtin_nontemporal_store(o0, (f32x4*)(xo + (size_t)t * DM + cc)); __builtin_nontemporal_store(o1, (f32x4*)(xo + (size_t)t * DM + cc + 4)); }
}

struct Args { const float* in[17]; float* out; unsigned char* ws; };
#define KA_AS __attribute__((address_space(4)))
#define AIN(k) (*(const float* const KA_AS*)(ka_ + 8 * (k)))
#define AOUT (*(float* const KA_AS*)(ka_ + 8 * 17))
#define AWS (*(unsigned char* const KA_AS*)(ka_ + 8 * 18))
#define TZ_INIT() const KA_AS unsigned char* ka_ = (const KA_AS unsigned char*)__builtin_amdgcn_kernarg_segment_ptr(); asm volatile("" : "+s"(ka_)); int lz = l_; asm volatile("" : "+s"(lz)); const int l = lz; (void)l; int tz = threadIdx.x; asm volatile("" : "+v"(tz)); const int tid = tz, lane = tz & 63, wave = __builtin_amdgcn_readfirstlane(tz >> 6); const int G = gridDim.x, gw = blockIdx.x * NWAVES + wave, NGW = G * NWAVES; (void)tid; (void)lane; (void)gw; (void)NGW
__global__ void __launch_bounds__(NTHR, 2) fwd(Args args) {
    extern __shared__ __attribute__((aligned(16))) unsigned char lds_raw[];
    LAS unsigned char* lds = (LAS unsigned char*)lds_raw;
    volatile LAS unsigned* MISC = (volatile LAS unsigned*)(lds + LDS_MISC);
    for (int u = threadIdx.x; u < (LDS_BYTES - 131072) / 4; u += NTHR) ((LAS unsigned*)(lds + 131072))[u] = 0u;
    __syncthreads();
    (void)xcd_barrier_post((unsigned*)(args.ws + WS_CTL) + 4096, MISC + 8);
#define GRID_BARRIER() do { XcdBarrier b_; b_.bar = (unsigned*)(args.ws + WS_CTL) + 4096; b_.x = xb_xcc_id(); b_.st = (volatile LAS unsigned*)(lds + LDS_MISC) + 8; xcd_barrier(b_); } while (0)
#define WSP(T, off) ((T*)(AWS + (off)))

    {
        const int l_ = 0; TZ_INIT();
        LAS float* scr = (LAS float*)(lds + wave * 16384);
        for (int ll = 0; ll < DEPTH; ++ll) convert_layer(AIN(1), AIN(14), AIN(15), AIN(16), AWS, ll, scr, gw, NGW, lane);
        for (int it = gw; it < DEPTH * 2 * 8 * 2; it += NGW) {
            const int nb = it & 1, hd = (it >> 1) & 7, gate = (it >> 4) & 1, ll = it >> 5;
            convert_task<false, false>(AIN(gate ? 8 : 6) + ((size_t)ll * 8 + hd) * 128 * 128, WSP(bf16, WS_WG) + (((size_t)ll * 2 + gate) * 8 + hd) * 128 * 128, 128, 128, scr, nb, 0, 2, lane, nullptr, nullptr, nullptr, nullptr); }
        const float* x = AIN(0); bf16* xb = WSP(bf16, WS_XB);
        { const size_t total = (size_t)M * DM / 8, S = (size_t)G * NTHR;
          for (size_t i = (size_t)blockIdx.x * NTHR + tid; i < total; i += 4 * S) {
            f32x4 a[4], b[4];
#pragma unroll
            for (int u = 0; u < 4; ++u) { const size_t iu = i + u * S; if (iu < total) { a[u] = __builtin_nontemporal_load((const f32x4*)x + 2 * iu); b[u] = __builtin_nontemporal_load((const f32x4*)x + 2 * iu + 1); } }
#pragma unroll
            for (int u = 0; u < 4; ++u) { const size_t iu = i + u * S; if (iu < total) {
                v4u o; o.x = pk2(a[u][0], a[u][1]); o.y = pk2(a[u][2], a[u][3]); o.z = pk2(b[u][0], b[u][1]); o.w = pk2(b[u][2], b[u][3]);
                const size_t row = iu / (DM / 8), cc = iu % (DM / 8);
                *(v4u*)(xb + row * LDK + 8 * cc) = o; } } } }
    }
    GRID_BARRIER();
    for (int l_ = 0; l_ < DEPTH; ++l_) {
#define GEMM1_TABLES(S_) do { const fx_t* stp = WSP(fx_t, WS_CTL + CTL_ST) + (size_t)(l > 0 ? l - 1 : 0) * M * 2; const fx_t* Gv = WSP(fx_t, WS_CTL + CTL_GV) + (size_t)l * INW; const fx_t* Bvv = WSP(fx_t, WS_CTL + CTL_BV) + (size_t)l * INW; \
            _Pragma("unroll") for (int i = 0; i < 6; ++i) { pg8::Unit u; if ((S_).next(i, u)) { \
                if (tid < 256) { float mu = 0.f, rs = 1.f; \
                    if (l > 0) { const float s = pg8::fx_get(stp + 2 * (size_t)(u.pm * 256 + tid)), q = pg8::fx_get(stp + 2 * (size_t)(u.pm * 256 + tid) + 1); mu = s * (1.f / DM); rs = rsqrtf(fmaxf(q * (1.f / DM) - mu * mu, 0.f) + LN_EPS); } \
                    ((LAS pg8::f32x2*)(lds + pg8::TBL_ROW))[i * 256 + tid] = (pg8::f32x2){mu, rs}; } \
                else { const int cidx = u.pn * 256 + tid - 256; float gg = 0.f, bb = 0.f; if (l > 0) { gg = pg8::fx_get(Gv + cidx); bb = pg8::fx_get(Bvv + cidx); } \
                    ((LAS pg8::f32x2*)(lds + pg8::TBL_COL))[i * 256 + tid - 256] = (pg8::f32x2){gg, bb}; } } } } while (0)
        { TZ_INIT();
          pg8::Gemm g; g.A = WSP(bf16, WS_XB); g.Bt = WSP(bf16, WS_WIN) + (size_t)l * WIN_L; g.M = M; g.N = INW - 512; g.K = DM; g.ld = LDK; pg8::EpiBf16LN E; E.O = WSP(bf16, WS_H); E.ldc = INW; E.pad = 0;
          pg8::StaticOrder S; S.init(M, INW - 512, G, (int)blockIdx.x);
          auto pre = [&]() { GEMM1_TABLES(S); };
          pg8::gemm_phase<pg8::EpiBf16LN, pg8::StaticOrder, true, true>(lds, g, S, E, tid, pre); }
        GRID_BARRIER();
        { TZ_INIT();
          pg8::Gemm g; g.A = WSP(bf16, WS_XB); g.Bt = WSP(bf16, WS_WIN) + (size_t)l * WIN_L; g.M = M; g.N = INW; g.K = DM; g.ld = LDK; pg8::EpiBf16LN E; E.O = WSP(bf16, WS_H); E.ldc = INW; E.pad = 0;
          pg8::OneUnit S; { const int bx = (int)blockIdx.x, x = bx & 7, idx = bx >> 3; S.has = (bx < 64) ? 1 : 0; S.pm = 4 * x + (idx >> 1); S.pn = (INW / 256 - 2) + (idx & 1); }
          if (S.has) { auto pre = [&]() { GEMM1_TABLES(S); }; pg8::gemm_phase<pg8::EpiBf16LN, pg8::OneUnit, false, true>(lds, g, S, E, tid, pre);
              VM_WAIT(); __syncthreads();
              if (tid == 0) { __builtin_amdgcn_fence(__ATOMIC_RELEASE, "agent"); VM_WAIT();
                  __hip_atomic_fetch_add(WSP(unsigned, WS_CTL + CTL_RF) + 64 * l + S.pm * 2 + (S.pn - (INW / 256 - 2)), 1u, __ATOMIC_RELAXED, __HIP_MEMORY_SCOPE_AGENT); } } }
#define Q_NEXT() do { if (tid == 0) *qw = __hip_atomic_fetch_add(qctr, 1u, __ATOMIC_RELAXED, __HIP_MEMORY_SCOPE_AGENT); __syncthreads(); tk = (int)__builtin_amdgcn_readfirstlane((int)*qw); __syncthreads(); } while (0)
        { TZ_INIT();
          unsigned* qctr = WSP(unsigned, WS_CTL + CTL_Q) + 64 * l; LAS unsigned* qw = (LAS unsigned*)(lds + LDS_MISC) + 16; int tk;
          fx_t* ssb = WSP(fx_t, WS_CTL + CTL_SS) + (size_t)(2 * l) * M;
          Q_NEXT();
          while (tk < 256) { attn_unit(WSP(bf16, WS_H), AIN(3) + (size_t)l * NQH, AIN(12) + (size_t)l * WB, WSP(bf16, WS_MIX), ssb, lds, tk, tid); Q_NEXT(); } }
        { TZ_INIT();
          unsigned* qctr = WSP(unsigned, WS_CTL + CTL_Q) + 64 * l; LAS unsigned* qw = (LAS unsigned*)(lds + LDS_MISC) + 16; int tk = (int)__builtin_amdgcn_readfirstlane((int)*qw);
          fx_t* ssc = WSP(fx_t, WS_CTL + CTL_SS) + (size_t)(2 * l + 1) * M;
          while (tk < 512) { const int r = tk - 256;
              rg_unit(WSP(bf16, WS_H), AIN(4) + (size_t)l * 4 * WC, AIN(5) + (size_t)l * WC, WSP(bf16, WS_WG) + (size_t)l * 2 * 8 * 128 * 128, AIN(7) + (size_t)l * WC, AIN(9) + (size_t)l * WC,
                      AIN(10) + (size_t)l * WC, AIN(13) + (size_t)l * WC, WSP(bf16, WS_MIX), ssc, WSP(unsigned long long, WS_CTL + CTL_GR), WSP(unsigned, WS_CTL) + 8, (unsigned)(l + 1), lds, r >> 4, r & 3, (r >> 2) & 3, tid);
              Q_NEXT(); } }
        { TZ_INIT();
          unsigned* qctr = WSP(unsigned, WS_CTL + CTL_Q) + 64 * l; LAS unsigned* qw = (LAS unsigned*)(lds + LDS_MISC) + 16; int tk = (int)__builtin_amdgcn_readfirstlane((int)*qw);
          while (tk < 768) { const int t0 = 32 * (tk - 512) + 4 * wave;
              branch_a_pair(WSP(bf16, WS_H), AIN(2) + (size_t)l * 3 * WA, AIN(11) + (size_t)l * WA, WSP(bf16, WS_MIX), t0, lane);
              branch_a_pair(WSP(bf16, WS_H), AIN(2) + (size_t)l * 3 * WA, AIN(11) + (size_t)l * WA, WSP(bf16, WS_MIX), t0 + 2, lane);
              Q_NEXT(); } }
        { TZ_INIT();
          unsigned* qctr = WSP(unsigned, WS_CTL + CTL_Q) + 64 * l; LAS unsigned* qw = (LAS unsigned*)(lds + LDS_MISC) + 16; int tk = (int)__builtin_amdgcn_readfirstlane((int)*qw);
          fx_t* ssc = WSP(fx_t, WS_CTL + CTL_SS) + (size_t)(2 * l + 1) * M;
          while (tk < 1024) { const int r = tk - 768; int tu = tid; asm volatile("" : "+v"(tu));
              if (tid == 0) { unsigned* f = WSP(unsigned, WS_CTL + CTL_RF) + 64 * l + (8 * ((r >> 2) & 3) + (r >> 5)) * 2 + ((r & 3) >> 1); unsigned sp = 0u;
                  while (__hip_atomic_load(f, __ATOMIC_RELAXED, __HIP_MEMORY_SCOPE_AGENT) == 0u) { __builtin_amdgcn_s_sleep(2); if (++sp > (1u << 20)) { __hip_atomic_store(WSP(unsigned, WS_CTL) + 8, 1u, __ATOMIC_RELAXED, __HIP_MEMORY_SCOPE_AGENT); break; } }
                  __builtin_amdgcn_fence(__ATOMIC_ACQUIRE, "agent"); VM_WAIT(); }
              __syncthreads();
              rg_unit(WSP(bf16, WS_H), AIN(4) + (size_t)l * 4 * WC, AIN(5) + (size_t)l * WC, WSP(bf16, WS_WG) + (size_t)l * 2 * 8 * 128 * 128, AIN(7) + (size_t)l * WC, AIN(9) + (size_t)l * WC,
                      AIN(10) + (size_t)l * WC, AIN(13) + (size_t)l * WC, WSP(bf16, WS_MIX), ssc, WSP(unsigned long long, WS_CTL + CTL_GR), WSP(unsigned, WS_CTL) + 8, (unsigned)(l + 1), lds, r >> 4, 4 + (r & 3), (r >> 2) & 3, tu);
              Q_NEXT(); } }
        GRID_BARRIER();
        { TZ_INIT();
          pg8::Gemm g; g.A = WSP(bf16, WS_MIX); g.Bt = WSP(bf16, WS_WOUT) + (size_t)l * WOUT_L; g.M = M; g.N = DM; g.K = DMIX; g.ld = LDK;
          pg8::EpiResLN E; E.Yb = WSP(bf16, WS_XB); const float* lng = AIN(15) + (size_t)(l > 0 ? l - 1 : 0) * DM; const float* lnb = AIN(16) + (size_t)(l > 0 ? l - 1 : 0) * DM;
          E.st = WSP(fx_t, WS_CTL + CTL_ST) + (size_t)l * M * 2; E.alpha = ALPHA; E.ldb = LDK;
          pg8::StaticOrder S; S.init(M, DM, G, (int)blockIdx.x);
          auto pre = [&]() { const fx_t* ssb = WSP(fx_t, WS_CTL + CTL_SS) + (size_t)(2 * l) * M; const fx_t* ssc = ssb + M; const fx_t* stp = WSP(fx_t, WS_CTL + CTL_ST) + (size_t)(l > 0 ? l - 1 : 0) * M * 2;
            pg8::Unit u; if (S.next(wave >> 2, u)) { const int grow = u.pm * 256 + (tid & 255);
                const float rb = rsqrtf(pg8::fx_get(ssb + grow) * (1.f / WB) + RMS_EPS), rc = rsqrtf(pg8::fx_get(ssc + grow) * (1.f / WC) + RMS_EPS); float mu = 0.f, rs = 1.f;
                if (l > 0) { const float s = pg8::fx_get(stp + 2 * (size_t)grow), q = pg8::fx_get(stp + 2 * (size_t)grow + 1); mu = s * (1.f / DM); rs = rsqrtf(fmaxf(q * (1.f / DM) - mu * mu, 0.f) + LN_EPS); }
                ((LAS pg8::f32x4*)(lds + pg8::TBL_ROW))[tid] = (pg8::f32x4){rc / rb, rb, mu, rs};
                float gg = 1.f, bb = 0.f; if (l > 0) { gg = lng[u.pn * 256 + (tid & 255)]; bb = lnb[u.pn * 256 + (tid & 255)]; }
                ((LAS pg8::f32x2*)(lds + pg8::TBL_COL))[tid] = (pg8::f32x2){gg, bb}; } };
          pg8::gemm_phase<pg8::EpiResLN, pg8::StaticOrder, true, true>(lds, g, S, E, tid, pre); }
        GRID_BARRIER();
    }
    { const int l_ = DEPTH - 1; TZ_INIT();
      for (int t = gw; t < M; t += NGW) final_ln_token(WSP(bf16, WS_XB), WSP(fx_t, WS_CTL + CTL_ST) + (size_t)l * M * 2, AIN(15) + (size_t)l * DM, AIN(16) + (size_t)l * DM, AOUT, t, lane); }
}

extern "C" void kernel_launch(void* const* d_in, const int* in_sizes, int n_in, void* d_out, int out_size, void* d_ws, size_t ws_size, hipStream_t stream) {
    static int grid = 0;
    if (grid == 0) {
        if (n_in != 17 || in_sizes[0] != M * DM || out_size != M * DM || ws_size < WS_END) { fprintf(stderr, "kernel_launch: unexpected shapes/workspace (n_in %d, ws %zu)\n", n_in, ws_size); grid = -1; return; }
        int dev = 0, cus = 0, per_cu = 0;
        if (hipGetDevice(&dev) != hipSuccess || hipDeviceGetAttribute(&cus, hipDeviceAttributeMultiprocessorCount, dev) != hipSuccess) { grid = -1; return; }
        if (hipFuncSetAttribute((const void*)fwd, hipFuncAttributeMaxDynamicSharedMemorySize, LDS_BYTES) != hipSuccess) { fprintf(stderr, "kernel_launch: hipFuncSetAttribute failed\n"); grid = -1; return; }
        if (hipOccupancyMaxActiveBlocksPerMultiprocessor(&per_cu, (const void*)fwd, NTHR, LDS_BYTES) != hipSuccess || per_cu < 1) fprintf(stderr, "kernel_launch: occupancy query reports %d\n", per_cu);
        (void)hipGetLastError();
        grid = cus > 0 ? cus : 256;
        if (grid < 256) { fprintf(stderr, "kernel_launch: this kernel's unit tables assume at least 256 workgroups (one per CU of a 256-CU device); found %d CUs: nothing launched\n", grid); grid = -1; return; }
    }
    if (grid < 0) return;
    (void)hipMemsetAsync((char*)d_ws + WS_CTL, 0, CTL_BYTES, stream);
    Args a{};
    for (int i = 0; i < 17; ++i) a.in[i] = (const float*)d_in[i];
    a.out = (float*)d_out; a.ws = (unsigned char*)d_ws;
    hipLaunchKernelGGL(fwd, dim3(grid), dim3(NTHR), LDS_BYTES, stream, a);
}
```

```cpp
#include <hip/hip_runtime.h>
#include <cstdio>
#include <cstdint>
namespace pg8 {
#define PG8_LAS __attribute__((address_space(3)))
typedef unsigned short bf16_t;
typedef short bf16x8 __attribute__((ext_vector_type(8)));
typedef float f32x4 __attribute__((ext_vector_type(4)));
typedef float f32x2 __attribute__((ext_vector_type(2)));
typedef unsigned u32x4 __attribute__((ext_vector_type(4)));
constexpr int BM = 256, BK = 64, HALF = 128, HTB = HALF * BK * 2  , STAGE_BYTES = 8 * HTB, NXCD = 8, WGM = 8;

__host__ __device__ __forceinline__ int lds_byte(int r, int c) { const int st = (r >> 4) * 2 + (c >> 5), rr = r & 15, cc = c & 31, ob = rr * 64 + cc * 2; return st * 1024 + (ob ^ (((ob >> 9) & 1) << 5)); }
__host__ __device__ __forceinline__ void stage_rc(int b, int& R, int& C) { const int st = b / 1024, sb = b % 1024, swz = sb ^ (((sb >> 9) & 1) << 5); R = (st >> 1) * 16 + swz / 64; C = (st & 1) * 32 + (swz % 64) / 2; }
__host__ __device__ __forceinline__ int perm32(int rho) { const int n = rho >> 4, i = rho & 15; return 8 * (i >> 2) + 4 * n + (i & 3); }

struct Unit { int pm, pn; };
struct Gemm { const bf16_t* A; const bf16_t* Bt; int M, N, K, ld; };

struct StaticOrder {
    int nM, nN, nwg, G, c;
    __host__ __device__ void init(int M, int N, int G_, int c_) { nM = M / BM; nN = N / BM; nwg = nM * nN; G = G_; c = c_; }
    __host__ __device__ bool next(int i, Unit& u) const {
        const long L = (long)i * G + c; if (L >= nwg) return false;
        int wgid = (int)L; { const int q = nwg / NXCD, r = nwg % NXCD, xcd = wgid % NXCD, off = wgid / NXCD; wgid = (xcd < r ? xcd * (q + 1) : r * (q + 1) + (xcd - r) * q) + off; }
        const int nig = WGM * nN, gid = wgid / nig, fm = gid * WGM, gsz = (nM - fm) < WGM ? (nM - fm) : WGM;
        u.pm = fm + ((wgid % nig) % gsz); u.pn = (wgid % nig) / gsz; return true;
    }
    __device__ __forceinline__ void a_ready(const Unit&) const {}
    __device__ __forceinline__ void done(const Unit&) const {}
};

struct OneUnit {
    int pm, pn, has;
    __host__ __device__ bool next(int i, Unit& u) const { if (i != 0 || !has) return false; u.pm = pm; u.pn = pn; return true; }
    __device__ __forceinline__ void a_ready(const Unit&) const {}
    __device__ __forceinline__ void done(const Unit&) const {}
};

__device__ __forceinline__ void fx_add(unsigned long long* p, float v) { atomicAdd(p, (unsigned long long)__float2ll_rn(v * 4294967296.f)); }
__device__ __forceinline__ float fx_get(const unsigned long long* p) { return (float)(long long)(*p) * 2.3283064365386963e-10f; }
__device__ __forceinline__ unsigned cvt_pk_bf16(float lo, float hi) { unsigned r; asm volatile("v_cvt_pk_bf16_f32 %0, %1, %2" : "=v"(r) : "v"(lo), "v"(hi)); return r; }

constexpr int TBL_ROW = 131072 + 2048;
constexpr int TBL_COL = TBL_ROW + 6 * 256 * 8;
struct EpiBf16LN {
    static constexpr bool PERM = true, AFTER_DRAIN = false, KSCALE = false;
    bf16_t* O; int ldc, pad;
    __device__ __forceinline__ void operator()(const f32x4 (&acc)[2][2][4][2], const Unit& u, int wr, int wc, int fr, int fq, int ui, PG8_LAS unsigned char* lds) const {
        const int row0 = u.pm * BM + wr * 64 + fr; const int col0 = u.pn * BM + wc * 32 + 8 * fq;
        const bool prod = (u.pn >= 4) && (u.pn < 12); const int pcol = 1024 + (u.pn - 4) * HALF + wc * 32 + 8 * fq;
        const PG8_LAS f32x2* rt = (const PG8_LAS f32x2*)(lds + TBL_ROW) + ui * 256 + wr * 64 + fr;
        const PG8_LAS f32x4* ct = (const PG8_LAS f32x4*)(lds + TBL_COL + (ui * 256 + wc * 32 + 8 * fq) * 8);
        f32x4 cq[2][2][2];
#pragma unroll
        for (int bj = 0; bj < 2; ++bj)
#pragma unroll
            for (int n = 0; n < 2; ++n) { cq[bj][n][0] = ct[(bj * HALF + 4 * n) / 2]; cq[bj][n][1] = ct[(bj * HALF + 4 * n) / 2 + 1]; }
#pragma unroll
        for (int ai = 0; ai < 2; ++ai)
#pragma unroll
            for (int m = 0; m < 4; ++m) { bf16_t* rowp = O + (size_t)(row0 + ai * HALF + m * 16) * ldc; const f32x2 ms = rt[ai * HALF + m * 16]; const float mu = ms.x, rs = ms.y;
                float o[2][8];
#pragma unroll
                for (int bj = 0; bj < 2; ++bj)
#pragma unroll
                    for (int n = 0; n < 2; ++n) { const f32x4 v = acc[ai][bj][m][n];
                        o[bj][4 * n + 0] = rs * (v[0] - mu * cq[bj][n][0][0]) + cq[bj][n][0][1]; o[bj][4 * n + 1] = rs * (v[1] - mu * cq[bj][n][0][2]) + cq[bj][n][0][3];
                        o[bj][4 * n + 2] = rs * (v[2] - mu * cq[bj][n][1][0]) + cq[bj][n][1][1]; o[bj][4 * n + 3] = rs * (v[3] - mu * cq[bj][n][1][2]) + cq[bj][n][1][3]; }
                if (prod) {
                    u32x4 w; w.x = cvt_pk_bf16(o[0][0] * o[1][0], o[0][1] * o[1][1]); w.y = cvt_pk_bf16(o[0][2] * o[1][2], o[0][3] * o[1][3]); w.z = cvt_pk_bf16(o[0][4] * o[1][4], o[0][5] * o[1][5]); w.w = cvt_pk_bf16(o[0][6] * o[1][6], o[0][7] * o[1][7]);
                    *(u32x4*)(rowp + pcol) = w;
                } else {
#pragma unroll
                    for (int bj = 0; bj < 2; ++bj) { u32x4 w; w.x = cvt_pk_bf16(o[bj][0], o[bj][1]); w.y = cvt_pk_bf16(o[bj][2], o[bj][3]); w.z = cvt_pk_bf16(o[bj][4], o[bj][5]); w.w = cvt_pk_bf16(o[bj][6], o[bj][7]);
                        *(u32x4*)(rowp + col0 + bj * HALF) = w; } } }
    }
};
struct EpiResLN {
    static constexpr bool PERM = true, AFTER_DRAIN = false, KSCALE = true;
    static constexpr int KS1 = 16, KS2 = 48;
    bf16_t* Yb; unsigned long long* st; float alpha; int ldb;
    __device__ __forceinline__ void kscale(f32x4 (&acc)[2][2][4][2], int ui, int which, int wr, int fr, PG8_LAS unsigned char* lds) const {
        const PG8_LAS f32x4* tbl = (const PG8_LAS f32x4*)(lds + TBL_ROW) + ui * 256 + wr * 64 + fr;
#pragma unroll
        for (int ai = 0; ai < 2; ++ai)
#pragma unroll
            for (int m = 0; m < 4; ++m) { const f32x4 fv = tbl[ai * HALF + m * 16]; const float f = which ? fv[1] : fv[0];
#pragma unroll
                for (int bj = 0; bj < 2; ++bj)
#pragma unroll
                    for (int n = 0; n < 2; ++n) acc[ai][bj][m][n] = acc[ai][bj][m][n] * f; }
    }
    static __device__ __forceinline__ float lo16(unsigned w) { return __builtin_bit_cast(float, w << 16); }
    static __device__ __forceinline__ float hi16(unsigned w) { return __builtin_bit_cast(float, w & 0xffff0000u); }
    __device__ __forceinline__ void operator()(const f32x4 (&acc)[2][2][4][2], const Unit& u, int wr, int wc, int fr, int fq, int ui, PG8_LAS unsigned char* lds) const {
        const int row0 = u.pm * BM + wr * 64 + fr, col0 = u.pn * BM + wc * 32 + 8 * fq;
        const PG8_LAS f32x4* rt = (const PG8_LAS f32x4*)(lds + TBL_ROW) + ui * 256 + wr * 64 + fr;
        const PG8_LAS f32x4* ct = (const PG8_LAS f32x4*)(lds + TBL_COL + (ui * 256 + wc * 32 + 8 * fq) * 8);
        u32x4 A0[4][2];
#define EPI_LOAD(buf, stg) do { _Pragma("unroll") for (int bj_ = 0; bj_ < 2; ++bj_) { const int row_ = row0 + ((stg) >> 2) * HALF + ((stg) & 3) * 16; \
            A0[buf][bj_] = *(const u32x4*)(Yb + (size_t)row_ * ldb + col0 + bj_ * HALF); } } while (0)
        EPI_LOAD(0, 0); EPI_LOAD(1, 1); EPI_LOAD(2, 2);
        float sq[2][2];
#pragma unroll
        for (int stg = 0; stg < 8; ++stg) {
            const int ai = stg >> 2, m = stg & 3, mi = m & 1;
            if (stg + 3 < 8) { if (((stg + 3) & 3) == 0) EPI_LOAD(0, stg + 3); else if (((stg + 3) & 3) == 1) EPI_LOAD(1, stg + 3); else if (((stg + 3) & 3) == 2) EPI_LOAD(2, stg + 3); else EPI_LOAD(3, stg + 3); }
            asm volatile("" ::: "memory");
            { const int row = row0 + ai * HALF + m * 16; const f32x4 tv = rt[ai * HALF + m * 16]; const float mu = tv[2], rs = tv[3];
                float s = 0.f, q = 0.f;
#pragma unroll
                for (int bj = 0; bj < 2; ++bj) { const size_t oh = (size_t)row * ldb + col0 + bj * HALF;
                    const u32x4 w0 = ((stg & 3) == 0) ? A0[0][bj] : (((stg & 3) == 1) ? A0[1][bj] : (((stg & 3) == 2) ? A0[2][bj] : A0[3][bj]));
                    float xr[8];
#pragma unroll
                    for (int j = 0; j < 4; ++j) { const float ye = lo16(w0[j]), yo = hi16(w0[j]);
                        const f32x4 gb = ct[(bj * HALF) / 2 + j];
                        xr[2 * j] = (ye - mu) * rs * gb[0] + gb[1]; xr[2 * j + 1] = (yo - mu) * rs * gb[2] + gb[3]; }
                    float y[8];
#pragma unroll
                    for (int j = 0; j < 4; ++j) { y[j] = xr[j] * alpha + acc[ai][bj][m][0][j]; y[4 + j] = xr[4 + j] * alpha + acc[ai][bj][m][1][j]; }
#pragma unroll
                    for (int j = 0; j < 8; ++j) { s += y[j]; q += y[j] * y[j]; }
                    u32x4 hn;
#pragma unroll
                    for (int j = 0; j < 4; ++j) hn[j] = cvt_pk_bf16(y[2 * j], y[2 * j + 1]);
                    *(u32x4*)(Yb + oh) = hn; }
                s += __shfl_xor(s, 16); s += __shfl_xor(s, 32); q += __shfl_xor(q, 16); q += __shfl_xor(q, 32);
                sq[mi][0] = s; sq[mi][1] = q; }
            if (mi == 1) {
                const int mi2 = fq >> 1, wh = fq & 1; const int row = row0 + ai * HALF + ((m & 2) + mi2) * 16;
                const float v = mi2 ? (wh ? sq[1][1] : sq[1][0]) : (wh ? sq[0][1] : sq[0][0]);
                fx_add(st + 2 * (size_t)row + wh, v); }
        }
#undef EPI_LOAD
    }
};

template <class Epi, class Sched, bool ALIGN_EPI = false, bool SP2 = false, class Pre>
__device__ __forceinline__ void gemm_phase(PG8_LAS unsigned char* lds, const Gemm g, const Sched& S, const Epi& E, const int tid, const Pre& pre) {
    const int wid = __builtin_amdgcn_readfirstlane(tid >> 6), lane = tid & 63, wr = wid >> 2, wc = wid & 3, fr = lane & 15, fq = lane >> 4;
    const int K = g.ld, nt = g.K / BK;
    unsigned voffA[2], voffB[2];
#pragma unroll
    for (int i = 0; i < 2; ++i) { int R, C; stage_rc(tid * 16 + i * 8192, R, C); const int Rb = Epi::PERM ? ((R & ~31) + perm32(R & 31)) : R;
        voffA[i] = (unsigned)(R * K + C) * 2u; voffB[i] = (unsigned)(Rb * K + C) * 2u; }
    const size_t kstep = (size_t)(BK * 2);
    const size_t hstep = (size_t)HALF * K * 2;
    const size_t tstep = 2 * hstep;
    const unsigned ldsw = (unsigned)wid * 1024u;
    const int aoff = lds_byte(wr * 64 + fr, fq * 8), boff = lds_byte(wc * 32 + fr, fq * 8);
#define PG8_SA(b, h) (((b) * 2 + (h)) * HTB)
#define PG8_SB(b, h) ((4 + (b) * 2 + (h)) * HTB)
#define PG8_STAGE(bufoff, gbase, voff) do { _Pragma("unroll") for (int _i = 0; _i < 2; ++_i) \
        __builtin_amdgcn_global_load_lds((const unsigned*)((const char*)(gbase) + (voff)[_i]), (PG8_LAS unsigned*)(lds + (bufoff) + ldsw + _i * 8192), 16, 0, 0); } while (0)
#define PG8_LDA(dst, b, h) do { _Pragma("unroll") for (int m = 0; m < 4; ++m) _Pragma("unroll") for (int k = 0; k < 2; ++k) dst[m][k] = *(const PG8_LAS bf16x8*)(lds + PG8_SA(b, h) + aoff + m * 2048 + k * 1024); } while (0)
#define PG8_LDB(dst, b, h) do { _Pragma("unroll") for (int n = 0; n < 2; ++n) _Pragma("unroll") for (int k = 0; k < 2; ++k) dst[n][k] = *(const PG8_LAS bf16x8*)(lds + PG8_SB(b, h) + boff + n * 2048 + k * 1024); } while (0)
#define PG8_MMA(ai, bj, At, Bt) do { __builtin_amdgcn_s_setprio(1); _Pragma("unroll") for (int m = 0; m < 4; ++m) _Pragma("unroll") for (int n = 0; n < 2; ++n) _Pragma("unroll") for (int k = 0; k < 2; ++k) \
        acc[ai][bj][m][n] = __builtin_amdgcn_mfma_f32_16x16x32_bf16(Bt[n][k], At[m][k], acc[ai][bj][m][n], 0, 0, 0); __builtin_amdgcn_s_setprio(0); } while (0)
#define PG8_WAIT_V(n) asm volatile("s_waitcnt vmcnt(" #n ")" ::: "memory")
#define PG8_WAIT_L(n) asm volatile("s_waitcnt lgkmcnt(" #n ")" ::: "memory")
#define PG8_BAR __builtin_amdgcn_s_barrier()
#define PG8_SCHED __builtin_amdgcn_sched_barrier(0)
    Unit cur, nxt; int ui = 0;
    if (!S.next(0, cur)) return;
    f32x4 acc[2][2][4][2];
#pragma unroll
    for (int a = 0; a < 2; ++a)
#pragma unroll
        for (int b = 0; b < 2; ++b)
#pragma unroll
            for (int m = 0; m < 4; ++m)
#pragma unroll
                for (int n = 0; n < 2; ++n) acc[a][b][m][n] = (f32x4){0.f, 0.f, 0.f, 0.f};
    bf16x8 At[4][2], B0[2][2], B1[2][2];
    const char* cA = (const char*)g.A + (size_t)cur.pm * tstep; const char* cB = (const char*)g.Bt + (size_t)cur.pn * tstep;
    S.a_ready(cur);
    if constexpr (SP2) {
        PG8_STAGE(PG8_SB(0, 0), cB, voffB); PG8_STAGE(PG8_SB(0, 1), cB + hstep, voffB); PG8_STAGE(PG8_SA(0, 0), cA, voffA); PG8_STAGE(PG8_SA(0, 1), cA + hstep, voffA);
        pre();
        if (wr == 1) PG8_BAR;
        PG8_WAIT_V(2); PG8_BAR;
        PG8_STAGE(PG8_SB(1, 0), cB + kstep, voffB); PG8_STAGE(PG8_SA(1, 0), cA + kstep, voffA); PG8_STAGE(PG8_SB(1, 1), cB + hstep + kstep, voffB);
        PG8_WAIT_V(6); PG8_BAR;
    } else {
        PG8_STAGE(PG8_SB(0, 0), cB, voffB); PG8_STAGE(PG8_SA(0, 0), cA, voffA); PG8_STAGE(PG8_SB(0, 1), cB + hstep, voffB); PG8_STAGE(PG8_SA(0, 1), cA + hstep, voffA);
        if (wr == 1) PG8_BAR;
        PG8_WAIT_V(4); PG8_BAR;
        PG8_STAGE(PG8_SB(1, 0), cB + kstep, voffB); PG8_STAGE(PG8_SA(1, 0), cA + kstep, voffA); PG8_STAGE(PG8_SB(1, 1), cB + hstep + kstep, voffB);
        PG8_WAIT_V(6); PG8_BAR;
    }
    for (;;) {
        const bool has_next = S.next(ui + 1, nxt);
        const char* nA = has_next ? (const char*)g.A + (size_t)nxt.pm * tstep : cA; const char* nB = has_next ? (const char*)g.Bt + (size_t)nxt.pn * tstep : cB;
        for (int t = 0; t < nt; t += 2) {
            const bool last = (t == nt - 2);
            const char* a1 = cA + (size_t)(t + 1) * kstep;
            const char* a2 = last ? nA : cA + (size_t)(t + 2) * kstep; const char* b2 = last ? nB : cB + (size_t)(t + 2) * kstep;
            const char* a3 = a2 + kstep; const char* b3 = b2 + kstep;
            if (last && has_next) S.a_ready(nxt);
            if constexpr (Epi::KSCALE) { if (t == Epi::KS1 || t == Epi::KS2) E.kscale(acc, ui, t == Epi::KS1 ? 0 : 1, wr, fr, lds); }
            if constexpr (SP2) {
            PG8_LDB(B0, 0, 0); PG8_LDB(B1, 0, 1); PG8_SCHED; PG8_LDA(At, 0, 0); PG8_STAGE(PG8_SA(1, 1), a1 + hstep, voffA);
            PG8_WAIT_V(8); PG8_WAIT_L(0); PG8_BAR; PG8_MMA(0, 0, At, B0); PG8_MMA(0, 1, At, B1); PG8_BAR; PG8_SCHED;
            PG8_LDA(At, 0, 1); PG8_STAGE(PG8_SB(0, 0), b2, voffB); PG8_STAGE(PG8_SB(0, 1), b2 + hstep, voffB); PG8_STAGE(PG8_SA(0, 0), a2, voffA);
            PG8_WAIT_V(8); PG8_WAIT_L(0); PG8_BAR; PG8_MMA(1, 0, At, B0); PG8_MMA(1, 1, At, B1); PG8_BAR; PG8_SCHED;
            PG8_LDB(B0, 1, 0); PG8_LDB(B1, 1, 1); PG8_SCHED; PG8_LDA(At, 1, 0); PG8_STAGE(PG8_SA(0, 1), a2 + hstep, voffA);
            PG8_WAIT_V(8); PG8_WAIT_L(0); PG8_BAR; PG8_MMA(0, 0, At, B0); PG8_MMA(0, 1, At, B1); PG8_BAR; PG8_SCHED;
            PG8_LDA(At, 1, 1); PG8_STAGE(PG8_SB(1, 0), b3, voffB); PG8_STAGE(PG8_SB(1, 1), b3 + hstep, voffB); PG8_STAGE(PG8_SA(1, 0), a3, voffA);
            PG8_WAIT_V(8); PG8_WAIT_L(0); PG8_BAR; PG8_MMA(1, 0, At, B0); PG8_MMA(1, 1, At, B1); PG8_BAR; PG8_SCHED;
            } else {
            PG8_LDB(B0, 0, 0); PG8_SCHED; PG8_LDA(At, 0, 0); PG8_STAGE(PG8_SA(1, 1), a1 + hstep, voffA);
            PG8_WAIT_L(8); PG8_BAR; PG8_WAIT_L(0); PG8_MMA(0, 0, At, B0); PG8_BAR; PG8_SCHED;
            PG8_LDB(B1, 0, 1); PG8_STAGE(PG8_SB(0, 0), b2, voffB);
            PG8_BAR; PG8_WAIT_L(0); PG8_MMA(0, 1, At, B1); PG8_BAR;
            PG8_LDA(At, 0, 1); PG8_STAGE(PG8_SA(0, 0), a2, voffA);
            PG8_BAR; PG8_WAIT_L(0); PG8_MMA(1, 0, At, B0); PG8_BAR; PG8_SCHED;
            PG8_STAGE(PG8_SB(0, 1), b2 + hstep, voffB);
            PG8_WAIT_V(6); PG8_BAR; PG8_MMA(1, 1, At, B1); PG8_BAR;
            PG8_LDB(B0, 1, 0); PG8_SCHED; PG8_LDA(At, 1, 0); PG8_STAGE(PG8_SA(0, 1), a2 + hstep, voffA);
            PG8_WAIT_L(8); PG8_BAR; PG8_WAIT_L(0); PG8_MMA(0, 0, At, B0); PG8_BAR; PG8_SCHED;
            PG8_LDB(B1, 1, 1); PG8_STAGE(PG8_SB(1, 0), b3, voffB);
            PG8_BAR; PG8_WAIT_L(0); PG8_MMA(0, 1, At, B1); PG8_BAR;
            PG8_LDA(At, 1, 1); PG8_STAGE(PG8_SA(1, 0), a3, voffA);
            PG8_BAR; PG8_WAIT_L(0); PG8_MMA(1, 0, At, B0); PG8_BAR; PG8_SCHED;
            PG8_STAGE(PG8_SB(1, 1), b3 + hstep, voffB);
            PG8_WAIT_V(6); PG8_BAR; PG8_MMA(1, 1, At, B1); PG8_BAR;
            }
        }
        if constexpr (ALIGN_EPI) { if (wr == 0) PG8_BAR; }
        if constexpr (!Epi::AFTER_DRAIN) { E(acc, cur, wr, wc, fr, fq, ui, lds); S.done(cur); }
        if (!has_next) break;
#pragma unroll
        for (int a = 0; a < 2; ++a)
#pragma unroll
            for (int b = 0; b < 2; ++b)
#pragma unroll
                for (int m = 0; m < 4; ++m)
#pragma unroll
                    for (int n = 0; n < 2; ++n) acc[a][b][m][n] = (f32x4){0.f, 0.f, 0.f, 0.f};
        cur = nxt; cA = nA; cB = nB; ++ui;
        if constexpr (ALIGN_EPI) { if (wr == 1) PG8_BAR; }
    }
    PG8_WAIT_V(0);
    if constexpr (!ALIGN_EPI) { if (wr == 0) PG8_BAR; }
    PG8_BAR;
    if constexpr (Epi::AFTER_DRAIN) { E.fused(acc, cur, wr, wc, fr, fq, lds, wid, lane); S.done(cur); }
#undef PG8_SA
#undef PG8_SB
#undef PG8_STAGE
#undef PG8_LDA
#undef PG8_LDB
#undef PG8_MMA
#undef PG8_WAIT_V
#undef PG8_WAIT_L
#undef PG8_BAR
#undef PG8_SCHED
}
}

typedef unsigned short bf16;
typedef unsigned v4u __attribute__((ext_vector_type(4)));
typedef unsigned v2u __attribute__((ext_vector_type(2)));
typedef float f32x4 __attribute__((ext_vector_type(4)));
constexpr int DM = 4096, NB = 4, SEQ = 2048, M = NB * SEQ, DEPTH = 4;
constexpr int WA = 1024, WB = 2048, WC = 1024, DMIX = 4096, HD = 64, NQH = 32, KVG = 8, NKV = 4;
constexpr int INW = 10752;
constexpr int LDK = 4096 + 64;
constexpr int OFF_AB = 0, OFF_AC = 1024, OFF_AX = 2048, OFF_AG = 3072, OFF_Q = 4096, OFF_K = 6144, OFF_V = 6400, OFF_BG = 6656, OFF_CX = 8704, OFF_CG = 9728;
constexpr int MIX_C = 0, MIX_B = 1024, MIX_A = 3072;
constexpr size_t CTL_SS = 65536;
constexpr size_t CTL_BYTES = 3u << 20, CTL_GR = 2u << 20;
constexpr size_t WS_WG = 8u << 20;
constexpr size_t CTL_GV = CTL_SS + (size_t)DEPTH * 2 * M * 8, CTL_BV = CTL_GV + (size_t)DEPTH * INW * 8, CTL_ST = CTL_BV + (size_t)DEPTH * INW * 8;
static_assert(CTL_ST + (size_t)DEPTH * M * 2 * 8 <= CTL_GR, "CTL map");
typedef unsigned long long fx_t;
constexpr size_t CTL_RF = 8192;
constexpr size_t CTL_Q = 4096;
constexpr float ALPHA = 1.6817928305074290861f;
constexpr float LN_EPS = 1e-5f, RMS_EPS = 1e-6f;
constexpr size_t MiB = 1u << 20;
constexpr size_t WS_CTL = 0, WS_WIN = 16 * MiB, WS_WOUT = 360 * MiB, WS_XB = 492 * MiB, WS_H = 558 * MiB, WS_MIX = 726 * MiB, WS_Y = 792 * MiB, WS_END = 920 * MiB;
constexpr size_t WIN_L = (size_t)INW * LDK, WOUT_L = (size_t)DM * LDK;

__device__ __forceinline__ unsigned f2bf(float f) { unsigned u = __builtin_bit_cast(unsigned, f); return (u + 0x7fffu + ((u >> 16) & 1u)) >> 16; }
__device__ __forceinline__ unsigned pk2(float lo, float hi) { return f2bf(lo) | (f2bf(hi) << 16); }
__device__ __forceinline__ float bf2f(unsigned short b) { return __builtin_bit_cast(float, (unsigned)b << 16); }
__device__ __forceinline__ float bflo(unsigned w) { return __builtin_bit_cast(float, w << 16); }
__device__ __forceinline__ float bfhi(unsigned w) { return __builtin_bit_cast(float, w & 0xffff0000u); }
__device__ __forceinline__ float wave_sum(float v) {
#pragma unroll
    for (int o = 1; o < 64; o <<= 1) v += __shfl_xor(v, o);
    return v;
}
__device__ __forceinline__ float wave_max(float v) {
#pragma unroll
    for (int o = 1; o < 64; o <<= 1) v = fmaxf(v, __shfl_xor(v, o));
    return v;
}
__device__ __forceinline__ float silu(float x) { return x * __builtin_amdgcn_rcpf(1.f + __builtin_amdgcn_exp2f(x * -1.44269504088896341f)); }
__device__ __forceinline__ float sigmoidf(float x) { return 1.f / (1.f + __expf(-x)); }
#define LDS_WAIT() asm volatile("s_waitcnt lgkmcnt(0)" ::: "memory")

static_assert(WS_WIN + DEPTH * WIN_L * 2 <= WS_WOUT && WS_WOUT + DEPTH * WOUT_L * 2 <= WS_XB && WS_XB + (size_t)M * LDK * 2 <= WS_H && WS_H + (size_t)M * INW * 2 <= WS_MIX && WS_MIX + (size_t)M * LDK * 2 <= WS_Y && WS_Y + (size_t)M * DM * 4 <= WS_END, "workspace map");
#define XB_TMO      128
#define XB_XCNT(j)  (256  + 64 * (j))
#define XB_XSUB(j)  (1280 + 64 * (j))
#define XB_XGEN(j)  (2304 + 64 * (j))
#define XB_TOP      3328
#define XB_TOPGEN   3392
#define XCD_BAR_WORDS 3456
#define XB_SPIN_CAP (1u << 18)
#define LAS __attribute__((address_space(3)))

__device__ __forceinline__ unsigned xb_ld(unsigned* p)              { return __hip_atomic_load(p, __ATOMIC_RELAXED, __HIP_MEMORY_SCOPE_AGENT); }
__device__ __forceinline__ unsigned xb_add(unsigned* p, unsigned v) { return __hip_atomic_fetch_add(p, v, __ATOMIC_RELAXED, __HIP_MEMORY_SCOPE_AGENT); }
__device__ __forceinline__ unsigned xb_xcc_id() { return (unsigned)__builtin_amdgcn_s_getreg((3 << 11) | 20) & 0xFu; }
#define XB_SPIN(cond, bar) do { unsigned _sp = 0; while (cond) { __builtin_amdgcn_s_sleep(1); \
    if ((++_sp & 255u) == 0u) { if (xb_ld(&(bar)[XB_TMO])) break; if (_sp > XB_SPIN_CAP) { atomicAdd(&(bar)[XB_TMO], 1u); break; } } } } while (0)

struct XcdBarrier {
    unsigned* bar; unsigned x;
    volatile LAS unsigned* st;
};

__device__ __forceinline__ XcdBarrier xcd_barrier_post(unsigned* bar, volatile LAS unsigned* st) {
    XcdBarrier b; b.bar = bar; b.x = xb_xcc_id(); b.st = st;
    if (threadIdx.x == 0) (void)xb_add(&bar[XB_XCNT(b.x)], 1u);
    return b;
}
__device__ __forceinline__ void xcd_barrier_complete(unsigned* bar, unsigned x, unsigned& nloc, unsigned& nx) {
    const unsigned G = gridDim.x * gridDim.y * gridDim.z;
    unsigned sum, cnt, mine, sp = 0u;
    for (;;) {
        sum = 0u; cnt = 0u; mine = 0u;
#pragma unroll
        for (unsigned j = 0; j < 16; ++j) { const unsigned c = xb_ld(&bar[XB_XCNT(j)]); sum += c; cnt += (c > 0u) ? 1u : 0u; mine = (j == x) ? c : mine; }
        if (sum == G) break;
        __builtin_amdgcn_s_sleep(1);
        if ((++sp & 255u) == 0u) { if (xb_ld(&bar[XB_TMO])) break; if (sp > XB_SPIN_CAP) { atomicAdd(&bar[XB_TMO], 1u); break; } }
    }
    nloc = mine > 0u ? mine : 1u; nx = cnt > 0u ? cnt : 1u;
}

__device__ __forceinline__ void xcd_barrier(const XcdBarrier& b) {
    asm volatile("s_waitcnt vmcnt(0)" ::: "memory");
    __syncthreads();
    if (threadIdx.x == 0) {
        unsigned* bar = b.bar;
        __builtin_amdgcn_s_waitcnt(0);
        unsigned nloc = b.st[0], nx = b.st[1];
        if (nloc == 0u) { xcd_barrier_complete(bar, b.x, nloc, nx); b.st[0] = nloc; b.st[1] = nx; }
        const unsigned old = xb_add(&bar[XB_XSUB(b.x)], 1u);
        const unsigned gen = old / nloc;
        if (old + 1u == (gen + 1u) * nloc) {
            __builtin_amdgcn_fence(__ATOMIC_RELEASE, "agent");
            asm volatile("s_waitcnt vmcnt(0)" ::: "memory");
            const unsigned og = xb_add(&bar[XB_TOP], 1u);
            const unsigned tg = og / nx;
            if (og + 1u == (tg + 1u) * nx) xb_add(&bar[XB_TOPGEN], 1u);
            else XB_SPIN(xb_ld(&bar[XB_TOPGEN]) == tg, bar);
            __builtin_amdgcn_fence(__ATOMIC_ACQUIRE, "agent");
            xb_add(&bar[XB_XGEN(b.x)], 1u);
            asm volatile("s_waitcnt vmcnt(0)" ::: "memory");
        } else {
            XB_SPIN(xb_ld(&bar[XB_XGEN(b.x)]) == gen, bar);
            __builtin_amdgcn_fence(__ATOMIC_ACQUIRE, "agent");
            asm volatile("s_waitcnt vmcnt(0)" ::: "memory");
        }
    }
    __syncthreads();
}
constexpr int NWAVES = 8, NTHR = 512;
constexpr int LDS_MISC = 131072 + 320, LDS_BYTES = 163840;
#define VM_WAIT() asm volatile("s_waitcnt vmcnt(0)" ::: "memory")

template <bool KPERM, bool GFOLD> __device__ __forceinline__ void convert_task(const float* __restrict__ W, bf16* __restrict__ WT, int ldt, int N, LAS float* scr, int nb, int nbd, int kb0, int nkb, int lane,
                                                                               const float* __restrict__ gvec, const float* __restrict__ bvec, fx_t* __restrict__ Gout, fx_t* __restrict__ Bout) {
    const int n0 = 64 * nb, n0d = 64 * nbd, c = lane & 7, nr = lane >> 3;
    const __amdgpu_buffer_rsrc_t rsW = __builtin_amdgcn_make_buffer_rsrc((void*)W, (short)0, 0x7ffffff0, 0x00020000);
    float gacc[8], bacc[8];
#pragma unroll
    for (int j = 0; j < 8; ++j) { gacc[j] = 0.f; bacc[j] = 0.f; }
    for (int kb = kb0; kb < kb0 + nkb; ++kb) {
        const int k0 = 64 * kb;
        const int ks = KPERM ? (k0 < 1024 ? k0 + 3072 : (k0 < 3072 ? k0 : k0 - 3072)) : k0;
        const int kr = lane >> 4, cq = lane & 15;
        const int voff = (kr * N + 4 * cq) * 4;
        f32x4 r[16];
#pragma unroll
        for (int i = 0; i < 16; ++i) r[i] = __builtin_bit_cast(f32x4, __builtin_amdgcn_raw_buffer_load_b128(rsW, voff, ((ks + 4 * i) * N + n0) * 4, 2));
#pragma unroll
        for (int i = 0; i < 16; ++i) { const int row = 4 * i + kr; *(LAS f32x4*)(scr + row * 64 + ((4 * cq) ^ (8 * (row >> 3)))) = r[i]; }
        LDS_WAIT();
        float gk[8], bk[8];
        if (GFOLD) { const f32x4 g0 = *(const f32x4*)(gvec + k0 + 8 * c), g1 = *(const f32x4*)(gvec + k0 + 8 * c + 4), b0 = *(const f32x4*)(bvec + k0 + 8 * c), b1 = *(const f32x4*)(bvec + k0 + 8 * c + 4);
#pragma unroll
            for (int e = 0; e < 4; ++e) { gk[e] = g0[e]; gk[4 + e] = g1[e]; bk[e] = b0[e]; bk[4 + e] = b1[e]; } }
#pragma unroll
        for (int j = 0; j < 8; ++j) { const int n = nr + 8 * j; const LAS float* s = scr + (8 * c) * 64 + (n ^ (8 * c));
            float v[8];
#pragma unroll
            for (int e = 0; e < 8; ++e) { v[e] = s[e * 64]; if (GFOLD) { bacc[j] += bk[e] * v[e]; v[e] *= gk[e]; } }
            v4u o; o.x = pk2(v[0], v[1]); o.y = pk2(v[2], v[3]); o.z = pk2(v[4], v[5]); o.w = pk2(v[6], v[7]);
            *(v4u*)(WT + (size_t)(n0d + n) * ldt + k0 + 8 * c) = o;
            if (GFOLD) gacc[j] += ((bflo(o.x) + bfhi(o.x)) + (bflo(o.y) + bfhi(o.y))) + ((bflo(o.z) + bfhi(o.z)) + (bflo(o.w) + bfhi(o.w))); }
        LDS_WAIT();
    }
    if (GFOLD) {
#pragma unroll
        for (int j = 0; j < 8; ++j) { float gp = gacc[j], bp = bacc[j];
            gp += __shfl_xor(gp, 1); gp += __shfl_xor(gp, 2); gp += __shfl_xor(gp, 4); bp += __shfl_xor(bp, 1); bp += __shfl_xor(bp, 2); bp += __shfl_xor(bp, 4);
            if (c == 0) { pg8::fx_add(Gout + n0d + nr + 8 * j, gp); pg8::fx_add(Bout + n0d + nr + 8 * j, bp); } } }
}
__device__ __forceinline__ int win_dst_block(int nb) { return (nb >= 16 && nb < 32) ? 16 + 4 * ((nb - 16) >> 1) + ((nb - 16) & 1) : ((nb >= 32 && nb < 48) ? 18 + 4 * ((nb - 32) >> 1) + ((nb - 32) & 1) : nb); }
constexpr int CV_NK = 2, CV_KQ = DM / 64 / CV_NK, CV_T_IN = (INW / 64) * CV_KQ, CV_T_OUT = (DM / 64) * CV_KQ, CV_T_L = CV_T_IN + CV_T_OUT;
__device__ __forceinline__ void convert_layer(const float* __restrict__ w_in, const float* __restrict__ w_out, const float* __restrict__ ln_g, const float* __restrict__ ln_b, unsigned char* ws, int ll, LAS float* scr, int wv, int nwv, int lane) {
    for (int r = wv; r < CV_T_L; r += nwv) {
        if (r < CV_T_IN) { const int kq = r % CV_KQ, nb = r / CV_KQ;
            if (ll == 0) convert_task<false, false>(w_in, (bf16*)(ws + WS_WIN), LDK, INW, scr, nb, win_dst_block(nb), kq * CV_NK, CV_NK, lane, nullptr, nullptr, nullptr, nullptr);
            else convert_task<false, true>(w_in + (size_t)ll * DM * INW, (bf16*)(ws + WS_WIN) + (size_t)ll * WIN_L, LDK, INW, scr, nb, win_dst_block(nb), kq * CV_NK, CV_NK, lane, ln_g + (size_t)(ll - 1) * DM, ln_b + (size_t)(ll - 1) * DM,
                                                (fx_t*)(ws + WS_CTL + CTL_GV) + (size_t)ll * INW, (fx_t*)(ws + WS_CTL + CTL_BV) + (size_t)ll * INW); }
        else { const int r2 = r - CV_T_IN, kq = r2 % CV_KQ, nb = r2 / CV_KQ;
            convert_task<true, false>(w_out + (size_t)ll * DMIX * DM, (bf16*)(ws + WS_WOUT) + (size_t)ll * WOUT_L, LDK, DM, scr, nb, nb, kq * CV_NK, CV_NK, lane, nullptr, nullptr, nullptr, nullptr); }
    }
}

__device__ __forceinline__ void branch_a_pair(const bf16* __restrict__ h, const float* __restrict__ cw, const float* __restrict__ nrm, bf16* __restrict__ mix, int t0, int lane) {
    const int s0 = t0 % SEQ;
    const bf16* hr = h + (size_t)t0 * INW;
    float y[2][16], ss[2] = {0.f, 0.f}; v4u agk[2][2];
#pragma unroll
    for (int j = 0; j < 2; ++j) {
        const int ch0 = j * 512 + lane * 8;
        v4u ur[4], ab[2];
#pragma unroll
        for (int i = 0; i < 4; ++i) { ur[i] = (v4u){0u, 0u, 0u, 0u};
            if (i >= 2 || s0 > 0) ur[i] = *(const v4u*)(hr + (long)(i - 2) * INW + OFF_AC + ch0); }
#pragma unroll
        for (int i = 0; i < 2; ++i) { ab[i] = *(const v4u*)(hr + (size_t)i * INW + OFF_AB + ch0); agk[i][j] = *(const v4u*)(hr + (size_t)i * INW + OFF_AG + ch0); }
        float w0[8], w1[8], w2[8];
        { const f32x4 a0 = *(const f32x4*)(cw + ch0), a1 = *(const f32x4*)(cw + ch0 + 4), b0 = *(const f32x4*)(cw + 1024 + ch0), b1 = *(const f32x4*)(cw + 1024 + ch0 + 4),
                      c0 = *(const f32x4*)(cw + 2048 + ch0), c1 = *(const f32x4*)(cw + 2048 + ch0 + 4);
#pragma unroll
          for (int e = 0; e < 4; ++e) { w0[e] = a0[e]; w0[4 + e] = a1[e]; w1[e] = b0[e]; w1[4 + e] = b1[e]; w2[e] = c0[e]; w2[4 + e] = c1[e]; } }
        float p[4][8];
#pragma unroll
        for (int i = 0; i < 4; ++i)
#pragma unroll
            for (int e = 0; e < 8; ++e) { const int w = e >> 1; p[i][e] = (e & 1) ? bfhi(ur[i][w]) : bflo(ur[i][w]); }
#pragma unroll
        for (int i = 0; i < 2; ++i)
#pragma unroll
            for (int e = 0; e < 8; ++e) { const int w = e >> 1;
                const float cv = w0[e] * p[i][e] + w1[e] * p[i + 1][e] + w2[e] * p[i + 2][e];
                const float yv = ((e & 1) ? bfhi(ab[i][w]) : bflo(ab[i][w])) * cv; y[i][j * 8 + e] = yv; ss[i] += yv * yv; }
    }
#pragma unroll
    for (int i = 0; i < 2; ++i) { const float rstd = rsqrtf(wave_sum(ss[i]) * (1.f / WA) + RMS_EPS);
#pragma unroll
        for (int j = 0; j < 2; ++j) { const int ch0 = j * 512 + lane * 8; const f32x4 n0 = *(const f32x4*)(nrm + ch0), n1 = *(const f32x4*)(nrm + ch0 + 4); const v4u ag = agk[i][j]; float ov[8];
#pragma unroll
            for (int e = 0; e < 8; ++e) { const int w = e >> 1; ov[e] = y[i][j * 8 + e] * rstd * ((e < 4) ? n0[e & 3] : n1[e & 3]) * silu((e & 1) ? bfhi(ag[w]) : bflo(ag[w])); }
            v4u o; o.x = pk2(ov[0], ov[1]); o.y = pk2(ov[2], ov[3]); o.z = pk2(ov[4], ov[5]); o.w = pk2(ov[6], ov[7]);
            *(v4u*)(mix + (size_t)(t0 + i) * LDK + MIX_A + ch0) = o; } }
}
typedef short s16x8 __attribute__((ext_vector_type(8)));
typedef float f32x16 __attribute__((ext_vector_type(16)));
typedef __bf16 bf16x2_t __attribute__((ext_vector_type(2)));
typedef float f32x2_t __attribute__((ext_vector_type(2)));
__device__ __forceinline__ unsigned cvtpk(float lo, float hi) { const f32x2_t v = {lo, hi}; return __builtin_bit_cast(unsigned, __builtin_convertvector(v, bf16x2_t)); }
constexpr int ATT_KROW = 144, ATT_VROW = 520, ATT_K_OFF = 0, ATT_V_OFF = 256 * ATT_KROW;
__device__ __forceinline__ void attn_unit(const bf16* __restrict__ h, const float* __restrict__ sinks, const float* __restrict__ nrm, bf16* __restrict__ mix, fx_t* __restrict__ ssb, LAS unsigned char* lds, int task, const int tid) {
    const int n = task & 15, kvh = (task >> 4) & 3, b = task >> 6;
    const int lane = tid & 63, wave = tid >> 6;
    for (int pc = tid; pc < 2048; pc += NTHR) {
        const int j = pc >> 3, q = pc & 7, pos = 128 * n - 128 + j;
        v4u kv = {0u, 0u, 0u, 0u}, vv = {0u, 0u, 0u, 0u};
        if (pos >= 0) { const bf16* row = h + (size_t)(b * SEQ + pos) * INW; kv = *(const v4u*)(row + OFF_K + kvh * 64 + 8 * q); vv = *(const v4u*)(row + OFF_V + kvh * 64 + 8 * q); }
        *(LAS v4u*)(lds + ATT_K_OFF + j * ATT_KROW + 16 * q) = kv;
        LAS unsigned short* vt = (LAS unsigned short*)(lds + ATT_V_OFF) + (8 * q) * (ATT_VROW / 2) + j;
#pragma unroll
        for (int e = 0; e < 8; ++e) vt[e * (ATT_VROW / 2)] = (unsigned short)((e & 1) ? (vv[e >> 1] >> 16) : (vv[e >> 1] & 0xffffu));
    }
    __syncthreads();
    const int hq = kvh * 8 + wave; const float sink = sinks[hq];
    const int r = lane & 31, hh = lane >> 5; const bool first_blk = (n == 0);
    constexpr float LOG2E = 1.44269504088896341f, SC = 0.125f * LOG2E;
    const size_t tq0 = (size_t)b * SEQ + 128 * n + r;
    s16x8 qf[4];
    { const bf16* hrow = h + tq0 * INW;
#pragma unroll
      for (int s = 0; s < 4; ++s) qf[s] = *(const s16x8*)(hrow + OFF_Q + hq * 64 + 8 * hh + 16 * s); }
#pragma unroll 1
    for (int qs = 0; qs < 4; ++qs) {
        const size_t t = tq0 + 32 * qs;
        s16x8 qn[4]; v2u gw[2][4];
        { const bf16* hrow = h + (t + (qs < 3 ? 32 : 0)) * INW;
#pragma unroll
          for (int s = 0; s < 4; ++s) qn[s] = *(const s16x8*)(hrow + OFF_Q + hq * 64 + 8 * hh + 16 * s);
          const bf16* grow = h + t * INW;
#pragma unroll
          for (int dt = 0; dt < 2; ++dt)
#pragma unroll
              for (int g = 0; g < 4; ++g) gw[dt][g] = *(const v2u*)(grow + OFF_BG + hq * 64 + 32 * dt + 8 * g + 4 * hh); }
        f32x16 sc[5];
#pragma unroll
        for (int ci = 0; ci < 5; ++ci) {
            const LAS unsigned char* kp = lds + ATT_K_OFF + (32 * (qs + ci) + r) * ATT_KROW + 16 * hh;
            f32x16 acc;
#pragma unroll
            for (int i = 0; i < 16; ++i) acc[i] = 0.f;
#pragma unroll
            for (int s = 0; s < 4; ++s) { const s16x8 kf = *(const LAS s16x8*)(kp + 32 * s); acc = __builtin_amdgcn_mfma_f32_32x32x16_bf16(kf, qf[s], acc, 0, 0, 0); }
            sc[ci] = acc;
        }
        float mx = -1e30f;
#pragma unroll
        for (int ci = 0; ci < 5; ++ci)
#pragma unroll
            for (int i = 0; i < 16; ++i) { const int kk = (i & 3) + 8 * (i >> 2) + 4 * hh;
                const bool valid = ((ci == 0) ? (kk > r) : ((ci == 4) ? (kk <= r) : true)) && !(first_blk && qs + ci < 4);
                const float v = valid ? sc[ci][i] : -1e30f; sc[ci][i] = v; mx = fmaxf(mx, v); }
        mx = fmaxf(mx, __shfl_xor(mx, 32));
        const float m = fmaxf(mx * 0.125f, sink), mb = m * LOG2E;
        float sum = 0.f;
#pragma unroll
        for (int ci = 0; ci < 5; ++ci)
#pragma unroll
            for (int i = 0; i < 16; ++i) { const float p = __builtin_amdgcn_exp2f(sc[ci][i] * SC - mb); sc[ci][i] = p; sum += p; }
        sum += __shfl_xor(sum, 32);
        const float inv = 1.f / (sum + __builtin_amdgcn_exp2f((sink - m) * LOG2E));
        f32x16 o[2];
#pragma unroll
        for (int i = 0; i < 16; ++i) { o[0][i] = 0.f; o[1][i] = 0.f; }
#pragma unroll
        for (int ci = 0; ci < 5; ++ci)
#pragma unroll
            for (int s2 = 0; s2 < 2; ++s2) {
                v4u pw; pw.x = cvtpk(sc[ci][8 * s2 + 0], sc[ci][8 * s2 + 1]); pw.y = cvtpk(sc[ci][8 * s2 + 2], sc[ci][8 * s2 + 3]); pw.z = cvtpk(sc[ci][8 * s2 + 4], sc[ci][8 * s2 + 5]); pw.w = cvtpk(sc[ci][8 * s2 + 6], sc[ci][8 * s2 + 7]);
                const s16x8 pf = __builtin_bit_cast(s16x8, pw);
                const int key0 = 32 * (qs + ci) + 16 * s2 + 4 * hh;
#pragma unroll
                for (int dt = 0; dt < 2; ++dt) { const LAS unsigned char* vp = lds + ATT_V_OFF + (32 * dt + r) * ATT_VROW + 2 * key0;
                    const v2u lo = *(const LAS v2u*)vp, hi = *(const LAS v2u*)(vp + 16);
                    v4u vw; vw.x = lo.x; vw.y = lo.y; vw.z = hi.x; vw.w = hi.y;
                    o[dt] = __builtin_amdgcn_mfma_f32_32x32x16_bf16(__builtin_bit_cast(s16x8, vw), pf, o[dt], 0, 0, 0); }
            }
        float ssq = 0.f;
#pragma unroll
        for (int dt = 0; dt < 2; ++dt)
#pragma unroll
            for (int i = 0; i < 16; ++i) { const float y = o[dt][i] * inv; o[dt][i] = y; ssq += y * y; }
        ssq += __shfl_xor(ssq, 32);
        if (hh == 0) pg8::fx_add(ssb + t, ssq);
#pragma unroll
        for (int dt = 0; dt < 2; ++dt)
#pragma unroll
            for (int g = 0; g < 4; ++g) { const int cc = hq * 64 + 32 * dt + 8 * g + 4 * hh;
                const v2u gwv = gw[dt][g]; const f32x4 nv = *(const f32x4*)(nrm + cc);
                v2u ov; ov.x = cvtpk(o[dt][4 * g + 0] * nv[0] * silu(bflo(gwv.x)), o[dt][4 * g + 1] * nv[1] * silu(bfhi(gwv.x)));
                ov.y = cvtpk(o[dt][4 * g + 2] * nv[2] * silu(bflo(gwv.y)), o[dt][4 * g + 3] * nv[3] * silu(bfhi(gwv.y)));
                *(v2u*)(mix + t * LDK + MIX_B + cc) = ov; }
#pragma unroll
        for (int s = 0; s < 4; ++s) qf[s] = qn[s];
    }
    __syncthreads();
}
constexpr int RG_TOK = 128, RG_ROW = 272, RG_HP_OFF = RG_TOK * RG_ROW, RG_HP_ROW = 576, RG_CARRY_OFF = RG_HP_OFF + RG_TOK * RG_HP_ROW;
__device__ __forceinline__ void rg_unit(const bf16* __restrict__ h, const float* __restrict__ ccw, const float* __restrict__ ccb, const bf16* __restrict__ wg, const float* __restrict__ br, const float* __restrict__ bi,
                                        const float* __restrict__ lam, const float* __restrict__ nrm, bf16* __restrict__ mix, fx_t* __restrict__ ssc, unsigned long long* gran, unsigned* tmo, const unsigned epoch,
                                        LAS unsigned char* lds, const int c, const int hd, const int b, const int tid) {
    const int lane = tid & 63, wave = tid >> 6;
    const size_t T0 = (size_t)b * SEQ + RG_TOK * c;
    constexpr float LOG2E = 1.44269504088896341f;
    const int l15 = lane & 15, lg = lane >> 4, chl = 16 * wave + l15, ch = hd * 128 + chl;
    s16x8 Br[4], Bi[4];
    { const bf16* wrp = wg + ((size_t)hd * 128 + chl) * 128 + 8 * lg; const bf16* wip = wrp + (size_t)8 * 128 * 128;
#pragma unroll
      for (int s = 0; s < 4; ++s) { Br[s] = *(const s16x8*)(wrp + 32 * s); Bi[s] = *(const s16x8*)(wip + 32 * s); } }
    const float brv = br[ch] * LOG2E, biv = bi[ch] * LOG2E, L2 = -8.f * log1pf(expf(-lam[ch])) * LOG2E;
    {
        const int g = tid & 15, tr = tid >> 4, ch = hd * 128 + 8 * g;
        float w[4][8], bs[8];
#pragma unroll
        for (int k = 0; k < 4; ++k) { const f32x4 a = *(const f32x4*)(ccw + k * 1024 + ch), q = *(const f32x4*)(ccw + k * 1024 + ch + 4);
#pragma unroll
            for (int e = 0; e < 4; ++e) { w[k][e] = a[e]; w[k][4 + e] = q[e]; } }
        { const f32x4 a = *(const f32x4*)(ccb + ch), q = *(const f32x4*)(ccb + ch + 4);
#pragma unroll
          for (int e = 0; e < 4; ++e) { bs[e] = a[e]; bs[4 + e] = q[e]; } }
        v4u rows[7];
#pragma unroll
        for (int i = 0; i < 7; ++i) { const int trow = 4 * tr - 3 + i; const bool ok = (c > 0) || (trow >= 0);
            v4u z = {0u, 0u, 0u, 0u}; if (ok) z = *(const v4u*)(h + (size_t)((long)T0 + trow) * INW + OFF_CX + ch); rows[i] = z; }
#pragma unroll
        for (int i = 0; i < 4; ++i) { float o[8];
#pragma unroll
            for (int e = 0; e < 8; ++e) { float acc = bs[e];
#pragma unroll
                for (int k = 0; k < 4; ++k) { const unsigned wd = rows[i + k][e >> 1]; acc += w[k][e] * ((e & 1) ? bfhi(wd) : bflo(wd)); }
                o[e] = acc; }
            v4u ov; ov.x = cvtpk(o[0], o[1]); ov.y = cvtpk(o[2], o[3]); ov.z = cvtpk(o[4], o[5]); ov.w = cvtpk(o[6], o[7]);
            *(LAS v4u*)(lds + (4 * tr + i) * RG_ROW + 16 * g) = ov; }
    }
    __syncthreads();
    float Prun = 1.f, Hrun = 0.f;
    {
#pragma unroll 2
        for (int tt = 0; tt < RG_TOK / 16; ++tt) {
            const LAS unsigned char* ap = lds + (16 * tt + l15) * RG_ROW + 16 * lg;
            pg8::f32x4 ar = {0.f, 0.f, 0.f, 0.f}, ai = {0.f, 0.f, 0.f, 0.f};
#pragma unroll
            for (int s = 0; s < 4; ++s) { const s16x8 af = *(const LAS s16x8*)(ap + 64 * s);
                ar = __builtin_amdgcn_mfma_f32_16x16x32_bf16(af, Br[s], ar, 0, 0, 0); ai = __builtin_amdgcn_mfma_f32_16x16x32_bf16(af, Bi[s], ai, 0, 0, 0); }
            float pl[4], hl[4]; float P = 1.f, H = 0.f;
#pragma unroll
            for (int rg = 0; rg < 4; ++rg) { const int trow = 16 * tt + 4 * lg + rg;
                const float xcv = bf2f(*(const LAS unsigned short*)(lds + trow * RG_ROW + 2 * chl));
                const float rr = __builtin_amdgcn_rcpf(1.f + __builtin_amdgcn_exp2f(-(ar[rg] * LOG2E + brv)));
                const float ig = __builtin_amdgcn_rcpf(1.f + __builtin_amdgcn_exp2f(-(ai[rg] * LOG2E + biv)));
                const float a = __builtin_amdgcn_exp2f(rr * L2);
                const float u = __builtin_amdgcn_sqrtf(fmaxf(fmaf(-a, a, 1.f), 0.f)) * (ig * xcv);
                H = a * H + u; P = a * P; pl[rg] = P; hl[rg] = H; }
            float myP = Prun, myH = Hrun, Pst = Prun, Hst = Hrun;
#pragma unroll
            for (int x = 0; x < 4; ++x) { const float Ax = __shfl(P, l15 + 16 * x), Hx = __shfl(H, l15 + 16 * x);
                if (x == lg) { myP = Pst; myH = Hst; }
                Hst = Ax * Hst + Hx; Pst = Ax * Pst; }
            Prun = Pst; Hrun = Hst;
#pragma unroll
            for (int rg = 0; rg < 4; ++rg) *(LAS unsigned*)(lds + RG_HP_OFF + (16 * tt + 4 * lg + rg) * RG_HP_ROW + 4 * chl) = cvtpk(hl[rg] + pl[rg] * myH, pl[rg] * myP);
        }
    }
    unsigned gwv[RG_TOK / 8];
    { const size_t tbq = T0 + wave * (RG_TOK / 8);
#pragma unroll
      for (int i = 0; i < RG_TOK / 8; ++i) gwv[i] = *(const unsigned*)(h + (tbq + i) * INW + OFF_CG + hd * 128 + 2 * lane); }
    if (lg == 0) { unsigned long long* gp = gran + ((((size_t)b * 8 + hd) * 16 + c) * 128 + chl) * 2;
        __hip_atomic_store(gp, ((unsigned long long)epoch << 32) | __builtin_bit_cast(unsigned, Prun), __ATOMIC_RELAXED, __HIP_MEMORY_SCOPE_AGENT);
        __hip_atomic_store(gp + 1, ((unsigned long long)epoch << 32) | __builtin_bit_cast(unsigned, Hrun), __ATOMIC_RELAXED, __HIP_MEMORY_SCOPE_AGENT); }
    if (tid < 128) {
        const unsigned long long* gq = gran + (((size_t)b * 8 + hd) * 16 * 128 + tid) * 2;
        float Av[15], Hv[15]; unsigned spins = 0;
        for (;;) { bool ok = true;
#pragma unroll
            for (int cp = 0; cp < 15; ++cp) { Av[cp] = 1.f; Hv[cp] = 0.f;
                if (cp < c) { const unsigned long long xa = __hip_atomic_load(gq + cp * 256, __ATOMIC_RELAXED, __HIP_MEMORY_SCOPE_AGENT), xh = __hip_atomic_load(gq + cp * 256 + 1, __ATOMIC_RELAXED, __HIP_MEMORY_SCOPE_AGENT);
                    ok = ok && ((unsigned)(xa >> 32) == epoch) && ((unsigned)(xh >> 32) == epoch); Av[cp] = __builtin_bit_cast(float, (unsigned)xa); Hv[cp] = __builtin_bit_cast(float, (unsigned)xh); } }
            if (ok) break;
            if (++spins > 40000u) { __hip_atomic_store(tmo, 1u, __ATOMIC_RELAXED, __HIP_MEMORY_SCOPE_AGENT); break; }
            __builtin_amdgcn_s_sleep(2); }
        float carry = 0.f;
#pragma unroll
        for (int cp = 0; cp < 15; ++cp) if (cp < c) carry = Av[cp] * carry + Hv[cp];
        ((LAS float*)(lds + RG_CARRY_OFF))[tid] = carry;
    }
    __syncthreads();
    {
        const float n0 = nrm[hd * 128 + 2 * lane], n1 = nrm[hd * 128 + 2 * lane + 1];
        const float c0 = ((const LAS float*)(lds + RG_CARRY_OFF))[2 * lane], c1 = ((const LAS float*)(lds + RG_CARRY_OFF))[2 * lane + 1];
        const size_t tb = T0 + wave * (RG_TOK / 8);
        float ssq[RG_TOK / 8];
#pragma unroll
        for (int i = 0; i < RG_TOK / 8; ++i) { const int row = wave * (RG_TOK / 8) + i;
            const v2u hw = *(const LAS v2u*)(lds + RG_HP_OFF + row * RG_HP_ROW + 8 * lane);
            const float y0 = bflo(hw.x) + bfhi(hw.x) * c0, y1 = bflo(hw.y) + bfhi(hw.y) * c1;
            ssq[i] = y0 * y0 + y1 * y1;
            *(unsigned*)(mix + (tb + i) * LDK + MIX_C + hd * 128 + 2 * lane) = cvtpk(y0 * n0 * silu(bflo(gwv[i])), y1 * n1 * silu(bfhi(gwv[i]))); }
#pragma unroll
        for (int st = 0; st < 4; ++st) { const int hm = 8 >> st, bit = 1 << st;
            const bool up = (lane & bit) != 0;
#pragma unroll
            for (int k = 0; k < hm; ++k) { const float mine = up ? ssq[k + hm] : ssq[k], other = up ? ssq[k] : ssq[k + hm]; ssq[k] = mine + __shfl_xor(other, bit); } }
        float tot = ssq[0]; tot += __shfl_xor(tot, 16); tot += __shfl_xor(tot, 32);
        if (lane < 16) { const int row = 8 * (lane & 1) + 4 * ((lane >> 1) & 1) + 2 * ((lane >> 2) & 1) + ((lane >> 3) & 1); pg8::fx_add(ssc + tb + row, tot); }
    }
    __syncthreads();
}
__device__ __forceinline__ void final_ln_token(const bf16* __restrict__ yb, const fx_t* __restrict__ st, const float* __restrict__ g, const float* __restrict__ bta, float* __restrict__ xo, int t, int lane) {
    const float s = pg8::fx_get(st + 2 * (size_t)t), q = pg8::fx_get(st + 2 * (size_t)t + 1);
    const float mean = s * (1.f / DM), rstd = rsqrtf(fmaxf(q * (1.f / DM) - mean * mean, 0.f) + LN_EPS);
#pragma unroll
    for (int j = 0; j < 8; ++j) { const int cc = 8 * (lane + 64 * j);
        const v4u hw = *(const v4u*)(yb + (size_t)t * LDK + cc);
        const f32x4 g0 = *(const f32x4*)(g + cc), g1 = *(const f32x4*)(g + cc + 4), b0 = *(const f32x4*)(bta + cc), b1 = *(const f32x4*)(bta + cc + 4);
        f32x4 o0, o1;
        o0[0] = (bflo(hw[0]) - mean) * rstd * g0[0] + b0[0]; o0[1] = (bfhi(hw[0]) - mean) * rstd * g0[1] + b0[1];
        o0[2] = (bflo(hw[1]) - mean) * rstd * g0[2] + b0[2]; o0[3] = (bfhi(hw[1]) - mean) * rstd * g0[3] + b0[3];
        o1[0] = (bflo(hw[2]) - mean) * rstd * g1[0] + b1[0]; o1[1] = (bfhi(hw[2]) - mean) * rstd * g1[1] + b1[1];
        o1[2] = (bflo(hw[3]) - mean) * rstd * g1[2] + b1[2]; o1[3] = (bfhi(hw[3]) - mean) * rstd * g1[3] + b1[3];
        __builtin_nontemporal_store(o0, (f32x4*)(xo + (size_t)t * DM + cc)); __builtin_nontemporal_store(o1, (f32x4*)(xo + (size_t)t * DM + cc + 4)); }
}

struct Args { const float* in[17]; float* out; unsigned char* ws; };
#define KA_AS __attribute__((address_space(4)))
#define AIN(k) (*(const float* const KA_AS*)(ka_ + 8 * (k)))
#define AOUT (*(float* const KA_AS*)(ka_ + 8 * 17))
#define AWS (*(unsigned char* const KA_AS*)(ka_ + 8 * 18))
#define TZ_INIT() const KA_AS unsigned char* ka_ = (const KA_AS unsigned char*)__builtin_amdgcn_kernarg_segment_ptr(); asm volatile("" : "+s"(ka_)); int lz = l_; asm volatile("" : "+s"(lz)); const int l = lz; (void)l; int tz = threadIdx.x; asm volatile("" : "+v"(tz)); const int tid = tz, lane = tz & 63, wave = __builtin_amdgcn_readfirstlane(tz >> 6); const int G = gridDim.x, gw = blockIdx.x * NWAVES + wave, NGW = G * NWAVES; (void)tid; (void)lane; (void)gw; (void)NGW
__global__ void __launch_bounds__(NTHR, 2) fwd(Args args) {
    extern __shared__ __attribute__((aligned(16))) unsigned char lds_raw[];
    LAS unsigned char* lds = (LAS unsigned char*)lds_raw;
    volatile LAS unsigned* MISC = (volatile LAS unsigned*)(lds + LDS_MISC);
    for (int u = threadIdx.x; u < (LDS_BYTES - 131072) / 4; u += NTHR) ((LAS unsigned*)(lds + 131072))[u] = 0u;
    __syncthreads();
    (void)xcd_barrier_post((unsigned*)(args.ws + WS_CTL) + 4096, MISC + 8);
#define GRID_BARRIER() do { XcdBarrier b_; b_.bar = (unsigned*)(args.ws + WS_CTL) + 4096; b_.x = xb_xcc_id(); b_.st = (volatile LAS unsigned*)(lds + LDS_MISC) + 8; xcd_barrier(b_); } while (0)
#define WSP(T, off) ((T*)(AWS + (off)))

    {
        const int l_ = 0; TZ_INIT();
        LAS float* scr = (LAS float*)(lds + wave * 16384);
        for (int ll = 0; ll < DEPTH; ++ll) convert_layer(AIN(1), AIN(14), AIN(15), AIN(16), AWS, ll, scr, gw, NGW, lane);
        for (int it = gw; it < DEPTH * 2 * 8 * 2; it += NGW) {
            const int nb = it & 1, hd = (it >> 1) & 7, gate = (it >> 4) & 1, ll = it >> 5;
            convert_task<false, false>(AIN(gate ? 8 : 6) + ((size_t)ll * 8 + hd) * 128 * 128, WSP(bf16, WS_WG) + (((size_t)ll * 2 + gate) * 8 + hd) * 128 * 128, 128, 128, scr, nb, nb, 0, 2, lane, nullptr, nullptr, nullptr, nullptr); }
        const float* x = AIN(0); bf16* xb = WSP(bf16, WS_XB);
        { const size_t total = (size_t)M * DM / 8, S = (size_t)G * NTHR;
          for (size_t i = (size_t)blockIdx.x * NTHR + tid; i < total; i += 4 * S) {
            f32x4 a[4], b[4];
#pragma unroll
            for (int u = 0; u < 4; ++u) { const size_t iu = i + u * S; if (iu < total) { a[u] = __builtin_nontemporal_load((const f32x4*)x + 2 * iu); b[u] = __builtin_nontemporal_load((const f32x4*)x + 2 * iu + 1); } }
#pragma unroll
            for (int u = 0; u < 4; ++u) { const size_t iu = i + u * S; if (iu < total) {
                v4u o; o.x = pk2(a[u][0], a[u][1]); o.y = pk2(a[u][2], a[u][3]); o.z = pk2(b[u][0], b[u][1]); o.w = pk2(b[u][2], b[u][3]);
                const size_t row = iu / (DM / 8), cc = iu % (DM / 8);
                *(v4u*)(xb + row * LDK + 8 * cc) = o; } } } }
    }
    GRID_BARRIER();
    for (int l_ = 0; l_ < DEPTH; ++l_) {
#define GEMM1_TABLES(S_) do { const fx_t* stp = WSP(fx_t, WS_CTL + CTL_ST) + (size_t)(l > 0 ? l - 1 : 0) * M * 2; const fx_t* Gv = WSP(fx_t, WS_CTL + CTL_GV) + (size_t)l * INW; const fx_t* Bvv = WSP(fx_t, WS_CTL + CTL_BV) + (size_t)l * INW; \
            _Pragma("unroll") for (int i = 0; i < 6; ++i) { pg8::Unit u; if ((S_).next(i, u)) { \
                if (tid < 256) { float mu = 0.f, rs = 1.f; \
                    if (l > 0) { const float s = pg8::fx_get(stp + 2 * (size_t)(u.pm * 256 + tid)), q = pg8::fx_get(stp + 2 * (size_t)(u.pm * 256 + tid) + 1); mu = s * (1.f / DM); rs = rsqrtf(fmaxf(q * (1.f / DM) - mu * mu, 0.f) + LN_EPS); } \
                    ((LAS pg8::f32x2*)(lds + pg8::TBL_ROW))[i * 256 + tid] = (pg8::f32x2){mu, rs}; } \
                else { const int cidx = u.pn * 256 + tid - 256; float gg = 0.f, bb = 0.f; if (l > 0) { gg = pg8::fx_get(Gv + cidx); bb = pg8::fx_get(Bvv + cidx); } \
                    ((LAS pg8::f32x2*)(lds + pg8::TBL_COL))[i * 256 + tid - 256] = (pg8::f32x2){gg, bb}; } } } } while (0)
        { TZ_INIT();
          pg8::Gemm g; g.A = WSP(bf16, WS_XB); g.Bt = WSP(bf16, WS_WIN) + (size_t)l * WIN_L; g.M = M; g.N = INW - 512; g.K = DM; g.ld = LDK; pg8::EpiBf16LN E; E.O = WSP(bf16, WS_H); E.ldc = INW; E.pad = 0;
          pg8::StaticOrder S; S.init(M, INW - 512, G, (int)blockIdx.x);
          auto pre = [&]() { GEMM1_TABLES(S); };
          pg8::gemm_phase<pg8::EpiBf16LN, pg8::StaticOrder, true, true>(lds, g, S, E, tid, pre); }
        GRID_BARRIER();
        { TZ_INIT();
          pg8::Gemm g; g.A = WSP(bf16, WS_XB); g.Bt = WSP(bf16, WS_WIN) + (size_t)l * WIN_L; g.M = M; g.N = INW; g.K = DM; g.ld = LDK; pg8::EpiBf16LN E; E.O = WSP(bf16, WS_H); E.ldc = INW; E.pad = 0;
          pg8::OneUnit S; { const int bx = (int)blockIdx.x, x = bx & 7, idx = bx >> 3; S.has = (bx < 64) ? 1 : 0; S.pm = 4 * x + (idx >> 1); S.pn = (INW / 256 - 2) + (idx & 1); }
          if (S.has) { auto pre = [&]() { GEMM1_TABLES(S); }; pg8::gemm_phase<pg8::EpiBf16LN, pg8::OneUnit, false, true>(lds, g, S, E, tid, pre);
              VM_WAIT(); __syncthreads();
              if (tid == 0) { __builtin_amdgcn_fence(__ATOMIC_RELEASE, "agent"); VM_WAIT();
                  __hip_atomic_fetch_add(WSP(unsigned, WS_CTL + CTL_RF) + 64 * l + S.pm * 2 + (S.pn - (INW / 256 - 2)), 1u, __ATOMIC_RELAXED, __HIP_MEMORY_SCOPE_AGENT); } } }
#define Q_NEXT() do { if (tid == 0) *qw = __hip_atomic_fetch_add(qctr, 1u, __ATOMIC_RELAXED, __HIP_MEMORY_SCOPE_AGENT); __syncthreads(); tk = (int)__builtin_amdgcn_readfirstlane((int)*qw); __syncthreads(); } while (0)
        { TZ_INIT();
          unsigned* qctr = WSP(unsigned, WS_CTL + CTL_Q) + 64 * l; LAS unsigned* qw = (LAS unsigned*)(lds + LDS_MISC) + 16; int tk;
          fx_t* ssb = WSP(fx_t, WS_CTL + CTL_SS) + (size_t)(2 * l) * M;
          Q_NEXT();
          while (tk < 256) { attn_unit(WSP(bf16, WS_H), AIN(3) + (size_t)l * NQH, AIN(12) + (size_t)l * WB, WSP(bf16, WS_MIX), ssb, lds, tk, tid); Q_NEXT(); } }
        { TZ_INIT();
          unsigned* qctr = WSP(unsigned, WS_CTL + CTL_Q) + 64 * l; LAS unsigned* qw = (LAS unsigned*)(lds + LDS_MISC) + 16; int tk = (int)__builtin_amdgcn_readfirstlane((int)*qw);
          fx_t* ssc = WSP(fx_t, WS_CTL + CTL_SS) + (size_t)(2 * l + 1) * M;
          while (tk < 512) { const int r = tk - 256;
              rg_unit(WSP(bf16, WS_H), AIN(4) + (size_t)l * 4 * WC, AIN(5) + (size_t)l * WC, WSP(bf16, WS_WG) + (size_t)l * 2 * 8 * 128 * 128, AIN(7) + (size_t)l * WC, AIN(9) + (size_t)l * WC,
                      AIN(10) + (size_t)l * WC, AIN(13) + (size_t)l * WC, WSP(bf16, WS_MIX), ssc, WSP(unsigned long long, WS_CTL + CTL_GR), WSP(unsigned, WS_CTL) + 8, (unsigned)(l + 1), lds, r >> 4, r & 3, (r >> 2) & 3, tid);
              Q_NEXT(); } }
        { TZ_INIT();
          unsigned* qctr = WSP(unsigned, WS_CTL + CTL_Q) + 64 * l; LAS unsigned* qw = (LAS unsigned*)(lds + LDS_MISC) + 16; int tk = (int)__builtin_amdgcn_readfirstlane((int)*qw);
          while (tk < 768) { const int t0 = 32 * (tk - 512) + 4 * wave;
              branch_a_pair(WSP(bf16, WS_H), AIN(2) + (size_t)l * 3 * WA, AIN(11) + (size_t)l * WA, WSP(bf16, WS_MIX), t0, lane);
              branch_a_pair(WSP(bf16, WS_H), AIN(2) + (size_t)l * 3 * WA, AIN(11) + (size_t)l * WA, WSP(bf16, WS_MIX), t0 + 2, lane);
              Q_NEXT(); } }
        { TZ_INIT();
          unsigned* qctr = WSP(unsigned, WS_CTL + CTL_Q) + 64 * l; LAS unsigned* qw = (LAS unsigned*)(lds + LDS_MISC) + 16; int tk = (int)__builtin_amdgcn_readfirstlane((int)*qw);
          fx_t* ssc = WSP(fx_t, WS_CTL + CTL_SS) + (size_t)(2 * l + 1) * M;
          while (tk < 1024) { const int r = tk - 768; int tu = tid; asm volatile("" : "+v"(tu));
              if (tid == 0) { unsigned* f = WSP(unsigned, WS_CTL + CTL_RF) + 64 * l + (8 * ((r >> 2) & 3) + (r >> 5)) * 2 + ((r & 3) >> 1); unsigned sp = 0u;
                  while (__hip_atomic_load(f, __ATOMIC_RELAXED, __HIP_MEMORY_SCOPE_AGENT) == 0u) { __builtin_amdgcn_s_sleep(2); if (++sp > (1u << 20)) { __hip_atomic_store(WSP(unsigned, WS_CTL) + 8, 1u, __ATOMIC_RELAXED, __HIP_MEMORY_SCOPE_AGENT); break; } }
                  __builtin_amdgcn_fence(__ATOMIC_ACQUIRE, "agent"); VM_WAIT(); }
              __syncthreads();
              rg_unit(WSP(bf16, WS_H), AIN(4) + (size_t)l * 4 * WC, AIN(5) + (size_t)l * WC, WSP(bf16, WS_WG) + (size_t)l * 2 * 8 * 128 * 128, AIN(7) + (size_t)l * WC, AIN(9) + (size_t)l * WC,
                      AIN(10) + (size_t)l * WC, AIN(13) + (size_t)l * WC, WSP(bf16, WS_MIX), ssc, WSP(unsigned long long, WS_CTL + CTL_GR), WSP(unsigned, WS_CTL) + 8, (unsigned)(l + 1), lds, r >> 4, 4 + (r & 3), (r >> 2) & 3, tu);
              Q_NEXT(); } }
        GRID_BARRIER();
        { TZ_INIT();
          pg8::Gemm g; g.A = WSP(bf16, WS_MIX); g.Bt = WSP(bf16, WS_WOUT) + (size_t)l * WOUT_L; g.M = M; g.N = DM; g.K = DMIX; g.ld = LDK;
          pg8::EpiResLN E; E.Yb = WSP(bf16, WS_XB); const float* lng = AIN(15) + (size_t)(l > 0 ? l - 1 : 0) * DM; const float* lnb = AIN(16) + (size_t)(l > 0 ? l - 1 : 0) * DM;
          E.st = WSP(fx_t, WS_CTL + CTL_ST) + (size_t)l * M * 2; E.alpha = ALPHA; E.ldb = LDK;
          pg8::StaticOrder S; S.init(M, DM, G, (int)blockIdx.x);
          auto pre = [&]() { const fx_t* ssb = WSP(fx_t, WS_CTL + CTL_SS) + (size_t)(2 * l) * M; const fx_t* ssc = ssb + M; const fx_t* stp = WSP(fx_t, WS_CTL + CTL_ST) + (size_t)(l > 0 ? l - 1 : 0) * M * 2;
            pg8::Unit u; if (S.next(wave >> 2, u)) { const int grow = u.pm * 256 + (tid & 255);
                const float rb = rsqrtf(pg8::fx_get(ssb + grow) * (1.f / WB) + RMS_EPS), rc = rsqrtf(pg8::fx_get(ssc + grow) * (1.f / WC) + RMS_EPS); float mu = 0.f, rs = 1.f;
                if (l > 0) { const float s = pg8::fx_get(stp + 2 * (size_t)grow), q = pg8::fx_get(stp + 2 * (size_t)grow + 1); mu = s * (1.f / DM); rs = rsqrtf(fmaxf(q * (1.f / DM) - mu * mu, 0.f) + LN_EPS); }
                ((LAS pg8::f32x4*)(lds + pg8::TBL_ROW))[tid] = (pg8::f32x4){rc / rb, rb, mu, rs};
                float gg = 1.f, bb = 0.f; if (l > 0) { gg = lng[u.pn * 256 + (tid & 255)]; bb = lnb[u.pn * 256 + (tid & 255)]; }
                ((LAS pg8::f32x2*)(lds + pg8::TBL_COL))[tid] = (pg8::f32x2){gg, bb}; } };
          pg8::gemm_phase<pg8::EpiResLN, pg8::StaticOrder, true, true>(lds, g, S, E, tid, pre); }
        GRID_BARRIER();
    }
    { const int l_ = DEPTH - 1; TZ_INIT();
      for (int t = gw; t < M; t += NGW) final_ln_token(WSP(bf16, WS_XB), WSP(fx_t, WS_CTL + CTL_ST) + (size_t)l * M * 2, AIN(15) + (size_t)l * DM, AIN(16) + (size_t)l * DM, AOUT, t, lane); }
}

extern "C" void kernel_launch(void* const* d_in, const int* in_sizes, int n_in, void* d_out, int out_size, void* d_ws, size_t ws_size, hipStream_t stream) {
    static int grid = 0;
    if (grid == 0) {
        if (n_in != 17 || in_sizes[0] != M * DM || out_size != M * DM || ws_size < WS_END) { fprintf(stderr, "kernel_launch: unexpected shapes/workspace (n_in %d, ws %zu)\n", n_in, ws_size); grid = -1; return; }
        int dev = 0, cus = 0, per_cu = 0;
        if (hipGetDevice(&dev) != hipSuccess || hipDeviceGetAttribute(&cus, hipDeviceAttributeMultiprocessorCount, dev) != hipSuccess) { grid = -1; return; }
        if (hipFuncSetAttribute((const void*)fwd, hipFuncAttributeMaxDynamicSharedMemorySize, LDS_BYTES) != hipSuccess) { fprintf(stderr, "kernel_launch: hipFuncSetAttribute failed\n"); grid = -1; return; }
        if (hipOccupancyMaxActiveBlocksPerMultiprocessor(&per_cu, (const void*)fwd, NTHR, LDS_BYTES) != hipSuccess || per_cu < 1) fprintf(stderr, "kernel_launch: occupancy query reports %d\n", per_cu);
        (void)hipGetLastError();
        grid = cus > 0 ? cus : 256;
        if (grid < 256) { fprintf(stderr, "kernel_launch: this kernel's unit tables assume at least 256 workgroups (one per CU of a 256-CU device); found %d CUs: nothing launched\n", grid); grid = -1; return; }
    }
    if (grid < 0) return;
    (void)hipMemsetAsync((char*)d_ws + WS_CTL, 0, CTL_BYTES, stream);
    Args a{};
    for (int i = 0; i < 17; ++i) a.in[i] = (const float*)d_in[i];
    a.out = (float*)d_out; a.ws = (unsigned char*)d_ws;
    hipLaunchKernelGGL(fwd, dim3(grid), dim3(NTHR), LDS_BYTES, stream, a);
}
```
